# Optimizing an MI355X kernel written in HIP

```python
import math
import jax, jax.numpy as jnp
from jax import lax
import numpy as np

D_MODEL = 1024
BATCH = 16
SEQ = 4096
DEPTH = 1

CHUNK = 64
Q_BLOCK = 128

FOX_HEADS = 8
FOX_HEAD_DIM = 64
FOX_WIDTH = FOX_HEADS * FOX_HEAD_DIM

DIFF_HEADS = 4
DIFF_HALF_DIM = 64
DIFF_HEAD_DIM = 2 * DIFF_HALF_DIM
DIFF_WIDTH = DIFF_HEADS * DIFF_HEAD_DIM

MIX_WIDTH = FOX_WIDTH + DIFF_WIDTH
IN_COLS = 3 * FOX_WIDTH + FOX_HEADS + 3 * DIFF_WIDTH

PEER_HEADS = 8
PEER_N_KEYS = 128
PEER_N_EXPERTS = PEER_N_KEYS * PEER_N_KEYS
PEER_HALF_DIM = 128
PEER_QUERY_DIM = 2 * PEER_HALF_DIM
PEER_TOPK = 16
PEER_TOKEN_BLOCK = 128

RMS_EPS = 1e-6

kernel_name = "hybrid_fox_diffattn_peer_block"


def _rmsnorm(x, g):
    xf = x.astype(jnp.float32)
    y = xf * lax.rsqrt(jnp.mean(xf * xf, axis=-1, keepdims=True) + RMS_EPS)
    return (y * g.astype(jnp.float32)).astype(x.dtype)


def _alibi_slopes(n):
    return jnp.asarray([2.0 ** (-8.0 * (i + 1) / n) for i in range(n)], dtype=jnp.float32)


def _sweep(body, n_blocks):
    out = lax.map(body, jnp.arange(n_blocks))
    nb, b, h, qb, dv = out.shape
    return out.transpose(1, 0, 3, 2, 4).reshape(b, nb * qb, h * dv)


def _forgetting_attention(q, k, v, log_f):
    seq = q.shape[2]
    scale = FOX_HEAD_DIM ** -0.5
    c = jnp.cumsum(log_f, axis=-1)
    key_pos = jnp.arange(seq)

    def body(i):
        start = i * Q_BLOCK
        qb = lax.dynamic_slice_in_dim(q, start, Q_BLOCK, axis=2)
        cq = lax.dynamic_slice_in_dim(c, start, Q_BLOCK, axis=2)
        t = start + jnp.arange(Q_BLOCK)
        logits = (jnp.einsum('bhqd,bhkd->bhqk', qb, k).astype(jnp.float32) * scale
                  + (cq[..., :, None] - c[..., None, :]))
        mask = key_pos[None, :] <= t[:, None]
        p = jax.nn.softmax(jnp.where(mask, logits, -jnp.inf), axis=-1)
        return jnp.einsum('bhqk,bhkd->bhqd', p.astype(v.dtype), v)

    return _sweep(body, seq // Q_BLOCK)


def _differential_attention(q1, k1, q2, k2, v, lam, lambda_init, subln_g):
    seq = q1.shape[2]
    scale = DIFF_HALF_DIM ** -0.5
    slopes = _alibi_slopes(DIFF_HEADS)
    key_pos = jnp.arange(seq)

    def body(i):
        start = i * Q_BLOCK
        q1b = lax.dynamic_slice_in_dim(q1, start, Q_BLOCK, axis=2)
        q2b = lax.dynamic_slice_in_dim(q2, start, Q_BLOCK, axis=2)
        t = start + jnp.arange(Q_BLOCK)
        dist = jnp.abs(t[:, None] - key_pos[None, :]).astype(jnp.float32)
        alibi = -slopes[:, None, None] * dist[None]
        mask = (key_pos[None, :] // CHUNK) <= (t[:, None] // CHUNK)
        l1 = jnp.einsum('bhqd,bhkd->bhqk', q1b, k1).astype(jnp.float32) * scale + alibi
        l2 = jnp.einsum('bhqd,bhkd->bhqk', q2b, k2).astype(jnp.float32) * scale + alibi
        a1 = jax.nn.softmax(jnp.where(mask, l1, -jnp.inf), axis=-1)
        a2 = jax.nn.softmax(jnp.where(mask, l2, -jnp.inf), axis=-1)
        attn = a1 - lam * a2
        o = jnp.einsum('bhqk,bhkd->bhqd', attn.astype(v.dtype), v)
        return _rmsnorm(o, subln_g) * (1.0 - lambda_init)

    return _sweep(body, seq // Q_BLOCK)


def _peer(xn, w_q, sub_keys, u_tab, v_tab):
    b, s, d = xn.shape
    blocks = xn.reshape(-1, PEER_TOKEN_BLOCK, d)

    def body(xb):
        q = (xb @ w_q).reshape(PEER_TOKEN_BLOCK, PEER_HEADS, 2, PEER_HALF_DIM)
        sc = jnp.einsum('thpd,hpkd->thpk', q, sub_keys).astype(jnp.float32)
        s1, i1 = lax.top_k(sc[:, :, 0], PEER_TOPK)
        s2, i2 = lax.top_k(sc[:, :, 1], PEER_TOPK)
        cand = (s1[..., :, None] + s2[..., None, :]).reshape(PEER_TOKEN_BLOCK, PEER_HEADS, -1)
        cidx = (i1[..., :, None] * PEER_N_KEYS + i2[..., None, :]).reshape(PEER_TOKEN_BLOCK, PEER_HEADS, -1)
        top_s, pos = lax.top_k(cand, PEER_TOPK)
        eidx = jnp.take_along_axis(cidx, pos, axis=-1)
        g = jax.nn.softmax(top_s, axis=-1).astype(xb.dtype)
        u_sel = jnp.take(u_tab, eidx, axis=0)
        hid = jax.nn.gelu(jnp.einsum('thkd,td->thk', u_sel, xb), approximate=False) * g
        v_sel = jnp.take(v_tab, eidx, axis=0)
        return jnp.einsum('thk,thkd->td', hid, v_sel)

    return lax.map(body, blocks).reshape(b, s, d)


def setup_inputs(seed: int = 0) -> dict:
    key = jax.random.key(seed)
    ks = jax.random.split(key, 17)
    f32 = jnp.float32
    n = lambda k, shape, sc: jax.random.normal(k, shape, f32) * sc
    return {
        "x": n(ks[0], (BATCH, SEQ, D_MODEL), 1.0),
        "norm1_g": 1.0 + n(ks[1], (DEPTH, D_MODEL), 0.02),
        "w_in": n(ks[2], (DEPTH, D_MODEL, IN_COLS), D_MODEL ** -0.5),
        "b_f": 2.5 + n(ks[3], (DEPTH, FOX_HEADS), 0.5),
        "lambda_q1": n(ks[4], (DEPTH, DIFF_HALF_DIM), 0.1),
        "lambda_k1": n(ks[5], (DEPTH, DIFF_HALF_DIM), 0.1),
        "lambda_q2": n(ks[6], (DEPTH, DIFF_HALF_DIM), 0.1),
        "lambda_k2": n(ks[7], (DEPTH, DIFF_HALF_DIM), 0.1),
        "subln_g": 1.0 + n(ks[8], (DEPTH, DIFF_HEAD_DIM), 0.02),
        "w_out": n(ks[9], (DEPTH, MIX_WIDTH, D_MODEL), MIX_WIDTH ** -0.5),
        "norm2_g": 1.0 + n(ks[10], (DEPTH, D_MODEL), 0.02),
        "peer_w_q": n(ks[11], (DEPTH, D_MODEL, PEER_HEADS * PEER_QUERY_DIM), D_MODEL ** -0.5),
        "peer_sub_keys": n(ks[12], (DEPTH, PEER_HEADS, 2, PEER_N_KEYS, PEER_HALF_DIM), PEER_HALF_DIM ** -0.5),
        "peer_u": n(ks[13], (DEPTH, PEER_N_EXPERTS, D_MODEL), D_MODEL ** -0.5),
        "peer_v": n(ks[14], (DEPTH, PEER_N_EXPERTS, D_MODEL), 0.5),
        "final_g": 1.0 + n(ks[15], (D_MODEL,), 0.02),
    }


def reference(x, norm1_g, w_in, b_f, lambda_q1, lambda_k1, lambda_q2, lambda_k2,
              subln_g, w_out, norm2_g, peer_w_q, peer_sub_keys, peer_u, peer_v, final_g):
    b, s, _ = x.shape
    split_pts = np.cumsum([FOX_WIDTH, FOX_WIDTH, FOX_WIDTH, FOX_HEADS, DIFF_WIDTH, DIFF_WIDTH])
    h = x
    for layer in range(DEPTH):
        xn = _rmsnorm(h, norm1_g[layer])
        proj = xn @ w_in[layer]
        qa, ka, va, fa, qb, kb, vb = jnp.split(proj, split_pts, axis=-1)

        heads_a = lambda t: t.reshape(b, s, FOX_HEADS, FOX_HEAD_DIM).transpose(0, 2, 1, 3)
        log_f = jax.nn.log_sigmoid((fa + b_f[layer]).astype(jnp.float32)).transpose(0, 2, 1)
        out_a = _forgetting_attention(heads_a(qa), heads_a(ka), heads_a(va), log_f)

        heads_b = lambda t: t.reshape(b, s, DIFF_HEADS, DIFF_HEAD_DIM).transpose(0, 2, 1, 3)
        qb_h, kb_h, vb_h = heads_b(qb), heads_b(kb), heads_b(vb)
        lambda_init = 0.8 - 0.6 * math.exp(-0.3 * layer)
        lam = (jnp.exp(jnp.sum(lambda_q1[layer].astype(jnp.float32) * lambda_k1[layer].astype(jnp.float32)))
               - jnp.exp(jnp.sum(lambda_q2[layer].astype(jnp.float32) * lambda_k2[layer].astype(jnp.float32)))
               + lambda_init)
        out_b = _differential_attention(
            qb_h[..., :DIFF_HALF_DIM], kb_h[..., :DIFF_HALF_DIM],
            qb_h[..., DIFF_HALF_DIM:], kb_h[..., DIFF_HALF_DIM:],
            vb_h, lam, lambda_init, subln_g[layer])

        mixed = jnp.concatenate([out_a, out_b], axis=-1)
        h = h + mixed @ w_out[layer]

        hn = _rmsnorm(h, norm2_g[layer])
        h = h + _peer(hn, peer_w_q[layer], peer_sub_keys[layer], peer_u[layer], peer_v[layer])
    return _rmsnorm(h, final_g)
```

```cpp
#include <hip/hip_runtime.h>
#include <cstdio>
#include <cstdint>
#include <cmath>
namespace pg8 {
#define PG8_LAS __attribute__((address_space(3)))
typedef unsigned short bf16_t;
typedef short bf16x8 __attribute__((ext_vector_type(8)));
typedef float f32x4 __attribute__((ext_vector_type(4)));
typedef unsigned u32x4 __attribute__((ext_vector_type(4)));
constexpr int BM = 256, BK = 64, HALF = 128, HTB = HALF * BK * 2  , STAGE_BYTES = 8 * HTB, NXCD = 8, WGM = 8;

__host__ __device__ __forceinline__ int lds_byte(int r, int c) { const int st = (r >> 4) * 2 + (c >> 5), rr = r & 15, cc = c & 31, ob = rr * 64 + cc * 2; return st * 1024 + (ob ^ (((ob >> 9) & 1) << 5)); }
__host__ __device__ __forceinline__ void stage_rc(int b, int& R, int& C) { const int st = b / 1024, sb = b % 1024, swz = sb ^ (((sb >> 9) & 1) << 5); R = (st >> 1) * 16 + swz / 64; C = (st & 1) * 32 + (swz % 64) / 2; }
__host__ __device__ __forceinline__ int perm32(int rho) { const int n = rho >> 4, i = rho & 15; return 8 * (i >> 2) + 4 * n + (i & 3); }

struct Unit { int pm, pn; };
struct Gemm { const bf16_t* A; const bf16_t* Bt; int M, N, K; };

struct StaticOrder {
    int nM, nN, nwg, G, c;
    __host__ __device__ void init(int M, int N, int G_, int c_) { nM = M / BM; nN = N / BM; nwg = nM * nN; G = G_; c = c_; }
    __host__ __device__ bool next(int i, Unit& u) const {
        const long L = (long)i * G + c; if (L >= nwg) return false;
        int wgid = (int)L; { const int q = nwg / NXCD, r = nwg % NXCD, xcd = wgid % NXCD, off = wgid / NXCD; wgid = (xcd < r ? xcd * (q + 1) : r * (q + 1) + (xcd - r) * q) + off; }
        const int nig = WGM * nN, gid = wgid / nig, fm = gid * WGM, gsz = (nM - fm) < WGM ? (nM - fm) : WGM;
        u.pm = fm + ((wgid % nig) % gsz); u.pn = (wgid % nig) / gsz; return true;
    }
    __device__ __forceinline__ void a_ready(const Unit&) const {}
    __device__ __forceinline__ void done(const Unit&) const {}
};

__device__ __forceinline__ unsigned cvt_pk_bf16(float lo, float hi) { unsigned r; asm volatile("v_cvt_pk_bf16_f32 %0, %1, %2" : "=v"(r) : "v"(lo), "v"(hi)); return r; }
typedef float f32x2 __attribute__((ext_vector_type(2)));
__device__ __forceinline__ f32x2 gelu_pk(f32x2 v) {
    const f32x2 av = __builtin_elementwise_abs(v), d = av * 0.2316418882f + 1.0f;
    f32x2 t; t.x = __builtin_amdgcn_rcpf(d.x); t.y = __builtin_amdgcn_rcpf(d.y);
    f32x2 q = t * 0.5307027145f + (-0.7265760135f); q = q * t + 0.7107068705f; q = q * t + (-0.142248368f); q = q * t + 0.127414796f; q = q * t;
    const f32x2 s = (v * v) * (-0.72134752044f);
    f32x2 e; e.x = __builtin_amdgcn_exp2f(s.x); e.y = __builtin_amdgcn_exp2f(s.y);
    const f32x2 m = v * (q * e), r = v - m;
    f32x2 o; o.x = v.x < 0.f ? m.x : r.x; o.y = v.y < 0.f ? m.y : r.y; return o;
}

template <int ACT  > struct EpiBf16 {
    static constexpr bool PERM = true, AFTER_DRAIN = false; static_assert(ACT == 0 || ACT == 1, "EpiBf16: ACT is 0 (none) or 1 (gelu_pk)");
    bf16_t* O; int ldc; const float* bias; int split_cols; size_t split_stride; float scale0;
    __device__ __forceinline__ void operator()(const f32x4 (&acc)[2][2][4][2], const Unit& u, int wr, int wc, int fr, int fq) const {
        const int row0 = u.pm * BM + wr * 64 + fr; int colt = u.pn * BM; bf16_t* base = O;
        float sc = 1.f; if (split_cols) { const int t = colt / split_cols; base += (size_t)t * split_stride; colt -= t * split_cols; if (t == 0) sc = scale0; }
        const int col0 = colt + wc * 32 + 8 * fq, bcol0 = u.pn * BM + wc * 32 + 8 * fq;
        f32x4 bv[2][2];
#pragma unroll
        for (int bj = 0; bj < 2; ++bj)
#pragma unroll
            for (int n = 0; n < 2; ++n) bv[bj][n] = bias ? *(const f32x4*)(bias + bcol0 + bj * HALF + 4 * n) : (f32x4){0.f, 0.f, 0.f, 0.f};
#pragma unroll
        for (int ai = 0; ai < 2; ++ai)
#pragma unroll
            for (int m = 0; m < 4; ++m) { bf16_t* rowp = base + (size_t)(row0 + ai * HALF + m * 16) * ldc + col0;
#pragma unroll
                for (int bj = 0; bj < 2; ++bj) { f32x4 v0 = acc[ai][bj][m][0] + bv[bj][0], v1 = acc[ai][bj][m][1] + bv[bj][1];
                    if (ACT == 1) { f32x2 a = gelu_pk((f32x2){v0[0], v0[1]}), b = gelu_pk((f32x2){v0[2], v0[3]}), c = gelu_pk((f32x2){v1[0], v1[1]}), d = gelu_pk((f32x2){v1[2], v1[3]});
                        v0 = (f32x4){a.x, a.y, b.x, b.y}; v1 = (f32x4){c.x, c.y, d.x, d.y}; }
                    v0 = v0 * sc; v1 = v1 * sc; u32x4 w; w.x = cvt_pk_bf16(v0[0], v0[1]); w.y = cvt_pk_bf16(v0[2], v0[3]); w.z = cvt_pk_bf16(v1[0], v1[1]); w.w = cvt_pk_bf16(v1[2], v1[3]);
                    *(u32x4*)(rowp + bj * HALF) = w; } }
    }
};
template <class Epi, class Sched, bool ALIGN_EPI = false, bool SP2 = false>
__device__ __forceinline__ void gemm_phase(PG8_LAS unsigned char* lds, const Gemm g, const Sched& S, const Epi& E) {
    const int tid = threadIdx.x, wid = __builtin_amdgcn_readfirstlane(tid >> 6), lane = tid & 63, wr = wid >> 2, wc = wid & 3, fr = lane & 15, fq = lane >> 4;
    const int K = g.K, nt = K / BK;
    unsigned voffA[2], voffB[2];
#pragma unroll
    for (int i = 0; i < 2; ++i) { int R, C; stage_rc(tid * 16 + i * 8192, R, C); const int Rb = Epi::PERM ? ((R & ~31) + perm32(R & 31)) : R;
        voffA[i] = (unsigned)(R * K + C) * 2u; voffB[i] = (unsigned)(Rb * K + C) * 2u; }
    const size_t kstep = (size_t)(BK * 2);
    const size_t hstep = (size_t)HALF * K * 2;
    const size_t tstep = 2 * hstep;
    const unsigned ldsw = (unsigned)wid * 1024u;
    const int aoff = lds_byte(wr * 64 + fr, fq * 8), boff = lds_byte(wc * 32 + fr, fq * 8);
#define PG8_SA(b, h) (((b) * 2 + (h)) * HTB)
#define PG8_SB(b, h) ((4 + (b) * 2 + (h)) * HTB)
#define PG8_STAGE(bufoff, gbase, voff) do { _Pragma("unroll") for (int _i = 0; _i < 2; ++_i) \
        __builtin_amdgcn_global_load_lds((const unsigned*)((const char*)(gbase) + (voff)[_i]), (PG8_LAS unsigned*)(lds + (bufoff) + ldsw + _i * 8192), 16, 0, 0); } while (0)
#define PG8_LDA(dst, b, h) do { _Pragma("unroll") for (int m = 0; m < 4; ++m) _Pragma("unroll") for (int k = 0; k < 2; ++k) dst[m][k] = *(const PG8_LAS bf16x8*)(lds + PG8_SA(b, h) + aoff + m * 2048 + k * 1024); } while (0)
#define PG8_LDB(dst, b, h) do { _Pragma("unroll") for (int n = 0; n < 2; ++n) _Pragma("unroll") for (int k = 0; k < 2; ++k) dst[n][k] = *(const PG8_LAS bf16x8*)(lds + PG8_SB(b, h) + boff + n * 2048 + k * 1024); } while (0)
#define PG8_MMA(ai, bj, At, Bt) do { __builtin_amdgcn_s_setprio(1); _Pragma("unroll") for (int m = 0; m < 4; ++m) _Pragma("unroll") for (int n = 0; n < 2; ++n) _Pragma("unroll") for (int k = 0; k < 2; ++k) \
        acc[ai][bj][m][n] = __builtin_amdgcn_mfma_f32_16x16x32_bf16(Bt[n][k], At[m][k], acc[ai][bj][m][n], 0, 0, 0); __builtin_amdgcn_s_setprio(0); } while (0)
#define PG8_WAIT_V(n) asm volatile("s_waitcnt vmcnt(" #n ")" ::: "memory")
#define PG8_WAIT_L(n) asm volatile("s_waitcnt lgkmcnt(" #n ")" ::: "memory")
#define PG8_BAR __builtin_amdgcn_s_barrier()
#define PG8_SCHED __builtin_amdgcn_sched_barrier(0)
    Unit cur, nxt; int ui = 0;
    if (!S.next(0, cur)) return;
    f32x4 acc[2][2][4][2];
#pragma unroll
    for (int a = 0; a < 2; ++a)
#pragma unroll
        for (int b = 0; b < 2; ++b)
#pragma unroll
            for (int m = 0; m < 4; ++m)
#pragma unroll
                for (int n = 0; n < 2; ++n) acc[a][b][m][n] = (f32x4){0.f, 0.f, 0.f, 0.f};
    bf16x8 At[4][2], B0[2][2], B1[2][2];
    const char* cA = (const char*)g.A + (size_t)cur.pm * tstep; const char* cB = (const char*)g.Bt + (size_t)cur.pn * tstep;
    S.a_ready(cur);
    if constexpr (SP2) {
        PG8_STAGE(PG8_SB(0, 0), cB, voffB); PG8_STAGE(PG8_SB(0, 1), cB + hstep, voffB); PG8_STAGE(PG8_SA(0, 0), cA, voffA); PG8_STAGE(PG8_SA(0, 1), cA + hstep, voffA);
        if (wr == 1) PG8_BAR;
        PG8_WAIT_V(2); PG8_BAR;
        PG8_STAGE(PG8_SB(1, 0), cB + kstep, voffB); PG8_STAGE(PG8_SA(1, 0), cA + kstep, voffA); PG8_STAGE(PG8_SB(1, 1), cB + hstep + kstep, voffB);
        PG8_WAIT_V(6); PG8_BAR;
    } else {
        PG8_STAGE(PG8_SB(0, 0), cB, voffB); PG8_STAGE(PG8_SA(0, 0), cA, voffA); PG8_STAGE(PG8_SB(0, 1), cB + hstep, voffB); PG8_STAGE(PG8_SA(0, 1), cA + hstep, voffA);
        if (wr == 1) PG8_BAR;
        PG8_WAIT_V(4); PG8_BAR;
        PG8_STAGE(PG8_SB(1, 0), cB + kstep, voffB); PG8_STAGE(PG8_SA(1, 0), cA + kstep, voffA); PG8_STAGE(PG8_SB(1, 1), cB + hstep + kstep, voffB);
        PG8_WAIT_V(6); PG8_BAR;
    }
    for (;;) {
        const bool has_next = S.next(ui + 1, nxt);
        const char* nA = has_next ? (const char*)g.A + (size_t)nxt.pm * tstep : cA; const char* nB = has_next ? (const char*)g.Bt + (size_t)nxt.pn * tstep : cB;
        for (int t = 0; t < nt; t += 2) {
            const bool last = (t == nt - 2);
            const char* a1 = cA + (size_t)(t + 1) * kstep;
            const char* a2 = last ? nA : cA + (size_t)(t + 2) * kstep; const char* b2 = last ? nB : cB + (size_t)(t + 2) * kstep;
            const char* a3 = a2 + kstep; const char* b3 = b2 + kstep;
            if (last && has_next) S.a_ready(nxt);
            if constexpr (SP2) {
            PG8_LDB(B0, 0, 0); PG8_LDB(B1, 0, 1); PG8_SCHED; PG8_LDA(At, 0, 0); PG8_STAGE(PG8_SA(1, 1), a1 + hstep, voffA);
            PG8_WAIT_V(8); PG8_WAIT_L(0); PG8_BAR; PG8_MMA(0, 0, At, B0); PG8_MMA(0, 1, At, B1); PG8_BAR; PG8_SCHED;
            PG8_LDA(At, 0, 1); PG8_STAGE(PG8_SB(0, 0), b2, voffB); PG8_STAGE(PG8_SB(0, 1), b2 + hstep, voffB); PG8_STAGE(PG8_SA(0, 0), a2, voffA);
            PG8_WAIT_V(8); PG8_WAIT_L(0); PG8_BAR; PG8_MMA(1, 0, At, B0); PG8_MMA(1, 1, At, B1); PG8_BAR; PG8_SCHED;
            PG8_LDB(B0, 1, 0); PG8_LDB(B1, 1, 1); PG8_SCHED; PG8_LDA(At, 1, 0); PG8_STAGE(PG8_SA(0, 1), a2 + hstep, voffA);
            PG8_WAIT_V(8); PG8_WAIT_L(0); PG8_BAR; PG8_MMA(0, 0, At, B0); PG8_MMA(0, 1, At, B1); PG8_BAR; PG8_SCHED;
            PG8_LDA(At, 1, 1); PG8_STAGE(PG8_SB(1, 0), b3, voffB); PG8_STAGE(PG8_SB(1, 1), b3 + hstep, voffB); PG8_STAGE(PG8_SA(1, 0), a3, voffA);
            PG8_WAIT_V(8); PG8_WAIT_L(0); PG8_BAR; PG8_MMA(1, 0, At, B0); PG8_MMA(1, 1, At, B1); PG8_BAR; PG8_SCHED;
            } else {
            PG8_LDB(B0, 0, 0); PG8_SCHED; PG8_LDA(At, 0, 0); PG8_STAGE(PG8_SA(1, 1), a1 + hstep, voffA);
            PG8_WAIT_L(8); PG8_BAR; PG8_WAIT_L(0); PG8_MMA(0, 0, At, B0); PG8_BAR; PG8_SCHED;
            PG8_LDB(B1, 0, 1); PG8_STAGE(PG8_SB(0, 0), b2, voffB);
            PG8_BAR; PG8_WAIT_L(0); PG8_MMA(0, 1, At, B1); PG8_BAR;
            PG8_LDA(At, 0, 1); PG8_STAGE(PG8_SA(0, 0), a2, voffA);
            PG8_BAR; PG8_WAIT_L(0); PG8_MMA(1, 0, At, B0); PG8_BAR; PG8_SCHED;
            PG8_STAGE(PG8_SB(0, 1), b2 + hstep, voffB);
            PG8_WAIT_V(6); PG8_BAR; PG8_MMA(1, 1, At, B1); PG8_BAR;
            PG8_LDB(B0, 1, 0); PG8_SCHED; PG8_LDA(At, 1, 0); PG8_STAGE(PG8_SA(0, 1), a2 + hstep, voffA);
            PG8_WAIT_L(8); PG8_BAR; PG8_WAIT_L(0); PG8_MMA(0, 0, At, B0); PG8_BAR; PG8_SCHED;
            PG8_LDB(B1, 1, 1); PG8_STAGE(PG8_SB(1, 0), b3, voffB);
            PG8_BAR; PG8_WAIT_L(0); PG8_MMA(0, 1, At, B1); PG8_BAR;
            PG8_LDA(At, 1, 1); PG8_STAGE(PG8_SA(1, 0), a3, voffA);
            PG8_BAR; PG8_WAIT_L(0); PG8_MMA(1, 0, At, B0); PG8_BAR; PG8_SCHED;
            PG8_STAGE(PG8_SB(1, 1), b3 + hstep, voffB);
            PG8_WAIT_V(6); PG8_BAR; PG8_MMA(1, 1, At, B1); PG8_BAR;
            }
        }
        if constexpr (ALIGN_EPI) { if (wr == 0) PG8_BAR; }
        if constexpr (!Epi::AFTER_DRAIN) { E(acc, cur, wr, wc, fr, fq); S.done(cur); }
        if (!has_next) break;
#pragma unroll
        for (int a = 0; a < 2; ++a)
#pragma unroll
            for (int b = 0; b < 2; ++b)
#pragma unroll
                for (int m = 0; m < 4; ++m)
#pragma unroll
                    for (int n = 0; n < 2; ++n) acc[a][b][m][n] = (f32x4){0.f, 0.f, 0.f, 0.f};
        cur = nxt; cA = nA; cB = nB; ++ui;
        if constexpr (ALIGN_EPI) { if (wr == 1) PG8_BAR; }
    }
    PG8_WAIT_V(0);
    if constexpr (!ALIGN_EPI) { if (wr == 0) PG8_BAR; }
    PG8_BAR;
    if constexpr (Epi::AFTER_DRAIN) { E.fused(acc, cur, wr, wc, fr, fq, lds, wid, lane); S.done(cur); }
#undef PG8_SA
#undef PG8_SB
#undef PG8_STAGE
#undef PG8_LDA
#undef PG8_LDB
#undef PG8_MMA
#undef PG8_WAIT_V
#undef PG8_WAIT_L
#undef PG8_BAR
#undef PG8_SCHED
}
}

constexpr int BATCH = 16, SEQ = 4096, D = 1024, NTOK = BATCH * SEQ;
constexpr int FH = 8, DH = 4, HD = 64;
constexpr int NPROJ = 3072, IN_COLS = 3080;
constexpr int PH = 8, NKEY = 128, TOPK = 16, PQ = 2048, NEXP = 16384;
constexpr float RMS_EPS = 1e-6f, LOG2E = 1.4426950408889634f, C2 = 0.125f * LOG2E;
constexpr float LAMBDA_INIT = 0.2f;
constexpr int COL_QA = 0, COL_KA = 512, COL_VA = 1024, COL_QB = 1536, COL_KB = 2048, COL_VB = 2560;

typedef unsigned short bf16_t;
typedef float f32x4v __attribute__((ext_vector_type(4)));

constexpr size_t MiB = 1u << 20;
constexpr size_t WS_CTL = 0;
constexpr size_t WS_WIN = 2 * MiB;
constexpr size_t WS_WOUT = 8 * MiB;
constexpr size_t WS_WQ = 10 * MiB;
constexpr size_t WS_LOGF = 16 * MiB;
constexpr size_t WS_CUM = 18 * MiB;
constexpr size_t WS_XN = 96 * MiB;
constexpr size_t WS_PROJ = 224 * MiB;
constexpr size_t WS_Y = 224 * MiB;
constexpr size_t WS_QP = 352 * MiB;
constexpr size_t WS_MIXED = 608 * MiB;
constexpr size_t WS_EIDX = 608 * MiB;
constexpr size_t WS_GATE = 640 * MiB;
constexpr size_t WS_END = 736 * MiB;

__device__ __forceinline__ unsigned f2bf(float f) { unsigned u = __builtin_bit_cast(unsigned, f); return (u + 0x7fffu + ((u >> 16) & 1u)) >> 16; }
__device__ __forceinline__ unsigned pk2(float lo, float hi) { return f2bf(lo) | (f2bf(hi) << 16); }
__device__ __forceinline__ float bf2f(unsigned short b) { return __builtin_bit_cast(float, (unsigned)b << 16); }
__device__ __forceinline__ float bflo(unsigned w) { return __builtin_bit_cast(float, w << 16); }
__device__ __forceinline__ float bfhi(unsigned w) { return __builtin_bit_cast(float, w & 0xffff0000u); }
__device__ __forceinline__ float wave_sum(float v) {
#pragma unroll
    for (int o = 1; o < 64; o <<= 1) v += __shfl_xor(v, o);
    return v;
}

template <int MODE> __global__ void __launch_bounds__(256) prep_wt(const float* __restrict__ W, int ldw, bf16_t* __restrict__ out, int K) {
    __shared__ float t[32][33];
    const int n0 = blockIdx.x * 32, k0 = blockIdx.y * 32, tx = threadIdx.x & 31, ty = threadIdx.x >> 5;
    for (int i = ty; i < 32; i += 8) { const int k = k0 + i, n = n0 + tx; const int src = (MODE == 1 && n >= 1536) ? n + 8 : n; t[i][tx] = W[(size_t)k * ldw + src]; }
    __syncthreads();
    for (int i = ty; i < 32; i += 8) { const int n = n0 + i, k = k0 + tx; float s = 1.f; if (MODE == 1 && (n < 512 || (n >= 1536 && n < 2048))) s = C2; out[(size_t)n * K + k] = (bf16_t)f2bf(t[tx][i] * s); }
}

__global__ void __launch_bounds__(256) rms1_gates(const float* __restrict__ x, const float* __restrict__ g1, const float* __restrict__ w_in, const float* __restrict__ b_f,
                                                  bf16_t* __restrict__ XN, float* __restrict__ LOGF) {
    const int row = (blockIdx.x * 256 + threadIdx.x) >> 6, lane = threadIdx.x & 63;
    const f32x4v* xr = (const f32x4v*)(x + (size_t)row * D) + lane;
    f32x4v v[4]; float ss = 0.f;
#pragma unroll
    for (int j = 0; j < 4; ++j) { v[j] = xr[64 * j]; ss += (v[j].x * v[j].x + v[j].y * v[j].y) + (v[j].z * v[j].z + v[j].w * v[j].w); }
    ss = wave_sum(ss);
    const float rstd = rsqrtf(ss * (1.f / D) + RMS_EPS);
    float gate[8];
#pragma unroll
    for (int q = 0; q < 8; ++q) gate[q] = 0.f;
    unsigned long long* o8 = (unsigned long long*)(XN + (size_t)row * D) + lane;
#pragma unroll
    for (int j = 0; j < 4; ++j) {
        const f32x4v g = ((const f32x4v*)g1)[lane + 64 * j];
        v[j] = v[j] * rstd * g;
        o8[64 * j] = (unsigned long long)pk2(v[j].x, v[j].y) | ((unsigned long long)pk2(v[j].z, v[j].w) << 32);
#pragma unroll
        for (int e = 0; e < 4; ++e) {
            const int k = 4 * lane + 256 * j + e;
            const f32x4v* wr = (const f32x4v*)(w_in + (size_t)k * IN_COLS + 1536);
            const f32x4v w0 = wr[0], w1 = wr[1]; const float xe = v[j][e];
            gate[0] += xe * w0.x; gate[1] += xe * w0.y; gate[2] += xe * w0.z; gate[3] += xe * w0.w;
            gate[4] += xe * w1.x; gate[5] += xe * w1.y; gate[6] += xe * w1.z; gate[7] += xe * w1.w;
        }
    }
#pragma unroll
    for (int q = 0; q < 8; ++q) gate[q] = wave_sum(gate[q]);
    float gv = gate[0];
#pragma unroll
    for (int q = 1; q < 8; ++q) if (lane == q) gv = gate[q];
    if (lane < 8) {
        const float z = gv + b_f[lane];
        const float ls = fminf(z, 0.f) - log1pf(expf(-fabsf(z)));
        const int b = row / SEQ, t = row % SEQ;
        LOGF[((size_t)b * FH + lane) * SEQ + t] = ls;
    }
}

__global__ void __launch_bounds__(64) cumsum_k(const float* __restrict__ LOGF, float* __restrict__ CUM) {
    const int bh = blockIdx.x, lane = threadIdx.x;
    const float* src = LOGF + (size_t)bh * SEQ + lane * 64; float* dst = CUM + (size_t)bh * SEQ + lane * 64;
    float loc[64]; float run = 0.f;
#pragma unroll
    for (int i = 0; i < 64; ++i) { run += src[i]; loc[i] = run; }
    float incl = run;
#pragma unroll
    for (int o = 1; o < 64; o <<= 1) { const float t = __shfl_up(incl, o); if (lane >= o) incl += t; }
    const float excl = incl - run;
#pragma unroll
    for (int i = 0; i < 64; ++i) dst[i] = loc[i] + excl;
}

struct GemmArgs { const bf16_t* A; const bf16_t* Bt; bf16_t* O; int M, N, K, ldc; };
__global__ void __launch_bounds__(512, 2) gemm_kernel(GemmArgs a) {
    extern __shared__ __attribute__((aligned(16))) unsigned char lds[];
    pg8::Gemm g{a.A, a.Bt, a.M, a.N, a.K};
    pg8::StaticOrder S; S.init(a.M, a.N, (int)gridDim.x, (int)blockIdx.x);
    pg8::EpiBf16<0> E{a.O, a.ldc, nullptr, 0, 0, 1.f};
    pg8::gemm_phase<pg8::EpiBf16<0>, pg8::StaticOrder, true, true>((PG8_LAS unsigned char*)lds, g, S, E);
}

template <int MODE> __global__ void __launch_bounds__(256) attn_naive(const bf16_t* __restrict__ PROJ, const float* __restrict__ CUM, bf16_t* __restrict__ MIXED, float* __restrict__ DTMP) {
    __shared__ float Ks[64][64]; __shared__ float Vs[64][64]; __shared__ float Cs[64];
    const int qb = blockIdx.x, vh = blockIdx.y, b = blockIdx.z, tid = threadIdx.x;
    const int t = qb * 256 + tid; const size_t rowbase = (size_t)b * SEQ;
    int qcol, kcol, vcol; float slope2 = 0.f; const float* cum = nullptr;
    if (MODE == 0) { qcol = COL_QA + vh * 64; kcol = COL_KA + vh * 64; vcol = COL_VA + vh * 64; cum = CUM + ((size_t)b * FH + vh) * SEQ; }
    else { const int h = vh >> 2, m = (vh >> 1) & 1, half = vh & 1; qcol = COL_QB + h * 128 + m * 64; kcol = COL_KB + h * 128 + m * 64; vcol = COL_VB + h * 128 + half * 64;
           slope2 = exp2f(-2.f * (float)(h + 1)) * LOG2E; }
    float q[64], o[64];
    { const uint4* qp = (const uint4*)(PROJ + (rowbase + t) * NPROJ + qcol);
#pragma unroll
      for (int i = 0; i < 8; ++i) { const uint4 w = qp[i]; q[8 * i + 0] = bflo(w.x); q[8 * i + 1] = bfhi(w.x); q[8 * i + 2] = bflo(w.y); q[8 * i + 3] = bfhi(w.y); q[8 * i + 4] = bflo(w.z); q[8 * i + 5] = bfhi(w.z); q[8 * i + 6] = bflo(w.w); q[8 * i + 7] = bfhi(w.w); } }
#pragma unroll
    for (int d = 0; d < 64; ++d) o[d] = 0.f;
    float m = -INFINITY, l = 0.f;
    const float cq = (MODE == 0) ? cum[t] * LOG2E : 0.f;
    const int ntile = 4 * qb + 4;
    for (int j = 0; j < ntile; ++j) {
        __syncthreads();
        { const int r = tid >> 2, c0 = (tid & 3) * 16; const size_t grow = (rowbase + 64 * j + r) * NPROJ;
          const uint4* kp = (const uint4*)(PROJ + grow + kcol + c0); const uint4* vp = (const uint4*)(PROJ + grow + vcol + c0);
#pragma unroll
          for (int i = 0; i < 2; ++i) { const uint4 w = kp[i]; float* d = &Ks[r][c0 + 8 * i]; d[0] = bflo(w.x); d[1] = bfhi(w.x); d[2] = bflo(w.y); d[3] = bfhi(w.y); d[4] = bflo(w.z); d[5] = bfhi(w.z); d[6] = bflo(w.w); d[7] = bfhi(w.w);
                                        const uint4 u = vp[i]; float* e = &Vs[r][c0 + 8 * i]; e[0] = bflo(u.x); e[1] = bfhi(u.x); e[2] = bflo(u.y); e[3] = bfhi(u.y); e[4] = bflo(u.z); e[5] = bfhi(u.z); e[6] = bflo(u.w); e[7] = bfhi(u.w); }
          if (MODE == 0 && tid < 64) Cs[tid] = cum[64 * j + tid] * LOG2E; }
        __syncthreads();
        for (int kk = 0; kk < 64; ++kk) {
            const int s = 64 * j + kk;
            const bool valid = (MODE == 0) ? (s <= t) : ((s >> 6) <= (t >> 6));
            float dot = 0.f;
#pragma unroll
            for (int d = 0; d < 64; ++d) dot += q[d] * Ks[kk][d];
            const float bias = (MODE == 0) ? (cq - Cs[kk]) : (-slope2 * fabsf((float)(t - s)));
            const float xv = dot + bias;
            if (valid) {
                if (xv > m) { const float al = exp2f(m - xv); l *= al;
#pragma unroll
                    for (int d = 0; d < 64; ++d) o[d] *= al;
                    m = xv; }
                const float p = exp2f(xv - m); l += p;
#pragma unroll
                for (int d = 0; d < 64; ++d) o[d] += p * Vs[kk][d];
            }
        }
    }
    const float rl = 1.f / l;
    if (MODE == 0) { unsigned* op = (unsigned*)(MIXED + (rowbase + t) * D + vh * 64);
#pragma unroll
        for (int d = 0; d < 32; ++d) op[d] = pk2(o[2 * d] * rl, o[2 * d + 1] * rl); }
    else { float* op = DTMP + (rowbase + t) * 1024 + vh * 64;
#pragma unroll
        for (int d = 0; d < 64; ++d) op[d] = o[d] * rl; }
}

__global__ void __launch_bounds__(256) diff_combine(const float* __restrict__ DTMP, const float* __restrict__ lq1, const float* __restrict__ lk1, const float* __restrict__ lq2, const float* __restrict__ lk2,
                                                    const float* __restrict__ subg, bf16_t* __restrict__ MIXED) {
    const int gw = (blockIdx.x * 256 + threadIdx.x) >> 6, lane = threadIdx.x & 63;
    const int tok = gw >> 2, h = gw & 3;
    const float lam = expf(wave_sum(lq1[lane] * lk1[lane])) - expf(wave_sum(lq2[lane] * lk2[lane])) + LAMBDA_INIT;
    const float* base = DTMP + (size_t)tok * 1024 + h * 256;
    const float o0 = base[0 * 64 + lane] - lam * base[2 * 64 + lane];
    const float o1 = base[1 * 64 + lane] - lam * base[3 * 64 + lane];
    const float ss = wave_sum(o0 * o0 + o1 * o1);
    const float r = rsqrtf(ss * (1.f / 128.f) + RMS_EPS) * (1.f - LAMBDA_INIT);
    bf16_t* op = MIXED + (size_t)tok * D + 512 + h * 128;
    op[lane] = (bf16_t)f2bf(o0 * r * subg[lane]); op[64 + lane] = (bf16_t)f2bf(o1 * r * subg[64 + lane]);
}

__global__ void __launch_bounds__(256) resid_rms2(const float* __restrict__ x, const bf16_t* __restrict__ Y, const float* __restrict__ g2, float* __restrict__ H, bf16_t* __restrict__ HN) {
    const int row = (blockIdx.x * 256 + threadIdx.x) >> 6, lane = threadIdx.x & 63;
    const f32x4v* xr = (const f32x4v*)(x + (size_t)row * D) + lane;
    const uint2* yr = (const uint2*)(Y + (size_t)row * D) + lane;
    f32x4v* hr = (f32x4v*)(H + (size_t)row * D) + lane;
    f32x4v v[4]; float ss = 0.f;
#pragma unroll
    for (int j = 0; j < 4; ++j) { const uint2 y = yr[64 * j]; v[j] = xr[64 * j]; v[j].x += bflo(y.x); v[j].y += bfhi(y.x); v[j].z += bflo(y.y); v[j].w += bfhi(y.y);
        hr[64 * j] = v[j]; ss += (v[j].x * v[j].x + v[j].y * v[j].y) + (v[j].z * v[j].z + v[j].w * v[j].w); }
    ss = wave_sum(ss);
    const float rstd = rsqrtf(ss * (1.f / D) + RMS_EPS);
    unsigned long long* o8 = (unsigned long long*)(HN + (size_t)row * D) + lane;
#pragma unroll
    for (int j = 0; j < 4; ++j) { const f32x4v g = ((const f32x4v*)g2)[lane + 64 * j]; const f32x4v w = v[j] * rstd * g;
        o8[64 * j] = (unsigned long long)pk2(w.x, w.y) | ((unsigned long long)pk2(w.z, w.w) << 32); }
}

__global__ void __launch_bounds__(256) peer_route(const bf16_t* __restrict__ QP, const float* __restrict__ subk, int* __restrict__ EIDX, float* __restrict__ GATE) {
    __shared__ float qs[4][256];
    const int gw = (blockIdx.x * 256 + threadIdx.x) >> 6, lane = threadIdx.x & 63, wv = threadIdx.x >> 6;
    const int tok = gw >> 3, h = gw & 7;
    { const uint2 raw = *((const uint2*)(QP + (size_t)tok * PQ + h * 256) + lane);
      qs[wv][4 * lane + 0] = bflo(raw.x); qs[wv][4 * lane + 1] = bfhi(raw.x); qs[wv][4 * lane + 2] = bflo(raw.y); qs[wv][4 * lane + 3] = bfhi(raw.y); }
    __syncthreads();
    float sc[2][2];
#pragma unroll
    for (int p = 0; p < 2; ++p)
#pragma unroll
        for (int w = 0; w < 2; ++w) {
            const int key = lane + 64 * w;
            const f32x4v* kr = (const f32x4v*)(subk + (((size_t)h * 2 + p) * NKEY + key) * 128);
            const f32x4v* qv = (const f32x4v*)(&qs[wv][p * 128]);
            float acc = 0.f;
#pragma unroll 8
            for (int d = 0; d < 32; ++d) { const f32x4v a = kr[d], c = qv[d]; acc += (a.x * c.x + a.y * c.y) + (a.z * c.z + a.w * c.w); }
            sc[p][w] = acc;
        }
    float ts[2]; int ti[2]; ts[0] = ts[1] = 0.f; ti[0] = ti[1] = 0;
#pragma unroll
    for (int p = 0; p < 2; ++p) {
        float v0 = sc[p][0], v1 = sc[p][1];
        for (int r = 0; r < TOPK; ++r) {
            float bv; int bi; if (v1 > v0) { bv = v1; bi = lane + 64; } else { bv = v0; bi = lane; }
#pragma unroll
            for (int off = 32; off >= 1; off >>= 1) { const float ov = __shfl_xor(bv, off); const int oi = __shfl_xor(bi, off); if (ov > bv || (ov == bv && oi < bi)) { bv = ov; bi = oi; } }
            if (lane == r) { ts[p] = bv; ti[p] = bi; }
            if (bi == lane) v0 = -INFINITY; if (bi == lane + 64) v1 = -INFINITY;
        }
    }
    float cv[4];
#pragma unroll
    for (int w = 0; w < 4; ++w) { const int c = lane + 64 * w; cv[w] = __shfl(ts[0], c >> 4) + __shfl(ts[1], c & 15); }
    float fs = 0.f; int fc = 0;
    for (int r = 0; r < TOPK; ++r) {
        float bv = cv[0]; int bi = lane;
#pragma unroll
        for (int w = 1; w < 4; ++w) if (cv[w] > bv) { bv = cv[w]; bi = lane + 64 * w; }
#pragma unroll
        for (int off = 32; off >= 1; off >>= 1) { const float ov = __shfl_xor(bv, off); const int oi = __shfl_xor(bi, off); if (ov > bv || (ov == bv && oi < bi)) { bv = ov; bi = oi; } }
        if (lane == r) { fs = bv; fc = bi; }
#pragma unroll
        for (int w = 0; w < 4; ++w) if (bi == lane + 64 * w) cv[w] = -INFINITY;
    }
    const int ia = __shfl(ti[0], fc >> 4), ib = __shfl(ti[1], fc & 15);
    const float mx = __shfl(fs, 0);
    const float e = (lane < TOPK) ? expf(fs - mx) : 0.f;
    const float sum = wave_sum(e);
    if (lane < TOPK) { EIDX[(size_t)gw * TOPK + lane] = ia * NKEY + ib; GATE[(size_t)gw * TOPK + lane] = e / sum; }
}

__global__ void __launch_bounds__(256) peer_experts(const bf16_t* __restrict__ HN, const int* __restrict__ EIDX, const float* __restrict__ GATE, const float* __restrict__ U, const float* __restrict__ V,
                                                    const float* __restrict__ fg, float* __restrict__ H  ) {
    const int tok = (blockIdx.x * 256 + threadIdx.x) >> 6, lane = threadIdx.x & 63;
    f32x4v xv[4], acc[4];
    { const uint2* hr = (const uint2*)(HN + (size_t)tok * D) + lane;
#pragma unroll
      for (int j = 0; j < 4; ++j) { const uint2 y = hr[64 * j]; xv[j] = (f32x4v){bflo(y.x), bfhi(y.x), bflo(y.y), bfhi(y.y)}; acc[j] = (f32x4v){0.f, 0.f, 0.f, 0.f}; } }
    for (int hh = 0; hh < PH; ++hh) {
        const int el = (lane < TOPK) ? EIDX[((size_t)tok * PH + hh) * TOPK + lane] : 0;
        const float gl = (lane < TOPK) ? GATE[((size_t)tok * PH + hh) * TOPK + lane] : 0.f;
        for (int r = 0; r < TOPK; ++r) {
            const int e = __shfl(el, r); const float g = __shfl(gl, r);
            const f32x4v* ur = (const f32x4v*)(U + (size_t)e * D) + lane;
            const f32x4v* vr = (const f32x4v*)(V + (size_t)e * D) + lane;
            float dot = 0.f;
#pragma unroll
            for (int j = 0; j < 4; ++j) { const f32x4v u = ur[64 * j]; dot += (u.x * xv[j].x + u.y * xv[j].y) + (u.z * xv[j].z + u.w * xv[j].w); }
            dot = wave_sum(dot);
            const float hid = 0.5f * dot * (1.f + erff(dot * 0.70710678118654752f)) * g;
#pragma unroll
            for (int j = 0; j < 4; ++j) acc[j] += hid * vr[64 * j];
        }
    }
    f32x4v* hr = (f32x4v*)(H + (size_t)tok * D) + lane; float ss = 0.f;
#pragma unroll
    for (int j = 0; j < 4; ++j) { acc[j] += hr[64 * j]; ss += (acc[j].x * acc[j].x + acc[j].y * acc[j].y) + (acc[j].z * acc[j].z + acc[j].w * acc[j].w); }
    ss = wave_sum(ss);
    const float rstd = rsqrtf(ss * (1.f / D) + RMS_EPS);
#pragma unroll
    for (int j = 0; j < 4; ++j) hr[64 * j] = acc[j] * rstd * ((const f32x4v*)fg)[lane + 64 * j];
}

extern "C" void kernel_launch(void* const* d_in, const int* in_sizes, int n_in, void* d_out, int out_size, void* d_ws, size_t ws_size, hipStream_t stream) {
    static int ok = 0;
    if (ok == 0) {
        if (n_in != 16 || in_sizes[0] != NTOK * D || out_size != NTOK * D || ws_size < WS_END) { fprintf(stderr, "kernel_launch: unexpected shapes (n_in %d in0 %d out %d ws %zu)\n", n_in, in_sizes[0], out_size, ws_size); ok = -1; return; }
        if (hipFuncSetAttribute((const void*)gemm_kernel, hipFuncAttributeMaxDynamicSharedMemorySize, pg8::STAGE_BYTES) != hipSuccess) { fprintf(stderr, "hipFuncSetAttribute failed\n"); ok = -1; return; }
        ok = 1;
    }
    if (ok < 0) return;
    const float* x = (const float*)d_in[0]; const float* g1 = (const float*)d_in[1]; const float* w_in = (const float*)d_in[2]; const float* b_f = (const float*)d_in[3];
    const float* lq1 = (const float*)d_in[4]; const float* lk1 = (const float*)d_in[5]; const float* lq2 = (const float*)d_in[6]; const float* lk2 = (const float*)d_in[7];
    const float* subg = (const float*)d_in[8]; const float* w_out = (const float*)d_in[9]; const float* g2 = (const float*)d_in[10]; const float* w_q = (const float*)d_in[11];
    const float* subk = (const float*)d_in[12]; const float* U = (const float*)d_in[13]; const float* V = (const float*)d_in[14]; const float* fg = (const float*)d_in[15];
    unsigned char* ws = (unsigned char*)d_ws; float* out = (float*)d_out;
    bf16_t* WIN = (bf16_t*)(ws + WS_WIN); bf16_t* WOUT = (bf16_t*)(ws + WS_WOUT); bf16_t* WQ = (bf16_t*)(ws + WS_WQ);
    float* LOGF = (float*)(ws + WS_LOGF); float* CUM = (float*)(ws + WS_CUM);
    bf16_t* XN = (bf16_t*)(ws + WS_XN); bf16_t* PROJ = (bf16_t*)(ws + WS_PROJ); bf16_t* Y = (bf16_t*)(ws + WS_Y); bf16_t* QP = (bf16_t*)(ws + WS_QP);
    bf16_t* MIXED = (bf16_t*)(ws + WS_MIXED); int* EIDX = (int*)(ws + WS_EIDX); float* GATE = (float*)(ws + WS_GATE);

    prep_wt<1><<<dim3(NPROJ / 32, D / 32), 256, 0, stream>>>(w_in, IN_COLS, WIN, D);
    prep_wt<0><<<dim3(D / 32, D / 32), 256, 0, stream>>>(w_out, D, WOUT, D);
    prep_wt<0><<<dim3(PQ / 32, D / 32), 256, 0, stream>>>(w_q, PQ, WQ, D);
    rms1_gates<<<NTOK / 4, 256, 0, stream>>>(x, g1, w_in, b_f, XN, LOGF);
    cumsum_k<<<BATCH * FH, 64, 0, stream>>>(LOGF, CUM);
    { GemmArgs a{}; a.A = XN; a.Bt = WIN; a.O = PROJ; a.M = NTOK; a.N = NPROJ; a.K = D; a.ldc = NPROJ; gemm_kernel<<<256, 512, pg8::STAGE_BYTES, stream>>>(a); }
    attn_naive<0><<<dim3(SEQ / 256, FH, BATCH), 256, 0, stream>>>(PROJ, CUM, MIXED, out);
    attn_naive<1><<<dim3(SEQ / 256, 16, BATCH), 256, 0, stream>>>(PROJ, CUM, MIXED, out);
    diff_combine<<<NTOK * DH / 4, 256, 0, stream>>>(out, lq1, lk1, lq2, lk2, subg, MIXED);
    { GemmArgs a{}; a.A = MIXED; a.Bt = WOUT; a.O = Y; a.M = NTOK; a.N = D; a.K = D; a.ldc = D; gemm_kernel<<<256, 512, pg8::STAGE_BYTES, stream>>>(a); }
    resid_rms2<<<NTOK / 4, 256, 0, stream>>>(x, Y, g2, out, XN);
    { GemmArgs a{}; a.A = XN; a.Bt = WQ; a.O = QP; a.M = NTOK; a.N = PQ; a.K = D; a.ldc = PQ; gemm_kernel<<<256, 512, pg8::STAGE_BYTES, stream>>>(a); }
    peer_route<<<NTOK * PH / 4, 256, 0, stream>>>(QP, subk, EIDX, GATE);
    peer_experts<<<NTOK / 4, 256, 0, stream>>>(XN, EIDX, GATE, U, V, fg, out);
}
```

```cpp
#include <hip/hip_runtime.h>
#include <hip/hip_cooperative_groups.h>
#include <cstdio>
#include <cstdint>
#include <cmath>
namespace pg8 {
#define PG8_LAS __attribute__((address_space(3)))
typedef unsigned short bf16_t;
typedef short bf16x8 __attribute__((ext_vector_type(8)));
typedef float f32x4 __attribute__((ext_vector_type(4)));
typedef unsigned u32x4 __attribute__((ext_vector_type(4)));
constexpr int BM = 256, BK = 64, HALF = 128, HTB = HALF * BK * 2  , STAGE_BYTES = 8 * HTB, NXCD = 8, WGM = 8;

__host__ __device__ __forceinline__ int lds_byte(int r, int c) { const int st = (r >> 4) * 2 + (c >> 5), rr = r & 15, cc = c & 31, ob = rr * 64 + cc * 2; return st * 1024 + (ob ^ (((ob >> 9) & 1) << 5)); }
__host__ __device__ __forceinline__ void stage_rc(int b, int& R, int& C) { const int st = b / 1024, sb = b % 1024, swz = sb ^ (((sb >> 9) & 1) << 5); R = (st >> 1) * 16 + swz / 64; C = (st & 1) * 32 + (swz % 64) / 2; }
__host__ __device__ __forceinline__ int perm32(int rho) { const int n = rho >> 4, i = rho & 15; return 8 * (i >> 2) + 4 * n + (i & 3); }

struct Unit { int pm, pn; };
struct Gemm { const bf16_t* A; const bf16_t* Bt; int M, N, K; };

struct StaticOrder {
    int nM, nN, nwg, G, c;
    __host__ __device__ void init(int M, int N, int G_, int c_) { nM = M / BM; nN = N / BM; nwg = nM * nN; G = G_; c = c_; }
    __host__ __device__ bool next(int i, Unit& u) const {
        const long L = (long)i * G + c; if (L >= nwg) return false;
        int wgid = (int)L; { const int q = nwg / NXCD, r = nwg % NXCD, xcd = wgid % NXCD, off = wgid / NXCD; wgid = (xcd < r ? xcd * (q + 1) : r * (q + 1) + (xcd - r) * q) + off; }
        const int nig = WGM * nN, gid = wgid / nig, fm = gid * WGM, gsz = (nM - fm) < WGM ? (nM - fm) : WGM;
        u.pm = fm + ((wgid % nig) % gsz); u.pn = (wgid % nig) / gsz; return true;
    }
    __device__ __forceinline__ void a_ready(const Unit&) const {}
    __device__ __forceinline__ void done(const Unit&) const {}
};

__device__ __forceinline__ unsigned cvt_pk_bf16(float lo, float hi) { unsigned r; asm volatile("v_cvt_pk_bf16_f32 %0, %1, %2" : "=v"(r) : "v"(lo), "v"(hi)); return r; }
typedef float f32x2 __attribute__((ext_vector_type(2)));
__device__ __forceinline__ f32x2 gelu_pk(f32x2 v) {
    const f32x2 av = __builtin_elementwise_abs(v), d = av * 0.2316418882f + 1.0f;
    f32x2 t; t.x = __builtin_amdgcn_rcpf(d.x); t.y = __builtin_amdgcn_rcpf(d.y);
    f32x2 q = t * 0.5307027145f + (-0.7265760135f); q = q * t + 0.7107068705f; q = q * t + (-0.142248368f); q = q * t + 0.127414796f; q = q * t;
    const f32x2 s = (v * v) * (-0.72134752044f);
    f32x2 e; e.x = __builtin_amdgcn_exp2f(s.x); e.y = __builtin_amdgcn_exp2f(s.y);
    const f32x2 m = v * (q * e), r = v - m;
    f32x2 o; o.x = v.x < 0.f ? m.x : r.x; o.y = v.y < 0.f ? m.y : r.y; return o;
}

template <int ACT  > struct EpiBf16 {
    static constexpr bool PERM = true, AFTER_DRAIN = false; static_assert(ACT == 0 || ACT == 1, "EpiBf16: ACT is 0 (none) or 1 (gelu_pk)");
    bf16_t* O; int ldc; const float* bias; int split_cols; size_t split_stride; float scale0;
    __device__ __forceinline__ void operator()(const f32x4 (&acc)[2][2][4][2], const Unit& u, int wr, int wc, int fr, int fq) const {
        const int row0 = u.pm * BM + wr * 64 + fr; int colt = u.pn * BM; bf16_t* base = O;
        float sc = 1.f; if (split_cols) { const int t = colt / split_cols; base += (size_t)t * split_stride; colt -= t * split_cols; if (t == 0) sc = scale0; }
        const int col0 = colt + wc * 32 + 8 * fq, bcol0 = u.pn * BM + wc * 32 + 8 * fq;
        f32x4 bv[2][2];
#pragma unroll
        for (int bj = 0; bj < 2; ++bj)
#pragma unroll
            for (int n = 0; n < 2; ++n) bv[bj][n] = bias ? *(const f32x4*)(bias + bcol0 + bj * HALF + 4 * n) : (f32x4){0.f, 0.f, 0.f, 0.f};
#pragma unroll
        for (int ai = 0; ai < 2; ++ai)
#pragma unroll
            for (int m = 0; m < 4; ++m) { bf16_t* rowp = base + (size_t)(row0 + ai * HALF + m * 16) * ldc + col0;
#pragma unroll
                for (int bj = 0; bj < 2; ++bj) { f32x4 v0 = acc[ai][bj][m][0] + bv[bj][0], v1 = acc[ai][bj][m][1] + bv[bj][1];
                    if (ACT == 1) { f32x2 a = gelu_pk((f32x2){v0[0], v0[1]}), b = gelu_pk((f32x2){v0[2], v0[3]}), c = gelu_pk((f32x2){v1[0], v1[1]}), d = gelu_pk((f32x2){v1[2], v1[3]});
                        v0 = (f32x4){a.x, a.y, b.x, b.y}; v1 = (f32x4){c.x, c.y, d.x, d.y}; }
                    v0 = v0 * sc; v1 = v1 * sc; u32x4 w; w.x = cvt_pk_bf16(v0[0], v0[1]); w.y = cvt_pk_bf16(v0[2], v0[3]); w.z = cvt_pk_bf16(v1[0], v1[1]); w.w = cvt_pk_bf16(v1[2], v1[3]);
                    *(u32x4*)(rowp + bj * HALF) = w; } }
    }
};
template <class Epi, class Sched, bool ALIGN_EPI = false, bool SP2 = false>
__device__ __forceinline__ void gemm_phase(PG8_LAS unsigned char* lds, const Gemm g, const Sched& S, const Epi& E) {
    const int tid = threadIdx.x, wid = __builtin_amdgcn_readfirstlane(tid >> 6), lane = tid & 63, wr = wid >> 2, wc = wid & 3, fr = lane & 15, fq = lane >> 4;
    const int K = g.K, nt = K / BK;
    unsigned voffA[2], voffB[2];
#pragma unroll
    for (int i = 0; i < 2; ++i) { int R, C; stage_rc(tid * 16 + i * 8192, R, C); const int Rb = Epi::PERM ? ((R & ~31) + perm32(R & 31)) : R;
        voffA[i] = (unsigned)(R * K + C) * 2u; voffB[i] = (unsigned)(Rb * K + C) * 2u; }
    const size_t kstep = (size_t)(BK * 2);
    const size_t hstep = (size_t)HALF * K * 2;
    const size_t tstep = 2 * hstep;
    const unsigned ldsw = (unsigned)wid * 1024u;
    const int aoff = lds_byte(wr * 64 + fr, fq * 8), boff = lds_byte(wc * 32 + fr, fq * 8);
#define PG8_SA(b, h) (((b) * 2 + (h)) * HTB)
#define PG8_SB(b, h) ((4 + (b) * 2 + (h)) * HTB)
#define PG8_STAGE(bufoff, gbase, voff) do { _Pragma("unroll") for (int _i = 0; _i < 2; ++_i) \
        __builtin_amdgcn_global_load_lds((const unsigned*)((const char*)(gbase) + (voff)[_i]), (PG8_LAS unsigned*)(lds + (bufoff) + ldsw + _i * 8192), 16, 0, 0); } while (0)
#define PG8_LDA(dst, b, h) do { _Pragma("unroll") for (int m = 0; m < 4; ++m) _Pragma("unroll") for (int k = 0; k < 2; ++k) dst[m][k] = *(const PG8_LAS bf16x8*)(lds + PG8_SA(b, h) + aoff + m * 2048 + k * 1024); } while (0)
#define PG8_LDB(dst, b, h) do { _Pragma("unroll") for (int n = 0; n < 2; ++n) _Pragma("unroll") for (int k = 0; k < 2; ++k) dst[n][k] = *(const PG8_LAS bf16x8*)(lds + PG8_SB(b, h) + boff + n * 2048 + k * 1024); } while (0)
#define PG8_MMA(ai, bj, At, Bt) do { __builtin_amdgcn_s_setprio(1); _Pragma("unroll") for (int m = 0; m < 4; ++m) _Pragma("unroll") for (int n = 0; n < 2; ++n) _Pragma("unroll") for (int k = 0; k < 2; ++k) \
        acc[ai][bj][m][n] = __builtin_amdgcn_mfma_f32_16x16x32_bf16(Bt[n][k], At[m][k], acc[ai][bj][m][n], 0, 0, 0); __builtin_amdgcn_s_setprio(0); } while (0)
#define PG8_WAIT_V(n) asm volatile("s_waitcnt vmcnt(" #n ")" ::: "memory")
#define PG8_WAIT_L(n) asm volatile("s_waitcnt lgkmcnt(" #n ")" ::: "memory")
#define PG8_BAR __builtin_amdgcn_s_barrier()
#define PG8_SCHED __builtin_amdgcn_sched_barrier(0)
    Unit cur, nxt; int ui = 0;
    if (!S.next(0, cur)) return;
    f32x4 acc[2][2][4][2];
#pragma unroll
    for (int a = 0; a < 2; ++a)
#pragma unroll
        for (int b = 0; b < 2; ++b)
#pragma unroll
            for (int m = 0; m < 4; ++m)
#pragma unroll
                for (int n = 0; n < 2; ++n) acc[a][b][m][n] = (f32x4){0.f, 0.f, 0.f, 0.f};
    bf16x8 At[4][2], B0[2][2], B1[2][2];
    const char* cA = (const char*)g.A + (size_t)cur.pm * tstep; const char* cB = (const char*)g.Bt + (size_t)cur.pn * tstep;
    S.a_ready(cur);
    if constexpr (SP2) {
        PG8_STAGE(PG8_SB(0, 0), cB, voffB); PG8_STAGE(PG8_SB(0, 1), cB + hstep, voffB); PG8_STAGE(PG8_SA(0, 0), cA, voffA); PG8_STAGE(PG8_SA(0, 1), cA + hstep, voffA);
        if (wr == 1) PG8_BAR;
        PG8_WAIT_V(2); PG8_BAR;
        PG8_STAGE(PG8_SB(1, 0), cB + kstep, voffB); PG8_STAGE(PG8_SA(1, 0), cA + kstep, voffA); PG8_STAGE(PG8_SB(1, 1), cB + hstep + kstep, voffB);
        PG8_WAIT_V(6); PG8_BAR;
    } else {
        PG8_STAGE(PG8_SB(0, 0), cB, voffB); PG8_STAGE(PG8_SA(0, 0), cA, voffA); PG8_STAGE(PG8_SB(0, 1), cB + hstep, voffB); PG8_STAGE(PG8_SA(0, 1), cA + hstep, voffA);
        if (wr == 1) PG8_BAR;
        PG8_WAIT_V(4); PG8_BAR;
        PG8_STAGE(PG8_SB(1, 0), cB + kstep, voffB); PG8_STAGE(PG8_SA(1, 0), cA + kstep, voffA); PG8_STAGE(PG8_SB(1, 1), cB + hstep + kstep, voffB);
        PG8_WAIT_V(6); PG8_BAR;
    }
    for (;;) {
        const bool has_next = S.next(ui + 1, nxt);
        const char* nA = has_next ? (const char*)g.A + (size_t)nxt.pm * tstep : cA; const char* nB = has_next ? (const char*)g.Bt + (size_t)nxt.pn * tstep : cB;
        for (int t = 0; t < nt; t += 2) {
            const bool last = (t == nt - 2);
            const char* a1 = cA + (size_t)(t + 1) * kstep;
            const char* a2 = last ? nA : cA + (size_t)(t + 2) * kstep; const char* b2 = last ? nB : cB + (size_t)(t + 2) * kstep;
            const char* a3 = a2 + kstep; const char* b3 = b2 + kstep;
            if (last && has_next) S.a_ready(nxt);
            if constexpr (SP2) {
            PG8_LDB(B0, 0, 0); PG8_LDB(B1, 0, 1); PG8_SCHED; PG8_LDA(At, 0, 0); PG8_STAGE(PG8_SA(1, 1), a1 + hstep, voffA);
            PG8_WAIT_V(8); PG8_WAIT_L(0); PG8_BAR; PG8_MMA(0, 0, At, B0); PG8_MMA(0, 1, At, B1); PG8_BAR; PG8_SCHED;
            PG8_LDA(At, 0, 1); PG8_STAGE(PG8_SB(0, 0), b2, voffB); PG8_STAGE(PG8_SB(0, 1), b2 + hstep, voffB); PG8_STAGE(PG8_SA(0, 0), a2, voffA);
            PG8_WAIT_V(8); PG8_WAIT_L(0); PG8_BAR; PG8_MMA(1, 0, At, B0); PG8_MMA(1, 1, At, B1); PG8_BAR; PG8_SCHED;
            PG8_LDB(B0, 1, 0); PG8_LDB(B1, 1, 1); PG8_SCHED; PG8_LDA(At, 1, 0); PG8_STAGE(PG8_SA(0, 1), a2 + hstep, voffA);
            PG8_WAIT_V(8); PG8_WAIT_L(0); PG8_BAR; PG8_MMA(0, 0, At, B0); PG8_MMA(0, 1, At, B1); PG8_BAR; PG8_SCHED;
            PG8_LDA(At, 1, 1); PG8_STAGE(PG8_SB(1, 0), b3, voffB); PG8_STAGE(PG8_SB(1, 1), b3 + hstep, voffB); PG8_STAGE(PG8_SA(1, 0), a3, voffA);
            PG8_WAIT_V(8); PG8_WAIT_L(0); PG8_BAR; PG8_MMA(1, 0, At, B0); PG8_MMA(1, 1, At, B1); PG8_BAR; PG8_SCHED;
            } else {
            PG8_LDB(B0, 0, 0); PG8_SCHED; PG8_LDA(At, 0, 0); PG8_STAGE(PG8_SA(1, 1), a1 + hstep, voffA);
            PG8_WAIT_L(8); PG8_BAR; PG8_WAIT_L(0); PG8_MMA(0, 0, At, B0); PG8_BAR; PG8_SCHED;
            PG8_LDB(B1, 0, 1); PG8_STAGE(PG8_SB(0, 0), b2, voffB);
            PG8_BAR; PG8_WAIT_L(0); PG8_MMA(0, 1, At, B1); PG8_BAR;
            PG8_LDA(At, 0, 1); PG8_STAGE(PG8_SA(0, 0), a2, voffA);
            PG8_BAR; PG8_WAIT_L(0); PG8_MMA(1, 0, At, B0); PG8_BAR; PG8_SCHED;
            PG8_STAGE(PG8_SB(0, 1), b2 + hstep, voffB);
            PG8_WAIT_V(6); PG8_BAR; PG8_MMA(1, 1, At, B1); PG8_BAR;
            PG8_LDB(B0, 1, 0); PG8_SCHED; PG8_LDA(At, 1, 0); PG8_STAGE(PG8_SA(0, 1), a2 + hstep, voffA);
            PG8_WAIT_L(8); PG8_BAR; PG8_WAIT_L(0); PG8_MMA(0, 0, At, B0); PG8_BAR; PG8_SCHED;
            PG8_LDB(B1, 1, 1); PG8_STAGE(PG8_SB(1, 0), b3, voffB);
            PG8_BAR; PG8_WAIT_L(0); PG8_MMA(0, 1, At, B1); PG8_BAR;
            PG8_LDA(At, 1, 1); PG8_STAGE(PG8_SA(1, 0), a3, voffA);
            PG8_BAR; PG8_WAIT_L(0); PG8_MMA(1, 0, At, B0); PG8_BAR; PG8_SCHED;
            PG8_STAGE(PG8_SB(1, 1), b3 + hstep, voffB);
            PG8_WAIT_V(6); PG8_BAR; PG8_MMA(1, 1, At, B1); PG8_BAR;
            }
        }
        if constexpr (ALIGN_EPI) { if (wr == 0) PG8_BAR; }
        if constexpr (!Epi::AFTER_DRAIN) { E(acc, cur, wr, wc, fr, fq); S.done(cur); }
        if (!has_next) break;
#pragma unroll
        for (int a = 0; a < 2; ++a)
#pragma unroll
            for (int b = 0; b < 2; ++b)
#pragma unroll
                for (int m = 0; m < 4; ++m)
#pragma unroll
                    for (int n = 0; n < 2; ++n) acc[a][b][m][n] = (f32x4){0.f, 0.f, 0.f, 0.f};
        cur = nxt; cA = nA; cB = nB; ++ui;
        if constexpr (ALIGN_EPI) { if (wr == 1) PG8_BAR; }
    }
    PG8_WAIT_V(0);
    if constexpr (!ALIGN_EPI) { if (wr == 0) PG8_BAR; }
    PG8_BAR;
    if constexpr (Epi::AFTER_DRAIN) { E.fused(acc, cur, wr, wc, fr, fq, lds, wid, lane); S.done(cur); }
#undef PG8_SA
#undef PG8_SB
#undef PG8_STAGE
#undef PG8_LDA
#undef PG8_LDB
#undef PG8_MMA
#undef PG8_WAIT_V
#undef PG8_WAIT_L
#undef PG8_BAR
#undef PG8_SCHED
}
}

namespace cg = cooperative_groups;
constexpr int BATCH = 16, SEQ = 4096, D = 1024, NTOK = BATCH * SEQ;
constexpr int FH = 8, DH = 4, HD = 64;
constexpr int NPROJ = 3072, IN_COLS = 3080;
constexpr int PH = 8, NKEY = 128, TOPK = 16, PQ = 2048, NEXP = 16384;
constexpr float RMS_EPS = 1e-6f, LOG2E = 1.4426950408889634f, C2 = 0.125f * LOG2E;
constexpr float LAMBDA_INIT = 0.2f;
constexpr int COL_QA = 0, COL_KA = 512, COL_VA = 1024, COL_QB = 1536, COL_KB = 2048, COL_VB = 2560;
constexpr int NWAVES = 8, NTHR = 512;

typedef unsigned short bf16_t;
typedef float f32x4v __attribute__((ext_vector_type(4)));
#define LAS __attribute__((address_space(3)))

constexpr size_t MiB = 1u << 20;
constexpr size_t WS_CTL = 0;
constexpr size_t WS_WIN = 2 * MiB;
constexpr size_t WS_WOUT = 8 * MiB;
constexpr size_t WS_WQ = 10 * MiB;
constexpr size_t WS_LOGF = 16 * MiB;
constexpr size_t WS_CUM = 18 * MiB;
constexpr size_t WS_XN = 96 * MiB;
constexpr size_t WS_PROJ = 224 * MiB;
constexpr size_t WS_Y = 224 * MiB;
constexpr size_t WS_QP = 352 * MiB;
constexpr size_t WS_MIXED = 608 * MiB;
constexpr size_t WS_END = 736 * MiB;
constexpr int LDS_BYTES = 147456;

__device__ __forceinline__ unsigned f2bf(float f) { unsigned u = __builtin_bit_cast(unsigned, f); return (u + 0x7fffu + ((u >> 16) & 1u)) >> 16; }
__device__ __forceinline__ unsigned pk2(float lo, float hi) { return f2bf(lo) | (f2bf(hi) << 16); }
__device__ __forceinline__ float bflo(unsigned w) { return __builtin_bit_cast(float, w << 16); }
__device__ __forceinline__ float bfhi(unsigned w) { return __builtin_bit_cast(float, w & 0xffff0000u); }
__device__ __forceinline__ float wave_sum(float v) {
#pragma unroll
    for (int o = 1; o < 64; o <<= 1) v += __shfl_xor(v, o);
    return v;
}

struct Ctx { int tid, lane, wave, vcu, G, gw, NGW; LAS unsigned char* lds; };

__device__ __forceinline__ void p0_transpose_item(const float* W, int ldw, int K, int ncols, bf16_t* WT, int row_off, float scale, LAS float* scr, int item, int lane) {
    const int nblk = ncols / 32, kb = item / nblk, nb = item % nblk, k0 = 64 * kb, n0 = 32 * nb;
#pragma unroll 8
    for (int i = 0; i < 32; ++i) { const int kk = 2 * i + (lane >> 5); scr[kk * 33 + (lane & 31)] = W[(size_t)(k0 + kk) * ldw + n0 + (lane & 31)] * scale; }
    asm volatile("s_waitcnt lgkmcnt(0)" ::: "memory");
    const int c = lane & 7;
#pragma unroll
    for (int j = 0; j < 4; ++j) { const int n = (lane >> 3) + 8 * j; const LAS float* s = scr + (8 * c) * 33 + n;
        uint4 o; o.x = pk2(s[0 * 33], s[1 * 33]); o.y = pk2(s[2 * 33], s[3 * 33]); o.z = pk2(s[4 * 33], s[5 * 33]); o.w = pk2(s[6 * 33], s[7 * 33]);
        *(uint4*)(WT + (size_t)(row_off + n0 + n) * K + k0 + 8 * c) = o; }
    asm volatile("s_waitcnt lgkmcnt(0)" ::: "memory");
}
__device__ __forceinline__ void p0_weights(const Ctx& c, const float* w_in, const float* w_out, const float* w_q, bf16_t* WIN, bf16_t* WOUT, bf16_t* WQ) {
    LAS float* scr = (LAS float*)(c.lds + c.wave * 16384);
    constexpr int KB = D / 64;
    constexpr int I0 = KB * (512 / 32), I1 = KB * (1024 / 32), I2 = I0, I3 = I1, I4 = KB * (D / 32), I5 = KB * (PQ / 32);
    constexpr int NIT = I0 + I1 + I2 + I3 + I4 + I5;
    for (int it = c.gw; it < NIT; it += c.NGW) {
        int r = it;
        if (r < I0) { p0_transpose_item(w_in + 0, IN_COLS, D, 512, WIN, 0, C2, scr, r, c.lane); continue; } r -= I0;
        if (r < I1) { p0_transpose_item(w_in + 512, IN_COLS, D, 1024, WIN, 512, 1.f, scr, r, c.lane); continue; } r -= I1;
        if (r < I2) { p0_transpose_item(w_in + 1544, IN_COLS, D, 512, WIN, 1536, C2, scr, r, c.lane); continue; } r -= I2;
        if (r < I3) { p0_transpose_item(w_in + 2056, IN_COLS, D, 1024, WIN, 2048, 1.f, scr, r, c.lane); continue; } r -= I3;
        if (r < I4) { p0_transpose_item(w_out, D, D, D, WOUT, 0, 1.f, scr, r, c.lane); continue; } r -= I4;
        p0_transpose_item(w_q, PQ, D, PQ, WQ, 0, 1.f, scr, r, c.lane);
    }
}

__device__ __forceinline__ void rms1_gates_row(int row, int lane, const float* __restrict__ x, const float* __restrict__ g1, const float* __restrict__ w_in, const float* __restrict__ b_f,
                                               bf16_t* __restrict__ XN, float* __restrict__ LOGF) {
    const f32x4v* xr = (const f32x4v*)(x + (size_t)row * D) + lane;
    f32x4v v[4]; float ss = 0.f;
#pragma unroll
    for (int j = 0; j < 4; ++j) { v[j] = xr[64 * j]; ss += (v[j].x * v[j].x + v[j].y * v[j].y) + (v[j].z * v[j].z + v[j].w * v[j].w); }
    ss = wave_sum(ss);
    const float rstd = rsqrtf(ss * (1.f / D) + RMS_EPS);
    float gate[8];
#pragma unroll
    for (int q = 0; q < 8; ++q) gate[q] = 0.f;
    unsigned long long* o8 = (unsigned long long*)(XN + (size_t)row * D) + lane;
#pragma unroll
    for (int j = 0; j < 4; ++j) {
        const f32x4v g = ((const f32x4v*)g1)[lane + 64 * j];
        v[j] = v[j] * rstd * g;
        o8[64 * j] = (unsigned long long)pk2(v[j].x, v[j].y) | ((unsigned long long)pk2(v[j].z, v[j].w) << 32);
#pragma unroll
        for (int e = 0; e < 4; ++e) {
            const int k = 4 * lane + 256 * j + e;
            const f32x4v* wr = (const f32x4v*)(w_in + (size_t)k * IN_COLS + 1536);
            const f32x4v w0 = wr[0], w1 = wr[1]; const float xe = v[j][e];
            gate[0] += xe * w0.x; gate[1] += xe * w0.y; gate[2] += xe * w0.z; gate[3] += xe * w0.w;
            gate[4] += xe * w1.x; gate[5] += xe * w1.y; gate[6] += xe * w1.z; gate[7] += xe * w1.w;
        }
    }
#pragma unroll
    for (int q = 0; q < 8; ++q) gate[q] = wave_sum(gate[q]);
    float gv = gate[0];
#pragma unroll
    for (int q = 1; q < 8; ++q) if (lane == q) gv = gate[q];
    if (lane < 8) {
        const float z = gv + b_f[lane];
        const float ls = fminf(z, 0.f) - log1pf(expf(-fabsf(z)));
        const int b = row / SEQ, t = row % SEQ;
        LOGF[((size_t)b * FH + lane) * SEQ + t] = ls;
    }
}

__device__ __forceinline__ void cumsum_seq(int bh, int lane, const float* __restrict__ LOGF, float* __restrict__ CUM) {
    const float* src = LOGF + (size_t)bh * SEQ + lane * 64; float* dst = CUM + (size_t)bh * SEQ + lane * 64;
    float loc[64]; float run = 0.f;
#pragma unroll
    for (int i = 0; i < 64; ++i) { run += src[i]; loc[i] = run; }
    float incl = run;
#pragma unroll
    for (int o = 1; o < 64; o <<= 1) { const float t = __shfl_up(incl, o); if (lane >= o) incl += t; }
    const float excl = incl - run;
#pragma unroll
    for (int i = 0; i < 64; ++i) dst[i] = loc[i] + excl;
}

template <int MODE> __device__ __forceinline__ void attn_naive_unit(const Ctx& c, int qb, int vh, int b, const bf16_t* __restrict__ PROJ, const float* __restrict__ CUM, bf16_t* __restrict__ MIXED, float* __restrict__ DTMP) {
    LAS float* Ks = (LAS float*)c.lds; LAS float* Vs = Ks + 64 * 64; LAS float* Cs = Vs + 64 * 64;
    const int tid = c.tid;
    const int t = qb * 512 + tid; const size_t rowbase = (size_t)b * SEQ;
    int qcol, kcol, vcol; float slope2 = 0.f; const float* cum = nullptr;
    if (MODE == 0) { qcol = COL_QA + vh * 64; kcol = COL_KA + vh * 64; vcol = COL_VA + vh * 64; cum = CUM + ((size_t)b * FH + vh) * SEQ; }
    else { const int h = vh >> 2, m = (vh >> 1) & 1, half = vh & 1; qcol = COL_QB + h * 128 + m * 64; kcol = COL_KB + h * 128 + m * 64; vcol = COL_VB + h * 128 + half * 64;
           slope2 = exp2f(-2.f * (float)(h + 1)) * LOG2E; }
    float q[64], o[64];
    { const uint4* qp = (const uint4*)(PROJ + (rowbase + t) * NPROJ + qcol);
#pragma unroll
      for (int i = 0; i < 8; ++i) { const uint4 w = qp[i]; q[8 * i + 0] = bflo(w.x); q[8 * i + 1] = bfhi(w.x); q[8 * i + 2] = bflo(w.y); q[8 * i + 3] = bfhi(w.y); q[8 * i + 4] = bflo(w.z); q[8 * i + 5] = bfhi(w.z); q[8 * i + 6] = bflo(w.w); q[8 * i + 7] = bfhi(w.w); } }
#pragma unroll
    for (int d = 0; d < 64; ++d) o[d] = 0.f;
    float m = -INFINITY, l = 0.f;
    const float cq = (MODE == 0) ? cum[t] * LOG2E : 0.f;
    const int ntile = 8 * qb + 8;
    for (int j = 0; j < ntile; ++j) {
        __syncthreads();
        { const int r = tid >> 3, c0 = (tid & 7) * 8; const size_t grow = (rowbase + 64 * j + r) * NPROJ;
          const uint4 w = *(const uint4*)(PROJ + grow + kcol + c0); const uint4 u = *(const uint4*)(PROJ + grow + vcol + c0);
          LAS float* d = Ks + r * 64 + c0; d[0] = bflo(w.x); d[1] = bfhi(w.x); d[2] = bflo(w.y); d[3] = bfhi(w.y); d[4] = bflo(w.z); d[5] = bfhi(w.z); d[6] = bflo(w.w); d[7] = bfhi(w.w);
          LAS float* e = Vs + r * 64 + c0; e[0] = bflo(u.x); e[1] = bfhi(u.x); e[2] = bflo(u.y); e[3] = bfhi(u.y); e[4] = bflo(u.z); e[5] = bfhi(u.z); e[6] = bflo(u.w); e[7] = bfhi(u.w);
          if (MODE == 0 && tid < 64) Cs[tid] = cum[64 * j + tid] * LOG2E; }
        __syncthreads();
        for (int kk = 0; kk < 64; ++kk) {
            const int s = 64 * j + kk;
            const bool valid = (MODE == 0) ? (s <= t) : ((s >> 6) <= (t >> 6));
            float dot = 0.f;
#pragma unroll
            for (int d = 0; d < 64; ++d) dot += q[d] * Ks[kk * 64 + d];
            const float bias = (MODE == 0) ? (cq - Cs[kk]) : (-slope2 * fabsf((float)(t - s)));
            const float xv = dot + bias;
            if (valid) {
                if (xv > m) { const float al = exp2f(m - xv); l *= al;
#pragma unroll
                    for (int d = 0; d < 64; ++d) o[d] *= al;
                    m = xv; }
                const float p = exp2f(xv - m); l += p;
#pragma unroll
                for (int d = 0; d < 64; ++d) o[d] += p * Vs[kk * 64 + d];
            }
        }
    }
    const float rl = 1.f / l;
    if (MODE == 0) { unsigned* op = (unsigned*)(MIXED + (rowbase + t) * D + vh * 64);
#pragma unroll
        for (int d = 0; d < 32; ++d) op[d] = pk2(o[2 * d] * rl, o[2 * d + 1] * rl); }
    else { float* op = DTMP + (rowbase + t) * 1024 + vh * 64;
#pragma unroll
        for (int d = 0; d < 64; ++d) op[d] = o[d] * rl; }
}

__device__ __forceinline__ void diff_combine_item(int gwi, int lane, float lam, const float* __restrict__ DTMP, const float* __restrict__ subg, bf16_t* __restrict__ MIXED) {
    const int tok = gwi >> 2, h = gwi & 3;
    const float* base = DTMP + (size_t)tok * 1024 + h * 256;
    const float o0 = base[0 * 64 + lane] - lam * base[2 * 64 + lane];
    const float o1 = base[1 * 64 + lane] - lam * base[3 * 64 + lane];
    const float ss = wave_sum(o0 * o0 + o1 * o1);
    const float r = rsqrtf(ss * (1.f / 128.f) + RMS_EPS) * (1.f - LAMBDA_INIT);
    bf16_t* op = MIXED + (size_t)tok * D + 512 + h * 128;
    op[lane] = (bf16_t)f2bf(o0 * r * subg[lane]); op[64 + lane] = (bf16_t)f2bf(o1 * r * subg[64 + lane]);
}

__device__ __forceinline__ void resid_rms2_row(int row, int lane, const float* __restrict__ x, const bf16_t* __restrict__ Y, const float* __restrict__ g2, float* __restrict__ H, bf16_t* __restrict__ HN) {
    const f32x4v* xr = (const f32x4v*)(x + (size_t)row * D) + lane;
    const uint2* yr = (const uint2*)(Y + (size_t)row * D) + lane;
    f32x4v* hr = (f32x4v*)(H + (size_t)row * D) + lane;
    f32x4v v[4]; float ss = 0.f;
#pragma unroll
    for (int j = 0; j < 4; ++j) { const uint2 y = yr[64 * j]; v[j] = xr[64 * j]; v[j].x += bflo(y.x); v[j].y += bfhi(y.x); v[j].z += bflo(y.y); v[j].w += bfhi(y.y);
        hr[64 * j] = v[j]; ss += (v[j].x * v[j].x + v[j].y * v[j].y) + (v[j].z * v[j].z + v[j].w * v[j].w); }
    ss = wave_sum(ss);
    const float rstd = rsqrtf(ss * (1.f / D) + RMS_EPS);
    unsigned long long* o8 = (unsigned long long*)(HN + (size_t)row * D) + lane;
#pragma unroll
    for (int j = 0; j < 4; ++j) { const f32x4v g = ((const f32x4v*)g2)[lane + 64 * j]; const f32x4v w = v[j] * rstd * g;
        o8[64 * j] = (unsigned long long)pk2(w.x, w.y) | ((unsigned long long)pk2(w.z, w.w) << 32); }
}

__device__ __forceinline__ void peer_token(int tok, int lane, LAS float* qs  , const bf16_t* __restrict__ QP, const float* __restrict__ subk, const bf16_t* __restrict__ HN,
                                           const float* __restrict__ U, const float* __restrict__ V, const float* __restrict__ fg, float* __restrict__ H) {
    f32x4v xv[4], acc[4];
    { const uint2* hr = (const uint2*)(HN + (size_t)tok * D) + lane;
#pragma unroll
      for (int j = 0; j < 4; ++j) { const uint2 y = hr[64 * j]; xv[j] = (f32x4v){bflo(y.x), bfhi(y.x), bflo(y.y), bfhi(y.y)}; acc[j] = (f32x4v){0.f, 0.f, 0.f, 0.f}; } }
    for (int h = 0; h < PH; ++h) {
        asm volatile("s_waitcnt lgkmcnt(0)" ::: "memory");
        { const uint2 raw = *((const uint2*)(QP + (size_t)tok * PQ + h * 256) + lane);
          qs[4 * lane + 0] = bflo(raw.x); qs[4 * lane + 1] = bfhi(raw.x); qs[4 * lane + 2] = bflo(raw.y); qs[4 * lane + 3] = bfhi(raw.y); }
        asm volatile("s_waitcnt lgkmcnt(0)" ::: "memory");
        float sc[2][2];
#pragma unroll
        for (int p = 0; p < 2; ++p)
#pragma unroll
            for (int w = 0; w < 2; ++w) {
                const int key = lane + 64 * w;
                const f32x4v* kr = (const f32x4v*)(subk + (((size_t)h * 2 + p) * NKEY + key) * 128);
                const LAS f32x4v* qv = (const LAS f32x4v*)(qs + p * 128);
                float a = 0.f;
#pragma unroll 8
                for (int d = 0; d < 32; ++d) { const f32x4v kk = kr[d], cc = qv[d]; a += (kk.x * cc.x + kk.y * cc.y) + (kk.z * cc.z + kk.w * cc.w); }
                sc[p][w] = a;
            }
        float ts[2]; int ti[2]; ts[0] = ts[1] = 0.f; ti[0] = ti[1] = 0;
#pragma unroll
        for (int p = 0; p < 2; ++p) {
            float v0 = sc[p][0], v1 = sc[p][1];
            for (int r = 0; r < TOPK; ++r) {
                float bv; int bi; if (v1 > v0) { bv = v1; bi = lane + 64; } else { bv = v0; bi = lane; }
#pragma unroll
                for (int off = 32; off >= 1; off >>= 1) { const float ov = __shfl_xor(bv, off); const int oi = __shfl_xor(bi, off); if (ov > bv || (ov == bv && oi < bi)) { bv = ov; bi = oi; } }
                if (lane == r) { ts[p] = bv; ti[p] = bi; }
                if (bi == lane) v0 = -INFINITY; if (bi == lane + 64) v1 = -INFINITY;
            }
        }
        float cv[4];
#pragma unroll
        for (int w = 0; w < 4; ++w) { const int cc = lane + 64 * w; cv[w] = __shfl(ts[0], cc >> 4) + __shfl(ts[1], cc & 15); }
        float fs = 0.f; int fc = 0;
        for (int r = 0; r < TOPK; ++r) {
            float bv = cv[0]; int bi = lane;
#pragma unroll
            for (int w = 1; w < 4; ++w) if (cv[w] > bv) { bv = cv[w]; bi = lane + 64 * w; }
#pragma unroll
            for (int off = 32; off >= 1; off >>= 1) { const float ov = __shfl_xor(bv, off); const int oi = __shfl_xor(bi, off); if (ov > bv || (ov == bv && oi < bi)) { bv = ov; bi = oi; } }
            if (lane == r) { fs = bv; fc = bi; }
#pragma unroll
            for (int w = 0; w < 4; ++w) if (bi == lane + 64 * w) cv[w] = -INFINITY;
        }
        const int ia = __shfl(ti[0], fc >> 4), ib = __shfl(ti[1], fc & 15);
        const float mx = __shfl(fs, 0);
        const float ee = (lane < TOPK) ? expf(fs - mx) : 0.f;
        const float sum = wave_sum(ee);
        const int el = ia * NKEY + ib; const float gl = ee / sum;
        for (int r = 0; r < TOPK; ++r) {
            const int e = __shfl(el, r); const float g = __shfl(gl, r);
            const f32x4v* ur = (const f32x4v*)(U + (size_t)e * D) + lane;
            const f32x4v* vr = (const f32x4v*)(V + (size_t)e * D) + lane;
            float dot = 0.f;
#pragma unroll
            for (int j = 0; j < 4; ++j) { const f32x4v u = ur[64 * j]; dot += (u.x * xv[j].x + u.y * xv[j].y) + (u.z * xv[j].z + u.w * xv[j].w); }
            dot = wave_sum(dot);
            const float hid = 0.5f * dot * (1.f + erff(dot * 0.70710678118654752f)) * g;
#pragma unroll
            for (int j = 0; j < 4; ++j) acc[j] += hid * vr[64 * j];
        }
    }
    f32x4v* hr = (f32x4v*)(H + (size_t)tok * D) + lane; float ss = 0.f;
#pragma unroll
    for (int j = 0; j < 4; ++j) { acc[j] += hr[64 * j]; ss += (acc[j].x * acc[j].x + acc[j].y * acc[j].y) + (acc[j].z * acc[j].z + acc[j].w * acc[j].w); }
    ss = wave_sum(ss);
    const float rstd = rsqrtf(ss * (1.f / D) + RMS_EPS);
#pragma unroll
    for (int j = 0; j < 4; ++j) hr[64 * j] = acc[j] * rstd * ((const f32x4v*)fg)[lane + 64 * j];
}

struct Args { const float* in[16]; float* out; unsigned char* ws; };
__global__ void __launch_bounds__(NTHR, 2) fwd_megakernel(Args a) {
    extern __shared__ __attribute__((aligned(16))) unsigned char lds_raw[];
    cg::grid_group grid = cg::this_grid();
    Ctx c; c.tid = threadIdx.x; c.lane = c.tid & 63; c.wave = __builtin_amdgcn_readfirstlane(c.tid >> 6); c.G = gridDim.x;
    { const int bx = blockIdx.x; c.vcu = (c.G % 8 == 0) ? (bx % 8) * (c.G / 8) + bx / 8 : bx; }
    c.gw = c.vcu * NWAVES + c.wave; c.NGW = c.G * NWAVES; c.lds = (LAS unsigned char*)lds_raw;
    const float* x = a.in[0]; const float* g1 = a.in[1]; const float* w_in = a.in[2]; const float* b_f = a.in[3];
    const float* lq1 = a.in[4]; const float* lk1 = a.in[5]; const float* lq2 = a.in[6]; const float* lk2 = a.in[7];
    const float* subg = a.in[8]; const float* w_out = a.in[9]; const float* g2 = a.in[10]; const float* w_q = a.in[11];
    const float* subk = a.in[12]; const float* U = a.in[13]; const float* V = a.in[14]; const float* fg = a.in[15];
    unsigned char* ws = a.ws; float* out = a.out;
    bf16_t* WIN = (bf16_t*)(ws + WS_WIN); bf16_t* WOUT = (bf16_t*)(ws + WS_WOUT); bf16_t* WQ = (bf16_t*)(ws + WS_WQ);
    float* LOGF = (float*)(ws + WS_LOGF); float* CUM = (float*)(ws + WS_CUM);
    bf16_t* XN = (bf16_t*)(ws + WS_XN); bf16_t* PROJ = (bf16_t*)(ws + WS_PROJ); bf16_t* Y = (bf16_t*)(ws + WS_Y); bf16_t* QP = (bf16_t*)(ws + WS_QP);
    bf16_t* MIXED = (bf16_t*)(ws + WS_MIXED);

    p0_weights(c, w_in, w_out, w_q, WIN, WOUT, WQ);
    for (int row = c.gw; row < NTOK; row += c.NGW) rms1_gates_row(row, c.lane, x, g1, w_in, b_f, XN, LOGF);
    grid.sync();
    if (c.gw < BATCH * FH) cumsum_seq(c.gw, c.lane, LOGF, CUM);
    __syncthreads();
    { pg8::Gemm g{XN, WIN, NTOK, NPROJ, D}; pg8::StaticOrder S; S.init(NTOK, NPROJ, c.G, (int)blockIdx.x);
      pg8::EpiBf16<0> E{PROJ, NPROJ, nullptr, 0, 0, 1.f};
      pg8::gemm_phase<pg8::EpiBf16<0>, pg8::StaticOrder, true, true>(c.lds, g, S, E); }
    grid.sync();
    for (int u = c.vcu; u < 8 * FH * BATCH; u += c.G) { const int qb = 7 - (u & 7), vh = (u >> 3) % FH, b = u / (8 * FH); attn_naive_unit<0>(c, qb, vh, b, PROJ, CUM, MIXED, out); __syncthreads(); }
    for (int u = c.vcu; u < 8 * 16 * BATCH; u += c.G) { const int qb = 7 - (u & 7), vh = (u >> 3) % 16, b = u / (8 * 16); attn_naive_unit<1>(c, qb, vh, b, PROJ, CUM, MIXED, out); __syncthreads(); }
    grid.sync();
    { const float lam = expf(wave_sum(lq1[c.lane] * lk1[c.lane])) - expf(wave_sum(lq2[c.lane] * lk2[c.lane])) + LAMBDA_INIT;
      for (int i = c.gw; i < NTOK * DH; i += c.NGW) diff_combine_item(i, c.lane, lam, out, subg, MIXED); }
    grid.sync();
    { pg8::Gemm g{MIXED, WOUT, NTOK, D, D}; pg8::StaticOrder S; S.init(NTOK, D, c.G, (int)blockIdx.x);
      pg8::EpiBf16<0> E{Y, D, nullptr, 0, 0, 1.f};
      pg8::gemm_phase<pg8::EpiBf16<0>, pg8::StaticOrder, true, true>(c.lds, g, S, E); }
    grid.sync();
    for (int row = c.gw; row < NTOK; row += c.NGW) resid_rms2_row(row, c.lane, x, Y, g2, out, XN);
    grid.sync();
    { pg8::Gemm g{XN, WQ, NTOK, PQ, D}; pg8::StaticOrder S; S.init(NTOK, PQ, c.G, (int)blockIdx.x);
      pg8::EpiBf16<0> E{QP, PQ, nullptr, 0, 0, 1.f};
      pg8::gemm_phase<pg8::EpiBf16<0>, pg8::StaticOrder, true, true>(c.lds, g, S, E); }
    grid.sync();
    { LAS float* qs = (LAS float*)(c.lds + c.wave * 1024);
      for (int tok = c.gw; tok < NTOK; tok += c.NGW) peer_token(tok, c.lane, qs, QP, subk, XN, U, V, fg, out); }
}

extern "C" void kernel_launch(void* const* d_in, const int* in_sizes, int n_in, void* d_out, int out_size, void* d_ws, size_t ws_size, hipStream_t stream) {
    static int grid = 0;
    if (grid == 0) {
        if (n_in != 16 || in_sizes[0] != NTOK * D || out_size != NTOK * D || ws_size < WS_END) { fprintf(stderr, "kernel_launch: unexpected shapes (n_in %d in0 %d out %d ws %zu)\n", n_in, in_sizes[0], out_size, ws_size); grid = -1; return; }
        int dev = 0, cus = 0, per_cu = 0;
        if (hipGetDevice(&dev) != hipSuccess || hipDeviceGetAttribute(&cus, hipDeviceAttributeMultiprocessorCount, dev) != hipSuccess) { grid = -1; return; }
        if (hipFuncSetAttribute((const void*)fwd_megakernel, hipFuncAttributeMaxDynamicSharedMemorySize, LDS_BYTES) != hipSuccess) { fprintf(stderr, "hipFuncSetAttribute failed\n"); grid = -1; return; }
        if (hipOccupancyMaxActiveBlocksPerMultiprocessor(&per_cu, (const void*)fwd_megakernel, NTHR, LDS_BYTES) != hipSuccess || per_cu < 1) { fprintf(stderr, "occupancy query failed (%d)\n", per_cu); grid = -1; return; }
        grid = cus;
    }
    if (grid < 0) return;
    Args a{};
    for (int i = 0; i < 16; ++i) a.in[i] = (const float*)d_in[i];
    a.out = (float*)d_out; a.ws = (unsigned char*)d_ws;
    void* args[] = {&a};
    hipError_t e = hipLaunchCooperativeKernel((const void*)fwd_megakernel, dim3(grid), dim3(NTHR), args, LDS_BYTES, stream);
    if (e != hipSuccess) fprintf(stderr, "cooperative launch failed: %s (grid %d)\n", hipGetErrorString(e), grid);
}
```

```cpp
#include <hip/hip_runtime.h>
#include <hip/hip_cooperative_groups.h>
#include <cstdio>
#include <cstdint>
#include <cmath>
namespace pg8 {
#define PG8_LAS __attribute__((address_space(3)))
typedef unsigned short bf16_t;
typedef short bf16x8 __attribute__((ext_vector_type(8)));
typedef float f32x4 __attribute__((ext_vector_type(4)));
typedef unsigned u32x4 __attribute__((ext_vector_type(4)));
constexpr int BM = 256, BK = 64, HALF = 128, HTB = HALF * BK * 2  , STAGE_BYTES = 8 * HTB, NXCD = 8, WGM = 8;

__host__ __device__ __forceinline__ int lds_byte(int r, int c) { const int st = (r >> 4) * 2 + (c >> 5), rr = r & 15, cc = c & 31, ob = rr * 64 + cc * 2; return st * 1024 + (ob ^ (((ob >> 9) & 1) << 5)); }
__host__ __device__ __forceinline__ void stage_rc(int b, int& R, int& C) { const int st = b / 1024, sb = b % 1024, swz = sb ^ (((sb >> 9) & 1) << 5); R = (st >> 1) * 16 + swz / 64; C = (st & 1) * 32 + (swz % 64) / 2; }
__host__ __device__ __forceinline__ int perm32(int rho) { const int n = rho >> 4, i = rho & 15; return 8 * (i >> 2) + 4 * n + (i & 3); }

struct Unit { int pm, pn; };
struct Gemm { const bf16_t* A; const bf16_t* Bt; int M, N, K; };

struct StaticOrder {
    int nM, nN, nwg, G, c;
    __host__ __device__ void init(int M, int N, int G_, int c_) { nM = M / BM; nN = N / BM; nwg = nM * nN; G = G_; c = c_; }
    __host__ __device__ bool next(int i, Unit& u) const {
        const long L = (long)i * G + c; if (L >= nwg) return false;
        int wgid = (int)L; { const int q = nwg / NXCD, r = nwg % NXCD, xcd = wgid % NXCD, off = wgid / NXCD; wgid = (xcd < r ? xcd * (q + 1) : r * (q + 1) + (xcd - r) * q) + off; }
        const int nig = WGM * nN, gid = wgid / nig, fm = gid * WGM, gsz = (nM - fm) < WGM ? (nM - fm) : WGM;
        u.pm = fm + ((wgid % nig) % gsz); u.pn = (wgid % nig) / gsz; return true;
    }
    __device__ __forceinline__ void a_ready(const Unit&) const {}
    __device__ __forceinline__ void done(const Unit&) const {}
};

__device__ __forceinline__ unsigned cvt_pk_bf16(float lo, float hi) { unsigned r; asm volatile("v_cvt_pk_bf16_f32 %0, %1, %2" : "=v"(r) : "v"(lo), "v"(hi)); return r; }
typedef float f32x2 __attribute__((ext_vector_type(2)));
__device__ __forceinline__ f32x2 gelu_pk(f32x2 v) {
    const f32x2 av = __builtin_elementwise_abs(v), d = av * 0.2316418882f + 1.0f;
    f32x2 t; t.x = __builtin_amdgcn_rcpf(d.x); t.y = __builtin_amdgcn_rcpf(d.y);
    f32x2 q = t * 0.5307027145f + (-0.7265760135f); q = q * t + 0.7107068705f; q = q * t + (-0.142248368f); q = q * t + 0.127414796f; q = q * t;
    const f32x2 s = (v * v) * (-0.72134752044f);
    f32x2 e; e.x = __builtin_amdgcn_exp2f(s.x); e.y = __builtin_amdgcn_exp2f(s.y);
    const f32x2 m = v * (q * e), r = v - m;
    f32x2 o; o.x = v.x < 0.f ? m.x : r.x; o.y = v.y < 0.f ? m.y : r.y; return o;
}

template <int ACT  > struct EpiBf16 {
    static constexpr bool PERM = true, AFTER_DRAIN = false; static_assert(ACT == 0 || ACT == 1, "EpiBf16: ACT is 0 (none) or 1 (gelu_pk)");
    bf16_t* O; int ldc; const float* bias; int split_cols; size_t split_stride; float scale0;
    __device__ __forceinline__ void operator()(const f32x4 (&acc)[2][2][4][2], const Unit& u, int wr, int wc, int fr, int fq) const {
        const int row0 = u.pm * BM + wr * 64 + fr; int colt = u.pn * BM; bf16_t* base = O;
        float sc = 1.f; if (split_cols) { const int t = colt / split_cols; base += (size_t)t * split_stride; colt -= t * split_cols; if (t == 0) sc = scale0; }
        const int col0 = colt + wc * 32 + 8 * fq, bcol0 = u.pn * BM + wc * 32 + 8 * fq;
        f32x4 bv[2][2];
#pragma unroll
        for (int bj = 0; bj < 2; ++bj)
#pragma unroll
            for (int n = 0; n < 2; ++n) bv[bj][n] = bias ? *(const f32x4*)(bias + bcol0 + bj * HALF + 4 * n) : (f32x4){0.f, 0.f, 0.f, 0.f};
#pragma unroll
        for (int ai = 0; ai < 2; ++ai)
#pragma unroll
            for (int m = 0; m < 4; ++m) { bf16_t* rowp = base + (size_t)(row0 + ai * HALF + m * 16) * ldc + col0;
#pragma unroll
                for (int bj = 0; bj < 2; ++bj) { f32x4 v0 = acc[ai][bj][m][0] + bv[bj][0], v1 = acc[ai][bj][m][1] + bv[bj][1];
                    if (ACT == 1) { f32x2 a = gelu_pk((f32x2){v0[0], v0[1]}), b = gelu_pk((f32x2){v0[2], v0[3]}), c = gelu_pk((f32x2){v1[0], v1[1]}), d = gelu_pk((f32x2){v1[2], v1[3]});
                        v0 = (f32x4){a.x, a.y, b.x, b.y}; v1 = (f32x4){c.x, c.y, d.x, d.y}; }
                    v0 = v0 * sc; v1 = v1 * sc; u32x4 w; w.x = cvt_pk_bf16(v0[0], v0[1]); w.y = cvt_pk_bf16(v0[2], v0[3]); w.z = cvt_pk_bf16(v1[0], v1[1]); w.w = cvt_pk_bf16(v1[2], v1[3]);
                    *(u32x4*)(rowp + bj * HALF) = w; } }
    }
};
template <class Epi, class Sched, bool ALIGN_EPI = false, bool SP2 = false>
__device__ __forceinline__ void gemm_phase(PG8_LAS unsigned char* lds, const Gemm g, const Sched& S, const Epi& E) {
    int tid_l = threadIdx.x; asm volatile("" : "+v"(tid_l));
    const int tid = tid_l, wid = __builtin_amdgcn_readfirstlane(tid >> 6), lane = tid & 63, wr = wid >> 2, wc = wid & 3, fr = lane & 15, fq = lane >> 4;
    const int K = g.K, nt = K / BK;
    unsigned voffA[2], voffB[2];
#pragma unroll
    for (int i = 0; i < 2; ++i) { int R, C; stage_rc(tid * 16 + i * 8192, R, C); const int Rb = Epi::PERM ? ((R & ~31) + perm32(R & 31)) : R;
        voffA[i] = (unsigned)(R * K + C) * 2u; voffB[i] = (unsigned)(Rb * K + C) * 2u; }
    const size_t kstep = (size_t)(BK * 2);
    const size_t hstep = (size_t)HALF * K * 2;
    const size_t tstep = 2 * hstep;
    const unsigned ldsw = (unsigned)wid * 1024u;
    const int aoff = lds_byte(wr * 64 + fr, fq * 8), boff = lds_byte(wc * 32 + fr, fq * 8);
#define PG8_SA(b, h) (((b) * 2 + (h)) * HTB)
#define PG8_SB(b, h) ((4 + (b) * 2 + (h)) * HTB)
#define PG8_STAGE(bufoff, gbase, voff) do { _Pragma("unroll") for (int _i = 0; _i < 2; ++_i) \
        __builtin_amdgcn_global_load_lds((const unsigned*)((const char*)(gbase) + (voff)[_i]), (PG8_LAS unsigned*)(lds + (bufoff) + ldsw + _i * 8192), 16, 0, 0); } while (0)
#define PG8_LDA(dst, b, h) do { _Pragma("unroll") for (int m = 0; m < 4; ++m) _Pragma("unroll") for (int k = 0; k < 2; ++k) dst[m][k] = *(const PG8_LAS bf16x8*)(lds + PG8_SA(b, h) + aoff + m * 2048 + k * 1024); } while (0)
#define PG8_LDB(dst, b, h) do { _Pragma("unroll") for (int n = 0; n < 2; ++n) _Pragma("unroll") for (int k = 0; k < 2; ++k) dst[n][k] = *(const PG8_LAS bf16x8*)(lds + PG8_SB(b, h) + boff + n * 2048 + k * 1024); } while (0)
#define PG8_MMA(ai, bj, At, Bt) do { __builtin_amdgcn_s_setprio(1); _Pragma("unroll") for (int m = 0; m < 4; ++m) _Pragma("unroll") for (int n = 0; n < 2; ++n) _Pragma("unroll") for (int k = 0; k < 2; ++k) \
        acc[ai][bj][m][n] = __builtin_amdgcn_mfma_f32_16x16x32_bf16(Bt[n][k], At[m][k], acc[ai][bj][m][n], 0, 0, 0); __builtin_amdgcn_s_setprio(0); } while (0)
#define PG8_WAIT_V(n) asm volatile("s_waitcnt vmcnt(" #n ")" ::: "memory")
#define PG8_WAIT_L(n) asm volatile("s_waitcnt lgkmcnt(" #n ")" ::: "memory")
#define PG8_BAR __builtin_amdgcn_s_barrier()
#define PG8_SCHED __builtin_amdgcn_sched_barrier(0)
    Unit cur, nxt; int ui = 0;
    if (!S.next(0, cur)) return;
    f32x4 acc[2][2][4][2];
#pragma unroll
    for (int a = 0; a < 2; ++a)
#pragma unroll
        for (int b = 0; b < 2; ++b)
#pragma unroll
            for (int m = 0; m < 4; ++m)
#pragma unroll
                for (int n = 0; n < 2; ++n) acc[a][b][m][n] = (f32x4){0.f, 0.f, 0.f, 0.f};
    bf16x8 At[4][2], B0[2][2], B1[2][2];
    const char* cA = (const char*)g.A + (size_t)cur.pm * tstep; const char* cB = (const char*)g.Bt + (size_t)cur.pn * tstep;
    S.a_ready(cur);
    if constexpr (SP2) {
        PG8_STAGE(PG8_SB(0, 0), cB, voffB); PG8_STAGE(PG8_SB(0, 1), cB + hstep, voffB); PG8_STAGE(PG8_SA(0, 0), cA, voffA); PG8_STAGE(PG8_SA(0, 1), cA + hstep, voffA);
        if (wr == 1) PG8_BAR;
        PG8_WAIT_V(2); PG8_BAR;
        PG8_STAGE(PG8_SB(1, 0), cB + kstep, voffB); PG8_STAGE(PG8_SA(1, 0), cA + kstep, voffA); PG8_STAGE(PG8_SB(1, 1), cB + hstep + kstep, voffB);
        PG8_WAIT_V(6); PG8_BAR;
    } else {
        PG8_STAGE(PG8_SB(0, 0), cB, voffB); PG8_STAGE(PG8_SA(0, 0), cA, voffA); PG8_STAGE(PG8_SB(0, 1), cB + hstep, voffB); PG8_STAGE(PG8_SA(0, 1), cA + hstep, voffA);
        if (wr == 1) PG8_BAR;
        PG8_WAIT_V(4); PG8_BAR;
        PG8_STAGE(PG8_SB(1, 0), cB + kstep, voffB); PG8_STAGE(PG8_SA(1, 0), cA + kstep, voffA); PG8_STAGE(PG8_SB(1, 1), cB + hstep + kstep, voffB);
        PG8_WAIT_V(6); PG8_BAR;
    }
    for (;;) {
        const bool has_next = S.next(ui + 1, nxt);
        const char* nA = has_next ? (const char*)g.A + (size_t)nxt.pm * tstep : cA; const char* nB = has_next ? (const char*)g.Bt + (size_t)nxt.pn * tstep : cB;
        for (int t = 0; t < nt; t += 2) {
            const bool last = (t == nt - 2);
            const char* a1 = cA + (size_t)(t + 1) * kstep;
            const char* a2 = last ? nA : cA + (size_t)(t + 2) * kstep; const char* b2 = last ? nB : cB + (size_t)(t + 2) * kstep;
            const char* a3 = a2 + kstep; const char* b3 = b2 + kstep;
            if (last && has_next) S.a_ready(nxt);
            if constexpr (SP2) {
            PG8_LDB(B0, 0, 0); PG8_LDB(B1, 0, 1); PG8_SCHED; PG8_LDA(At, 0, 0); PG8_STAGE(PG8_SA(1, 1), a1 + hstep, voffA);
            PG8_WAIT_V(8); PG8_WAIT_L(0); PG8_BAR; PG8_MMA(0, 0, At, B0); PG8_MMA(0, 1, At, B1); PG8_BAR; PG8_SCHED;
            PG8_LDA(At, 0, 1); PG8_STAGE(PG8_SB(0, 0), b2, voffB); PG8_STAGE(PG8_SB(0, 1), b2 + hstep, voffB); PG8_STAGE(PG8_SA(0, 0), a2, voffA);
            PG8_WAIT_V(8); PG8_WAIT_L(0); PG8_BAR; PG8_MMA(1, 0, At, B0); PG8_MMA(1, 1, At, B1); PG8_BAR; PG8_SCHED;
            PG8_LDB(B0, 1, 0); PG8_LDB(B1, 1, 1); PG8_SCHED; PG8_LDA(At, 1, 0); PG8_STAGE(PG8_SA(0, 1), a2 + hstep, voffA);
            PG8_WAIT_V(8); PG8_WAIT_L(0); PG8_BAR; PG8_MMA(0, 0, At, B0); PG8_MMA(0, 1, At, B1); PG8_BAR; PG8_SCHED;
            PG8_LDA(At, 1, 1); PG8_STAGE(PG8_SB(1, 0), b3, voffB); PG8_STAGE(PG8_SB(1, 1), b3 + hstep, voffB); PG8_STAGE(PG8_SA(1, 0), a3, voffA);
            PG8_WAIT_V(8); PG8_WAIT_L(0); PG8_BAR; PG8_MMA(1, 0, At, B0); PG8_MMA(1, 1, At, B1); PG8_BAR; PG8_SCHED;
            } else {
            PG8_LDB(B0, 0, 0); PG8_SCHED; PG8_LDA(At, 0, 0); PG8_STAGE(PG8_SA(1, 1), a1 + hstep, voffA);
            PG8_WAIT_L(8); PG8_BAR; PG8_WAIT_L(0); PG8_MMA(0, 0, At, B0); PG8_BAR; PG8_SCHED;
            PG8_LDB(B1, 0, 1); PG8_STAGE(PG8_SB(0, 0), b2, voffB);
            PG8_BAR; PG8_WAIT_L(0); PG8_MMA(0, 1, At, B1); PG8_BAR;
            PG8_LDA(At, 0, 1); PG8_STAGE(PG8_SA(0, 0), a2, voffA);
            PG8_BAR; PG8_WAIT_L(0); PG8_MMA(1, 0, At, B0); PG8_BAR; PG8_SCHED;
            PG8_STAGE(PG8_SB(0, 1), b2 + hstep, voffB);
            PG8_WAIT_V(6); PG8_BAR; PG8_MMA(1, 1, At, B1); PG8_BAR;
            PG8_LDB(B0, 1, 0); PG8_SCHED; PG8_LDA(At, 1, 0); PG8_STAGE(PG8_SA(0, 1), a2 + hstep, voffA);
            PG8_WAIT_L(8); PG8_BAR; PG8_WAIT_L(0); PG8_MMA(0, 0, At, B0); PG8_BAR; PG8_SCHED;
            PG8_LDB(B1, 1, 1); PG8_STAGE(PG8_SB(1, 0), b3, voffB);
            PG8_BAR; PG8_WAIT_L(0); PG8_MMA(0, 1, At, B1); PG8_BAR;
            PG8_LDA(At, 1, 1); PG8_STAGE(PG8_SA(1, 0), a3, voffA);
            PG8_BAR; PG8_WAIT_L(0); PG8_MMA(1, 0, At, B0); PG8_BAR; PG8_SCHED;
            PG8_STAGE(PG8_SB(1, 1), b3 + hstep, voffB);
            PG8_WAIT_V(6); PG8_BAR; PG8_MMA(1, 1, At, B1); PG8_BAR;
            }
        }
        if constexpr (ALIGN_EPI) { if (wr == 0) PG8_BAR; }
        if constexpr (!Epi::AFTER_DRAIN) { E(acc, cur, wr, wc, fr, fq); S.done(cur); }
        if (!has_next) break;
#pragma unroll
        for (int a = 0; a < 2; ++a)
#pragma unroll
            for (int b = 0; b < 2; ++b)
#pragma unroll
                for (int m = 0; m < 4; ++m)
#pragma unroll
                    for (int n = 0; n < 2; ++n) acc[a][b][m][n] = (f32x4){0.f, 0.f, 0.f, 0.f};
        cur = nxt; cA = nA; cB = nB; ++ui;
        if constexpr (ALIGN_EPI) { if (wr == 1) PG8_BAR; }
    }
    PG8_WAIT_V(0);
    if constexpr (!ALIGN_EPI) { if (wr == 0) PG8_BAR; }
    PG8_BAR;
    if constexpr (Epi::AFTER_DRAIN) { E.fused(acc, cur, wr, wc, fr, fq, lds, wid, lane); S.done(cur); }
#undef PG8_SA
#undef PG8_SB
#undef PG8_STAGE
#undef PG8_LDA
#undef PG8_LDB
#undef PG8_MMA
#undef PG8_WAIT_V
#undef PG8_WAIT_L
#undef PG8_BAR
#undef PG8_SCHED
}
}
#include <hip/hip_bf16.h>
#include <cmath>
namespace attn_body {
using bf16=__hip_bfloat16;
using bf16x8=__attribute__((ext_vector_type(8)))short;
using s16x4=__attribute__((ext_vector_type(4)))short;
using f32x16=__attribute__((ext_vector_type(16)))float;
using u32x4=__attribute__((ext_vector_type(4)))unsigned;
constexpr int SEQ=4096,D=64,DM=3072;
constexpr int NW=8,QBLK=32,QB=QBLK*NW,KVBLK=64,NQB=SEQ/QB;
constexpr int ATTN_UNIT_ROWS=QB;
__device__ __forceinline__ int crow(int r,int hi){return (r&3)+8*(r>>2)+4*hi;}
#define SBAR() __builtin_amdgcn_sched_barrier(0)
__device__ __forceinline__ void cmask(f32x16&p0,f32x16&p1,int jb,int qrel,int hi){
  asm volatile("":"+v"(qrel),"+v"(hi));
  const float NEG=-INFINITY; int kb=64*jb+4*hi;
  #pragma unroll
  for(int r=0;r<16;++r){int kv=kb+(r&3)+8*(r>>2); if(kv>qrel)p0[r]=NEG; if(kv+32>qrel)p1[r]=NEG;}
}

constexpr int NSLOT=3, SLOTB=8192;
constexpr int LDS_K=0, LDS_V=NSLOT*SLOTB, LDS_WS=2*NSLOT*SLOTB, LDS_OST=LDS_WS+NW*64*4, LDS_FEAT=LDS_OST+NW*4096, LDS_BYTES=LDS_FEAT+SEQ*8;
constexpr float C2=0.125f*1.4426950408889634f;
__device__ __forceinline__ void glds16(const void*gsrc,unsigned lds_dst){unsigned keep;
  asm volatile("s_mov_b32 %0, m0\n\ts_mov_b32 m0, %2\n\ts_nop 0\n\tglobal_load_lds_dwordx4 %1, off\n\ts_mov_b32 m0, %0":"=&s"(keep):"v"(gsrc),"s"(lds_dst):"memory");}
__device__ __forceinline__ float max3f(float a,float b,float c){float r;asm("v_max3_f32 %0, %1, %2, %3":"=v"(r):"v"(a),"v"(b),"v"(c));return r;}
__device__ __forceinline__ float max2f(float a,float b){float r;asm("v_max_f32_e32 %0, %1, %2":"=v"(r):"v"(a),"v"(b));return r;}
__device__ __forceinline__ float fadd_s(float a,float b){float r;asm("v_add_f32_e32 %0, %1, %2":"=v"(r):"v"(a),"v"(b));return r;}
__device__ __forceinline__ float fsub_s(float a,float b){float r;asm("v_sub_f32_e32 %0, %1, %2":"=v"(r):"v"(a),"v"(b));return r;}
typedef float f32x2_t __attribute__((ext_vector_type(2))); typedef __bf16 bf16x2_t __attribute__((ext_vector_type(2)));
__device__ __forceinline__ unsigned cvtpk_s(float lo,float hi){f32x2_t v={lo,hi};bf16x2_t b=__builtin_convertvector(v,bf16x2_t);return __builtin_bit_cast(unsigned,b);}
#define WAIT_BAR(N) asm volatile("s_waitcnt vmcnt(" #N ") lgkmcnt(0)\n\ts_barrier":::"memory")

__device__ __forceinline__ void qkt(f32x16&p0,f32x16&p1,const char*Kslot,const bf16x8*qr,bf16x8 ax0,bf16x8 ax1,bf16x8 qx,int r32,int hi){
  const char*kb=Kslot+hi*1024+r32*16;
  const f32x16 z=f32x16{};
  p0=__builtin_amdgcn_mfma_f32_32x32x16_bf16(ax0,qx,z,0,0,0);p1=__builtin_amdgcn_mfma_f32_32x32x16_bf16(ax1,qx,z,0,0,0);
  #pragma unroll
  for(int d0=0;d0<4;++d0){
    const bf16x8 b0=*reinterpret_cast<const bf16x8*>(kb+d0*2048);
    const bf16x8 b1=*reinterpret_cast<const bf16x8*>(kb+d0*2048+512);
    p0=__builtin_amdgcn_mfma_f32_32x32x16_bf16(b0,qr[d0],p0,0,0,0);p1=__builtin_amdgcn_mfma_f32_32x32x16_bf16(b1,qr[d0],p1,0,0,0);}
}
typedef __attribute__((address_space(3))) const char* lds_cptr;
typedef short v4i16_t __attribute__((ext_vector_type(4)));
__device__ __forceinline__ void kload8(bf16x8*kf,lds_cptr kp){
  kf[0]=*(const __attribute__((address_space(3))) bf16x8*)(kp);      kf[1]=*(const __attribute__((address_space(3))) bf16x8*)(kp+512);
  kf[2]=*(const __attribute__((address_space(3))) bf16x8*)(kp+2048); kf[3]=*(const __attribute__((address_space(3))) bf16x8*)(kp+2560);
  kf[4]=*(const __attribute__((address_space(3))) bf16x8*)(kp+4096); kf[5]=*(const __attribute__((address_space(3))) bf16x8*)(kp+4608);
  kf[6]=*(const __attribute__((address_space(3))) bf16x8*)(kp+6144); kf[7]=*(const __attribute__((address_space(3))) bf16x8*)(kp+6656);
}
__device__ __forceinline__ void kload2(bf16x8*kf,lds_cptr kp,int j){ kf[2*j]=*(const __attribute__((address_space(3))) bf16x8*)(kp+j*2048); kf[2*j+1]=*(const __attribute__((address_space(3))) bf16x8*)(kp+j*2048+512); }
__device__ __forceinline__ s16x4 vtr(lds_cptr p){ return __builtin_bit_cast(s16x4,__builtin_amdgcn_ds_read_tr16_b64_v4i16((__attribute__((address_space(3))) v4i16_t*)p)); }
__device__ __forceinline__ float rowmax(const f32x16&p0,const f32x16&p1){
  float a=max3f(p0[0],p0[1],p1[0]),b=max3f(p0[2],p0[3],p1[1]);a=max3f(a,p1[2],p1[3]);
  #pragma unroll
  for(int r=4;r<16;r+=4){a=max3f(a,p0[r],p0[r+1]);b=max3f(b,p0[r+2],p0[r+3]);a=max3f(a,p1[r],p1[r+1]);b=max3f(b,p1[r+2],p1[r+3]);}
  const float m=max2f(a,b);
  auto rr=__builtin_amdgcn_permlane32_swap(__float_as_uint(m),__float_as_uint(m),false,false);
  return max2f(__uint_as_float(rr[0]),__uint_as_float(rr[1]));
}
__device__ __forceinline__ void pv(f32x16*o,int vb,bf16x8 pa0,bf16x8 pa1,bf16x8 pa2,bf16x8 pa3){
  #pragma unroll
  for(int d0=0;d0<2;++d0){s16x4 lo[4],hi[4];
    #pragma unroll
    for(int ks=0;ks<4;++ks){
      asm volatile("ds_read_b64_tr_b16 %0,%1 offset:%c2":"=&v"(lo[ks]):"v"(vb),"i"(d0*4096+ks*1024):"memory");
      asm volatile("ds_read_b64_tr_b16 %0,%1 offset:%c2":"=&v"(hi[ks]):"v"(vb),"i"(d0*4096+ks*1024+512):"memory");}
    asm volatile("s_waitcnt lgkmcnt(0)":::"memory");SBAR();
    #define PK(k) (bf16x8){lo[k][0],lo[k][1],lo[k][2],lo[k][3],hi[k][0],hi[k][1],hi[k][2],hi[k][3]}
    o[d0]=__builtin_amdgcn_mfma_f32_32x32x16_bf16(pa0,PK(0),o[d0],0,0,0);
    o[d0]=__builtin_amdgcn_mfma_f32_32x32x16_bf16(pa1,PK(1),o[d0],0,0,0);
    o[d0]=__builtin_amdgcn_mfma_f32_32x32x16_bf16(pa2,PK(2),o[d0],0,0,0);
    o[d0]=__builtin_amdgcn_mfma_f32_32x32x16_bf16(pa3,PK(3),o[d0],0,0,0);
    #undef PK
  }
}


typedef unsigned u32x2 __attribute__((ext_vector_type(2)));
__device__ __forceinline__ void split3(float v,unsigned&h16,unsigned&m16,unsigned&l16){
  const unsigned uh=__float_as_uint(v)&0xffff0000u; const float r1=v-__uint_as_float(uh);
  const unsigned um=__float_as_uint(r1)&0xffff0000u; const float r2=r1-__uint_as_float(um);
  const unsigned ul=__float_as_uint(r2); h16=uh>>16; m16=um>>16; l16=(ul+0x7fffu+((ul>>16)&1u))>>16;
}
__device__ __forceinline__ bf16x8 make_qx(float qc){ unsigned h,m,l; split3(qc,h,m,l); const u32x4 w={0x3f803f80u,0x3f80u|(h<<16),m|(l<<16),0u}; return __builtin_bit_cast(bf16x8,w); }
__device__ __forceinline__ void dmask(f32x16&p0,f32x16&p1,int jb,int wid,int r32,int hi,float slope2){
  asm volatile("":"+v"(r32),"+v"(hi));
  const int dj=wid>>1, qrel=32*(wid&1)+r32; const float slope2x2=2.f*slope2;
  if(jb>dj){
    #pragma unroll
    for(int r=0;r<16;++r){p0[r]=-INFINITY;p1[r]=-INFINITY;}
  } else if(jb==dj){
    #pragma unroll
    for(int r=0;r<16;++r){const int kv=4*hi+(r&3)+8*(r>>2); if(kv>qrel)p0[r]-=slope2x2*(float)(kv-qrel); if(kv+32>qrel)p1[r]-=slope2x2*(float)(kv+32-qrel);}
  }
}

template<int MODE,int THRL> __device__ __forceinline__ void attn_pass(int qb,const bf16*Qh,const bf16*__restrict__ Kh,const bf16*__restrict__ Vh,const float*__restrict__ cumf,float slope2,char*shm,f32x16(&o)[2]){
  int tid_l=threadIdx.x; asm volatile("":"+v"(tid_l));
  const int tid=tid_l,lane=tid&63,r32=lane&31,hi=lane>>5; const int wid=__builtin_amdgcn_readfirstlane(tid>>6);
  const int q0=qb*QB;
  const bf16*Qw=Qh+(long)(q0+wid*QBLK)*DM;
  const unsigned lds0=(unsigned)(uintptr_t)shm;
  float*wsf=(float*)(shm+LDS_WS)+wid*64;
  const int NT=(q0+QB)/KVBLK;
  const lds_cptr shm3=(lds_cptr)shm;
  { __attribute__((address_space(3))) u32x2*feat=(__attribute__((address_space(3))) u32x2*)(shm+LDS_FEAT);
    for(int s=tid;s<64*NT;s+=NW*64){ const float kx=(MODE==0)?(-cumf[s]*1.4426950408889634f):(slope2*(float)s); unsigned h,m,l; split3(kx,h,m,l); u32x2 w; w.x=h|(m<<16); w.y=l|0x3f800000u; feat[s]=w; } }
  const __attribute__((address_space(3))) u32x2*featr=(const __attribute__((address_space(3))) u32x2*)(shm3+LDS_FEAT)+lane;
  #define AXF0(f) __builtin_bit_cast(bf16x8,(u32x4){hi?0u:(f).x,hi?0u:(f).y,hi?0u:0x3f803f80u,0u})
  #define AXF1(f) __builtin_bit_cast(bf16x8,(u32x4){hi?(f).x:0u,hi?(f).y:0u,hi?0x3f803f80u:0u,0u})
  const bf16*ksrc=Kh+(long)lane*DM+wid*8;
  const bf16*vsrc=Vh+(long)(16*(wid&3)+(lane>>2))*DM+(wid>>2)*32+(lane&3)*8;
  const unsigned kdst=lds0+LDS_K+wid*1024, vdst=lds0+LDS_V+wid*1024;
  #define DMA_K(t,slot) glds16(ksrc+(long)(t)*KVBLK*DM,(unsigned)__builtin_amdgcn_readfirstlane(kdst+(slot)))
  #define DMA_V(t,slot) glds16(vsrc+(long)(t)*KVBLK*DM,(unsigned)__builtin_amdgcn_readfirstlane(vdst+(slot)))
  const int vb0=(int)(lds0+LDS_V)+((lane>>4)&1)*32+(lane&3)*8+(4*hi+((lane&15)>>2))*64;
  const char*Kbase=shm+LDS_K; bf16x8 kf[8];
  const lds_cptr kp0=shm3+LDS_K+hi*1024+r32*16; const lds_cptr vp0=shm3+LDS_V+((lane>>4)&1)*32+(lane&3)*8+(4*hi+((lane&15)>>2))*64;
  const float qc=(MODE==0)?(cumf[q0+wid*QBLK+r32]*1.4426950408889634f):(-slope2*(float)(q0+wid*QBLK+r32));
  asm volatile("s_waitcnt vmcnt(0)":::"memory");
  DMA_K(0,0);DMA_V(0,0);DMA_K(1,SLOTB);
  bf16x8 qr[4];
  #pragma unroll
  for(int d0=0;d0<4;++d0)qr[d0]=*reinterpret_cast<const bf16x8*>(&Qw[(long)r32*DM+d0*16+hi*8]);
  float qcm=qc,l_reg=0.f;o[0]=f32x16{};o[1]=f32x16{};
  bf16x8 qx=make_qx(qcm);
  const int qrel=wid*QBLK+r32;
  #define CMASK(P0,P1,t) do{int jb_=(t)-(NT-4); if(jb_>=0){ if(MODE==0)cmask(P0,P1,jb_,qrel,hi); else dmask(P0,P1,jb_,wid,r32,hi,slope2);} }while(0)
  bool resc=false;
  #define RESC() do{ if(resc){ asm volatile("s_waitcnt lgkmcnt(0)":::"memory"); \
      _Pragma("unroll") for(int d_=0;d_<2;++d_) _Pragma("unroll") for(int r=0;r<16;++r)o[d_][r]*=wsf[crow(r,hi)]; } }while(0)
  f32x16 pA0,pA1,pB0,pB1;
  int sl_prev=0,sl_cur=0,sl_next=SLOTB;
  #define ROT() do{sl_prev=sl_cur;sl_cur=sl_next;sl_next=(sl_next==(NSLOT-1)*SLOTB)?0:sl_next+SLOTB;}while(0)
  DMA_K(2,2*SLOTB);
  WAIT_BAR(3);
  u32x2 fx=featr[0];
  qkt(pA0,pA1,Kbase,qr,AXF0(fx),AXF1(fx),qx,r32,hi);asm volatile("s_nop 15\n\ts_nop 7":"+v"(pA0),"+v"(pA1));CMASK(pA0,pA1,0);
  { const float rm=rowmax(pA0,pA1); const float dl=(rm>(float)THRL)?rm:0.f; qcm-=dl;
    _Pragma("unroll") for(int r=0;r<16;++r){pA0[r]=fsub_s(pA0[r],dl);pA1[r]=fsub_s(pA1[r],dl);}
    qx=make_qx(qcm);
    _Pragma("unroll") for(int r=0;r<16;++r)pA0[r]=__builtin_amdgcn_exp2f(pA0[r]); }
  _Pragma("unroll") for(int r=0;r<16;++r)pA1[r]=__builtin_amdgcn_exp2f(pA1[r]);
  fx=featr[64];
  WAIT_BAR(0);
  DMA_K(3,0);DMA_V(1,SLOTB);
  ROT();
  kload8(kf,kp0+sl_cur);
  WAIT_BAR(2);
  s16x4 vlo[8],vhi[8]; u32x4 pw0,pw1,pw2,pw3;
  #define PKW(P,B) cvtpk_s(P[B],P[B+1])
  #define PAF(k) __builtin_bit_cast(bf16x8,pw##k)
  #define VFR(i) (bf16x8){vlo[i][0],vlo[i][1],vlo[i][2],vlo[i][3],vhi[i][0],vhi[i][1],vhi[i][2],vhi[i][3]}
  #define PIN(x) asm volatile("":"+v"(x))
  #define MX3(a,b,c) __builtin_fmaxf(__builtin_fmaxf((a),(b)),(c))
  #define GAPA(MF,A0,A1,A2,A3,W0,W1,PW) do{ MF; sacc+=A0; sacc+=A1; sacc+=A2; sacc+=A3; PIN(sacc); W0; W1; PIN(PW); SBAR(); }while(0)
  #define EX(v) __builtin_amdgcn_exp2f(v)
  #define GAPB(MF,X,B) do{ MF; X[B]=EX(X[B]); X[B+1]=EX(X[B+1]); X[B+2]=EX(X[B+2]); X[B+3]=EX(X[B+3]); PIN(X); SBAR(); }while(0)
  #define VRD(i) do{ vlo[i]=vtr(vp_+(((i)>>2)*4096+((i)&3)*1024)); vhi[i]=vtr(vp_+(((i)>>2)*4096+((i)&3)*1024+512)); }while(0)
  #define KRD(G,j) do{ if(G){ kload2(kf,kp0+sl_next,j); SBAR(); } }while(0)
  #define STEP(C0,C1,P0,P1,t,GK,GV,GL) do{ SBAR(); \
    const lds_cptr vp_=vp0+sl_prev; \
    { const bf16x8 ax0_=AXF0(fx), ax1_=AXF1(fx); const f32x16 z_=f32x16{}; \
      C0=__builtin_amdgcn_mfma_f32_32x32x16_bf16(ax0_,qx,z_,0,0,0); C1=__builtin_amdgcn_mfma_f32_32x32x16_bf16(ax1_,qx,z_,0,0,0); SBAR(); } \
    VRD(0); SBAR(); float sacc=(P0[0]+P0[1]); \
    GAPA(C0=__builtin_amdgcn_mfma_f32_32x32x16_bf16(kf[0],qr[0],C0,0,0,0), P0[2],P0[3],P0[4],P0[5],     pw0[0]=PKW(P0,0), pw0[1]=PKW(P0,2), pw0); \
    VRD(4); SBAR(); GAPA(C1=__builtin_amdgcn_mfma_f32_32x32x16_bf16(kf[1],qr[0],C1,0,0,0), P0[6],P0[7],P0[8],P0[9],     pw0[2]=PKW(P0,4), pw0[3]=PKW(P0,6), pw0); \
    VRD(1); SBAR(); GAPA(C0=__builtin_amdgcn_mfma_f32_32x32x16_bf16(kf[2],qr[1],C0,0,0,0),   P0[10],P0[11],P0[12],P0[13], pw1[0]=PKW(P0,8), pw1[1]=PKW(P0,10), pw1); \
    VRD(5); SBAR(); GAPA(C1=__builtin_amdgcn_mfma_f32_32x32x16_bf16(kf[3],qr[1],C1,0,0,0),   P0[14],P0[15],P1[0],P1[1],   pw1[2]=PKW(P0,12),pw1[3]=PKW(P0,14), pw1); \
    VRD(2); SBAR(); GAPA(C0=__builtin_amdgcn_mfma_f32_32x32x16_bf16(kf[4],qr[2],C0,0,0,0),   P1[2],P1[3],P1[4],P1[5],     pw2[0]=PKW(P1,0), pw2[1]=PKW(P1,2), pw2); \
    VRD(6); SBAR(); GAPA(C1=__builtin_amdgcn_mfma_f32_32x32x16_bf16(kf[5],qr[2],C1,0,0,0),   P1[6],P1[7],P1[8],P1[9],     pw2[2]=PKW(P1,4), pw2[3]=PKW(P1,6), pw2); \
    VRD(3); SBAR(); GAPA(C0=__builtin_amdgcn_mfma_f32_32x32x16_bf16(kf[6],qr[3],C0,0,0,0),   P1[10],P1[11],P1[12],P1[13], pw3[0]=PKW(P1,8), pw3[1]=PKW(P1,10), pw3); \
    VRD(7); SBAR(); GAPA(C1=__builtin_amdgcn_mfma_f32_32x32x16_bf16(kf[7],qr[3],C1,0,0,0),   P1[14],P1[15],0.f,0.f,       pw3[2]=PKW(P1,12),pw3[3]=PKW(P1,14), pw3); \
    l_reg+=sacc; \
    if(GK){DMA_K((t)+3,sl_cur);} if(GV){DMA_V((t)+1,sl_next);} \
    CMASK(C0,C1,t); \
    { float a=MX3(C0[0],C0[1],C1[0]),b=MX3(C0[2],C0[3],C1[1]); a=MX3(a,C1[2],C1[3]); \
      _Pragma("unroll") for(int r=4;r<16;r+=4){a=MX3(a,C0[r],C0[r+1]);b=MX3(b,C0[r+2],C0[r+3]);a=MX3(a,C1[r],C1[r+1]);b=MX3(b,C1[r+2],C1[r+3]);} \
      float rm=__builtin_fmaxf(a,b); { auto rr=__builtin_amdgcn_permlane32_swap(__float_as_uint(rm),__float_as_uint(rm),false,false); rm=__builtin_fmaxf(__uint_as_float(rr[0]),__uint_as_float(rr[1])); } \
      resc=false; \
      if(__builtin_expect(__any(rm>(float)THRL),0)){ const float dl=__builtin_fmaxf(rm,0.f); qcm-=dl; \
        _Pragma("unroll") for(int r=0;r<16;++r){C0[r]-=dl;C1[r]-=dl;} \
        qx=make_qx(qcm); \
        const float f=__builtin_amdgcn_exp2f(-dl); l_reg*=f; if(hi==0)wsf[r32]=f; resc=true; } } \
    SBAR(); \
    GAPB(o[0]=__builtin_amdgcn_mfma_f32_32x32x16_bf16(PAF(0),VFR(0),o[0],0,0,0), C0,0); \
    GAPB(o[1]=__builtin_amdgcn_mfma_f32_32x32x16_bf16(PAF(0),VFR(4),o[1],0,0,0), C0,4); \
    KRD(GL,0); GAPB(o[0]=__builtin_amdgcn_mfma_f32_32x32x16_bf16(PAF(1),VFR(1),o[0],0,0,0), C0,8); \
    KRD(GL,1); GAPB(o[1]=__builtin_amdgcn_mfma_f32_32x32x16_bf16(PAF(1),VFR(5),o[1],0,0,0), C0,12); \
    KRD(GL,2); GAPB(o[0]=__builtin_amdgcn_mfma_f32_32x32x16_bf16(PAF(2),VFR(2),o[0],0,0,0), C1,0); \
    KRD(GL,3); GAPB(o[1]=__builtin_amdgcn_mfma_f32_32x32x16_bf16(PAF(2),VFR(6),o[1],0,0,0), C1,4); \
    if(GL){ fx=featr[64*((t)+1)]; SBAR(); } \
    GAPB(o[0]=__builtin_amdgcn_mfma_f32_32x32x16_bf16(PAF(3),VFR(3),o[0],0,0,0), C1,8); \
    GAPB(o[1]=__builtin_amdgcn_mfma_f32_32x32x16_bf16(PAF(3),VFR(7),o[1],0,0,0), C1,12); \
    }while(0)
  int t=1;
  #undef CMASK
  #define CMASK(P0,P1,t) do{}while(0)
  for(;t+5<NT;t+=2){
    STEP(pB0,pB1,pA0,pA1,t,true,true,true);     WAIT_BAR(2); RESC(); ROT();
    STEP(pA0,pA1,pB0,pB1,t+1,true,true,true);   WAIT_BAR(2); RESC(); ROT();
  }
  #undef CMASK
  #define CMASK(P0,P1,t) do{int jb_=(t)-(NT-4); if(jb_>=0){ if(MODE==0)cmask(P0,P1,jb_,qrel,hi); else dmask(P0,P1,jb_,wid,r32,hi,slope2);} }while(0)
  #define ENDW(tt) do{ if((tt)+3<NT){WAIT_BAR(2);} else if((tt)+2<NT){WAIT_BAR(1);} else {WAIT_BAR(0);} }while(0)
  for(;t+1<NT;t+=2){
    STEP(pB0,pB1,pA0,pA1,t,(t+3<NT),(t+1<NT),(t+1<NT));       ENDW(t);   RESC(); ROT();
    STEP(pA0,pA1,pB0,pB1,t+1,(t+4<NT),(t+2<NT),(t+2<NT));     ENDW(t+1); RESC(); ROT();
  }
  STEP(pB0,pB1,pA0,pA1,NT-1,false,false,false); RESC();
  { float sacc=pB0[0]+pB0[1]; _Pragma("unroll") for(int r=2;r<16;++r)sacc+=pB0[r]; _Pragma("unroll") for(int r=0;r<16;++r)sacc+=pB1[r]; l_reg+=sacc;
    pw0=(u32x4){PKW(pB0,0),PKW(pB0,2),PKW(pB0,4),PKW(pB0,6)};pw1=(u32x4){PKW(pB0,8),PKW(pB0,10),PKW(pB0,12),PKW(pB0,14)};pw2=(u32x4){PKW(pB1,0),PKW(pB1,2),PKW(pB1,4),PKW(pB1,6)};pw3=(u32x4){PKW(pB1,8),PKW(pB1,10),PKW(pB1,12),PKW(pB1,14)};
    SBAR(); pv(o,vb0+sl_cur,PAF(0),PAF(1),PAF(2),PAF(3)); }
  #undef PKW
  #undef PAF
  #undef VFR
  #undef PIN
  #undef MX3
  #undef GAPA
  #undef GAPB
  #undef EX
  #undef VRD
  #undef KRD
  #undef STEP
  #undef ENDW
  {auto rr=__builtin_amdgcn_permlane32_swap(__float_as_uint(l_reg),__float_as_uint(l_reg),false,false);l_reg=__uint_as_float(rr[0])+__uint_as_float(rr[1]);}
  if(hi==0)wsf[32+r32]=l_reg;asm volatile("s_waitcnt lgkmcnt(0)":::"memory");
  #pragma unroll
  for(int r=0;r<16;++r){const float rli=__builtin_amdgcn_rcpf(wsf[32+crow(r,hi)]); o[0][r]*=rli; o[1][r]*=rli;}
  asm volatile("s_waitcnt lgkmcnt(0)\n\ts_barrier":::"memory");
  #undef DMA_K
  #undef DMA_V
  #undef CMASK
  #undef RESC
  #undef ROT
  #undef AXF0
  #undef AXF1
}
__device__ __forceinline__ void store_tile_bf16(const f32x16(&o)[2],bf16*dst,int pitch,char*shm,int wid,int lane){
  const int r32=lane&31,hi=lane>>5;
  bf16*stg=(bf16*)(shm+LDS_OST)+wid*2048;
  #pragma unroll
  for(int r=0;r<16;++r){const int orow=crow(r,hi);
    #pragma unroll
    for(int d0=0;d0<2;++d0)stg[orow*64+d0*32+r32]=__float2bfloat16(o[d0][r]);}
  asm volatile("s_waitcnt lgkmcnt(0)":::"memory");
  #pragma unroll
  for(int i=0;i<4;++i){const int row=i*8+(lane>>3),ch=lane&7; const u32x4 v=*(const u32x4*)(stg+row*64+ch*8); *(u32x4*)(dst+(long)row*pitch+ch*8)=v;}
  asm volatile("s_waitcnt lgkmcnt(0)":::"memory");
}
constexpr int ATTN_LDS_BYTES=LDS_BYTES;
#undef SBAR
#undef WAIT_BAR
}

namespace cg = cooperative_groups;
constexpr int BATCH = 16, SEQ = 4096, D = 1024, NTOK = BATCH * SEQ;
constexpr int FH = 8, DH = 4, HD = 64;
constexpr int NPROJ = 3072, IN_COLS = 3080;
constexpr int PH = 8, NKEY = 128, TOPK = 16, PQ = 2048, NEXP = 16384;
constexpr float RMS_EPS = 1e-6f, LOG2E = 1.4426950408889634f, C2 = 0.125f * LOG2E;
constexpr float LAMBDA_INIT = 0.2f;
constexpr int COL_QA = 0, COL_KA = 512, COL_VA = 1024, COL_QB = 1536, COL_KB = 2048, COL_VB = 2560;
constexpr int NWAVES = 8, NTHR = 512;

typedef unsigned short bf16_t;
typedef float f32x4v __attribute__((ext_vector_type(4)));
#define LAS __attribute__((address_space(3)))

constexpr size_t MiB = 1u << 20;
constexpr size_t WS_CTL = 0;
constexpr size_t WS_WIN = 2 * MiB;
constexpr size_t WS_WOUT = 8 * MiB;
constexpr size_t WS_WQ = 10 * MiB;
constexpr size_t WS_LOGF = 16 * MiB;
constexpr size_t WS_CUM = 18 * MiB;
constexpr size_t WS_XN = 96 * MiB;
constexpr size_t WS_PROJ = 224 * MiB;
constexpr size_t WS_Y = 224 * MiB;
constexpr size_t WS_QP = 352 * MiB;
constexpr size_t WS_MIXED = 608 * MiB;
constexpr size_t WS_END = 736 * MiB;
constexpr int LDS_BYTES = 147456;

__device__ __forceinline__ unsigned f2bf(float f) { unsigned u = __builtin_bit_cast(unsigned, f); return (u + 0x7fffu + ((u >> 16) & 1u)) >> 16; }
__device__ __forceinline__ unsigned pk2(float lo, float hi) { return f2bf(lo) | (f2bf(hi) << 16); }
__device__ __forceinline__ float bflo(unsigned w) { return __builtin_bit_cast(float, w << 16); }
__device__ __forceinline__ float bfhi(unsigned w) { return __builtin_bit_cast(float, w & 0xffff0000u); }
__device__ __forceinline__ float wave_sum(float v) {
#pragma unroll
    for (int o = 1; o < 64; o <<= 1) v += __shfl_xor(v, o);
    return v;
}

struct Ctx { int tid, lane, wave, vcu, G, gw, NGW; LAS unsigned char* lds; unsigned char* lds_gen; };

__device__ __forceinline__ void p0_transpose_item(const float* W, int ldw, int K, int ncols, bf16_t* WT, int row_off, float scale, LAS float* scr, int item, int lane) {
    const int nblk = ncols / 32, kb = item / nblk, nb = item % nblk, k0 = 64 * kb, n0 = 32 * nb;
#pragma unroll 8
    for (int i = 0; i < 32; ++i) { const int kk = 2 * i + (lane >> 5); scr[kk * 33 + (lane & 31)] = W[(size_t)(k0 + kk) * ldw + n0 + (lane & 31)] * scale; }
    asm volatile("s_waitcnt lgkmcnt(0)" ::: "memory");
    const int c = lane & 7;
#pragma unroll
    for (int j = 0; j < 4; ++j) { const int n = (lane >> 3) + 8 * j; const LAS float* s = scr + (8 * c) * 33 + n;
        uint4 o; o.x = pk2(s[0 * 33], s[1 * 33]); o.y = pk2(s[2 * 33], s[3 * 33]); o.z = pk2(s[4 * 33], s[5 * 33]); o.w = pk2(s[6 * 33], s[7 * 33]);
        *(uint4*)(WT + (size_t)(row_off + n0 + n) * K + k0 + 8 * c) = o; }
    asm volatile("s_waitcnt lgkmcnt(0)" ::: "memory");
}
__device__ __forceinline__ void p0_weights(const Ctx& c, const float* w_in, const float* w_out, const float* w_q, bf16_t* WIN, bf16_t* WOUT, bf16_t* WQ) {
    LAS float* scr = (LAS float*)(c.lds + c.wave * 16384);
    constexpr int KB = D / 64;
    constexpr int I0 = KB * (512 / 32), I1 = KB * (1024 / 32), I2 = I0, I3 = I1, I4 = KB * (D / 32), I5 = KB * (PQ / 32);
    constexpr int NIT = I0 + I1 + I2 + I3 + I4 + I5;
    for (int it = c.gw; it < NIT; it += c.NGW) {
        int r = it;
        if (r < I0) { p0_transpose_item(w_in + 0, IN_COLS, D, 512, WIN, 0, C2, scr, r, c.lane); continue; } r -= I0;
        if (r < I1) { p0_transpose_item(w_in + 512, IN_COLS, D, 1024, WIN, 512, 1.f, scr, r, c.lane); continue; } r -= I1;
        if (r < I2) { p0_transpose_item(w_in + 1544, IN_COLS, D, 512, WIN, 1536, C2, scr, r, c.lane); continue; } r -= I2;
        if (r < I3) { p0_transpose_item(w_in + 2056, IN_COLS, D, 1024, WIN, 2048, 1.f, scr, r, c.lane); continue; } r -= I3;
        if (r < I4) { p0_transpose_item(w_out, D, D, D, WOUT, 0, 1.f, scr, r, c.lane); continue; } r -= I4;
        p0_transpose_item(w_q, PQ, D, PQ, WQ, 0, 1.f, scr, r, c.lane);
    }
}

__device__ __forceinline__ void rms1_gates_row(int row, int lane, const float* __restrict__ x, const float* __restrict__ g1, const float* __restrict__ w_in, const float* __restrict__ b_f,
                                               bf16_t* __restrict__ XN, float* __restrict__ LOGF) {
    const f32x4v* xr = (const f32x4v*)(x + (size_t)row * D) + lane;
    f32x4v v[4]; float ss = 0.f;
#pragma unroll
    for (int j = 0; j < 4; ++j) { v[j] = xr[64 * j]; ss += (v[j].x * v[j].x + v[j].y * v[j].y) + (v[j].z * v[j].z + v[j].w * v[j].w); }
    ss = wave_sum(ss);
    const float rstd = rsqrtf(ss * (1.f / D) + RMS_EPS);
    float gate[8];
#pragma unroll
    for (int q = 0; q < 8; ++q) gate[q] = 0.f;
    unsigned long long* o8 = (unsigned long long*)(XN + (size_t)row * D) + lane;
#pragma unroll
    for (int j = 0; j < 4; ++j) {
        const f32x4v g = ((const f32x4v*)g1)[lane + 64 * j];
        v[j] = v[j] * rstd * g;
        o8[64 * j] = (unsigned long long)pk2(v[j].x, v[j].y) | ((unsigned long long)pk2(v[j].z, v[j].w) << 32);
#pragma unroll
        for (int e = 0; e < 4; ++e) {
            const int k = 4 * lane + 256 * j + e;
            const f32x4v* wr = (const f32x4v*)(w_in + (size_t)k * IN_COLS + 1536);
            const f32x4v w0 = wr[0], w1 = wr[1]; const float xe = v[j][e];
            gate[0] += xe * w0.x; gate[1] += xe * w0.y; gate[2] += xe * w0.z; gate[3] += xe * w0.w;
            gate[4] += xe * w1.x; gate[5] += xe * w1.y; gate[6] += xe * w1.z; gate[7] += xe * w1.w;
        }
    }
#pragma unroll
    for (int q = 0; q < 8; ++q) gate[q] = wave_sum(gate[q]);
    float gv = gate[0];
#pragma unroll
    for (int q = 1; q < 8; ++q) if (lane == q) gv = gate[q];
    if (lane < 8) {
        const float z = gv + b_f[lane];
        const float ls = fminf(z, 0.f) - log1pf(expf(-fabsf(z)));
        const int b = row / SEQ, t = row % SEQ;
        LOGF[((size_t)b * FH + lane) * SEQ + t] = ls;
    }
}

__device__ __forceinline__ void cumsum_seq(int bh, int lane, const float* __restrict__ LOGF, float* __restrict__ CUM) {
    const float* src = LOGF + (size_t)bh * SEQ + lane * 64; float* dst = CUM + (size_t)bh * SEQ + lane * 64;
    float loc[64]; float run = 0.f;
#pragma unroll
    for (int i = 0; i < 64; ++i) { run += src[i]; loc[i] = run; }
    float incl = run;
#pragma unroll
    for (int o = 1; o < 64; o <<= 1) { const float t = __shfl_up(incl, o); if (lane >= o) incl += t; }
    const float excl = incl - run;
#pragma unroll
    for (int i = 0; i < 64; ++i) dst[i] = loc[i] + excl;
}

constexpr int LDS_LAM = 131072;
constexpr size_t WS_DSCR = 32 * MiB;
__device__ __forceinline__ void fox_unit(const Ctx& c, int b, int h, int qb, const bf16_t* PROJ, const float* CUM, bf16_t* MIXED) {
    using attn_body::bf16; using attn_body::f32x16; using attn_body::attn_pass; using attn_body::store_tile_bf16;
    const bf16* P = (const bf16*)PROJ + (size_t)b * SEQ * NPROJ;
    f32x16 o[2];
    attn_pass<0, 8>(qb, P + COL_QA + h * 64, P + COL_KA + h * 64, P + COL_VA + h * 64, CUM + ((size_t)b * FH + h) * SEQ, 0.f, (char*)c.lds_gen, o);
    int tid_l = threadIdx.x; asm volatile("" : "+v"(tid_l));
    const int lane = tid_l & 63, wave = __builtin_amdgcn_readfirstlane(tid_l >> 6);
    store_tile_bf16(o, (bf16*)MIXED + ((size_t)b * SEQ + qb * 256 + wave * 32) * D + h * 64, D, (char*)c.lds_gen, wave, lane);
}
__device__ __forceinline__ void diff_unit(const Ctx& c, int b, int h, int qb, const bf16_t* PROJ, const float* subg, bf16_t* MIXED, unsigned char* ws) {
    using attn_body::bf16; using attn_body::f32x16; using attn_body::attn_pass; using attn_body::store_tile_bf16;
    f32x16 o[2];
#pragma unroll 1
    for (int pi = 0; pi < 4; ++pi) {
        const int m = pi & 1, half = pi >> 1;
        { const bf16* P = (const bf16*)PROJ + (size_t)b * SEQ * NPROJ; const float slope2 = exp2f(-2.f * (float)(h + 1)) * LOG2E;
          attn_pass<1, 8>(qb, P + COL_QB + h * 128 + m * 64, P + COL_KB + h * 128 + m * 64, P + COL_VB + h * 128 + half * 64, nullptr, slope2, (char*)c.lds_gen, o); }
        int tid_l = threadIdx.x; asm volatile("" : "+v"(tid_l));
        const int lane = tid_l & 63, wave = __builtin_amdgcn_readfirstlane(tid_l >> 6);
        f32x4v* stash = (f32x4v*)(ws + WS_DSCR + ((size_t)blockIdx.x * NWAVES + wave) * 16384) + lane;
        if (m == 0) {
#pragma unroll
            for (int i = 0; i < 8; ++i) { const int d0 = i >> 2, r = (i & 3) * 4; stash[i * 64] = (f32x4v){o[d0][r], o[d0][r + 1], o[d0][r + 2], o[d0][r + 3]}; }
        } else {
            const float lam = ((const LAS float*)(c.lds + LDS_LAM))[0];
            asm volatile("s_waitcnt vmcnt(0)" ::: "memory");
#pragma unroll
            for (int i = 0; i < 8; ++i) { const int d0 = i >> 2, r = (i & 3) * 4; const f32x4v a = stash[i * 64];
                o[d0][r] = a.x - lam * o[d0][r]; o[d0][r + 1] = a.y - lam * o[d0][r + 1]; o[d0][r + 2] = a.z - lam * o[d0][r + 2]; o[d0][r + 3] = a.w - lam * o[d0][r + 3]; }
            if (half == 0) {
#pragma unroll
                for (int i = 0; i < 8; ++i) { const int d0 = i >> 2, r = (i & 3) * 4; stash[512 + i * 64] = (f32x4v){o[d0][r], o[d0][r + 1], o[d0][r + 2], o[d0][r + 3]}; }
            } else {
                f32x16 y0[2]; const int r32 = lane & 31;
#pragma unroll
                for (int i = 0; i < 8; ++i) { const int d0 = i >> 2, r = (i & 3) * 4; const f32x4v a = stash[512 + i * 64]; y0[d0][r] = a.x; y0[d0][r + 1] = a.y; y0[d0][r + 2] = a.z; y0[d0][r + 3] = a.w; }
                const float g00 = subg[r32], g01 = subg[32 + r32], g10 = subg[64 + r32], g11 = subg[96 + r32];
#pragma unroll
                for (int r = 0; r < 16; ++r) {
                    float ss = (y0[0][r] * y0[0][r] + y0[1][r] * y0[1][r]) + (o[0][r] * o[0][r] + o[1][r] * o[1][r]);
#pragma unroll
                    for (int off = 1; off < 32; off <<= 1) ss += __shfl_xor(ss, off);
                    const float rn = rsqrtf(ss * (1.f / 128.f) + RMS_EPS) * (1.f - LAMBDA_INIT);
                    y0[0][r] *= rn * g00; y0[1][r] *= rn * g01; o[0][r] *= rn * g10; o[1][r] *= rn * g11;
                }
                bf16* dst = (bf16*)MIXED + ((size_t)b * SEQ + qb * 256 + wave * 32) * D + 512 + h * 128;
                store_tile_bf16(y0, dst, D, (char*)c.lds_gen, wave, lane);
                store_tile_bf16(o, dst + 64, D, (char*)c.lds_gen, wave, lane);
            }
        }
    }
}

__device__ __forceinline__ void resid_rms2_row(int row, int lane, const float* __restrict__ x, const bf16_t* __restrict__ Y, const float* __restrict__ g2, float* __restrict__ H, bf16_t* __restrict__ HN) {
    const f32x4v* xr = (const f32x4v*)(x + (size_t)row * D) + lane;
    const uint2* yr = (const uint2*)(Y + (size_t)row * D) + lane;
    f32x4v* hr = (f32x4v*)(H + (size_t)row * D) + lane;
    f32x4v v[4]; float ss = 0.f;
#pragma unroll
    for (int j = 0; j < 4; ++j) { const uint2 y = yr[64 * j]; v[j] = xr[64 * j]; v[j].x += bflo(y.x); v[j].y += bfhi(y.x); v[j].z += bflo(y.y); v[j].w += bfhi(y.y);
        hr[64 * j] = v[j]; ss += (v[j].x * v[j].x + v[j].y * v[j].y) + (v[j].z * v[j].z + v[j].w * v[j].w); }
    ss = wave_sum(ss);
    const float rstd = rsqrtf(ss * (1.f / D) + RMS_EPS);
    unsigned long long* o8 = (unsigned long long*)(HN + (size_t)row * D) + lane;
#pragma unroll
    for (int j = 0; j < 4; ++j) { const f32x4v g = ((const f32x4v*)g2)[lane + 64 * j]; const f32x4v w = v[j] * rstd * g;
        o8[64 * j] = (unsigned long long)pk2(w.x, w.y) | ((unsigned long long)pk2(w.z, w.w) << 32); }
}

__device__ __forceinline__ void peer_token(int tok, int lane, LAS float* qs  , const bf16_t* __restrict__ QP, const float* __restrict__ subk, const bf16_t* __restrict__ HN,
                                           const float* __restrict__ U, const float* __restrict__ V, const float* __restrict__ fg, float* __restrict__ H) {
    f32x4v xv[4], acc[4];
    { const uint2* hr = (const uint2*)(HN + (size_t)tok * D) + lane;
#pragma unroll
      for (int j = 0; j < 4; ++j) { const uint2 y = hr[64 * j]; xv[j] = (f32x4v){bflo(y.x), bfhi(y.x), bflo(y.y), bfhi(y.y)}; acc[j] = (f32x4v){0.f, 0.f, 0.f, 0.f}; } }
    for (int h = 0; h < PH; ++h) {
        asm volatile("s_waitcnt lgkmcnt(0)" ::: "memory");
        { const uint2 raw = *((const uint2*)(QP + (size_t)tok * PQ + h * 256) + lane);
          qs[4 * lane + 0] = bflo(raw.x); qs[4 * lane + 1] = bfhi(raw.x); qs[4 * lane + 2] = bflo(raw.y); qs[4 * lane + 3] = bfhi(raw.y); }
        asm volatile("s_waitcnt lgkmcnt(0)" ::: "memory");
        float sc[2][2];
#pragma unroll
        for (int p = 0; p < 2; ++p)
#pragma unroll
            for (int w = 0; w < 2; ++w) {
                const int key = lane + 64 * w;
                const f32x4v* kr = (const f32x4v*)(subk + (((size_t)h * 2 + p) * NKEY + key) * 128);
                const LAS f32x4v* qv = (const LAS f32x4v*)(qs + p * 128);
                float a = 0.f;
#pragma unroll 8
                for (int d = 0; d < 32; ++d) { const f32x4v kk = kr[d], cc = qv[d]; a += (kk.x * cc.x + kk.y * cc.y) + (kk.z * cc.z + kk.w * cc.w); }
                sc[p][w] = a;
            }
        float ts[2]; int ti[2]; ts[0] = ts[1] = 0.f; ti[0] = ti[1] = 0;
#pragma unroll
        for (int p = 0; p < 2; ++p) {
            float v0 = sc[p][0], v1 = sc[p][1];
            for (int r = 0; r < TOPK; ++r) {
                float bv; int bi; if (v1 > v0) { bv = v1; bi = lane + 64; } else { bv = v0; bi = lane; }
#pragma unroll
                for (int off = 32; off >= 1; off >>= 1) { const float ov = __shfl_xor(bv, off); const int oi = __shfl_xor(bi, off); if (ov > bv || (ov == bv && oi < bi)) { bv = ov; bi = oi; } }
                if (lane == r) { ts[p] = bv; ti[p] = bi; }
                if (bi == lane) v0 = -INFINITY; if (bi == lane + 64) v1 = -INFINITY;
            }
        }
        float cv[4];
#pragma unroll
        for (int w = 0; w < 4; ++w) { const int cc = lane + 64 * w; cv[w] = __shfl(ts[0], cc >> 4) + __shfl(ts[1], cc & 15); }
        float fs = 0.f; int fc = 0;
        for (int r = 0; r < TOPK; ++r) {
            float bv = cv[0]; int bi = lane;
#pragma unroll
            for (int w = 1; w < 4; ++w) if (cv[w] > bv) { bv = cv[w]; bi = lane + 64 * w; }
#pragma unroll
            for (int off = 32; off >= 1; off >>= 1) { const float ov = __shfl_xor(bv, off); const int oi = __shfl_xor(bi, off); if (ov > bv || (ov == bv && oi < bi)) { bv = ov; bi = oi; } }
            if (lane == r) { fs = bv; fc = bi; }
#pragma unroll
            for (int w = 0; w < 4; ++w) if (bi == lane + 64 * w) cv[w] = -INFINITY;
        }
        const int ia = __shfl(ti[0], fc >> 4), ib = __shfl(ti[1], fc & 15);
        const float mx = __shfl(fs, 0);
        const float ee = (lane < TOPK) ? expf(fs - mx) : 0.f;
        const float sum = wave_sum(ee);
        const int el = ia * NKEY + ib; const float gl = ee / sum;
        for (int r = 0; r < TOPK; ++r) {
            const int e = __shfl(el, r); const float g = __shfl(gl, r);
            const f32x4v* ur = (const f32x4v*)(U + (size_t)e * D) + lane;
            const f32x4v* vr = (const f32x4v*)(V + (size_t)e * D) + lane;
            float dot = 0.f;
#pragma unroll
            for (int j = 0; j < 4; ++j) { const f32x4v u = ur[64 * j]; dot += (u.x * xv[j].x + u.y * xv[j].y) + (u.z * xv[j].z + u.w * xv[j].w); }
            dot = wave_sum(dot);
            const float hid = 0.5f * dot * (1.f + erff(dot * 0.70710678118654752f)) * g;
#pragma unroll
            for (int j = 0; j < 4; ++j) acc[j] += hid * vr[64 * j];
        }
    }
    f32x4v* hr = (f32x4v*)(H + (size_t)tok * D) + lane; float ss = 0.f;
#pragma unroll
    for (int j = 0; j < 4; ++j) { acc[j] += hr[64 * j]; ss += (acc[j].x * acc[j].x + acc[j].y * acc[j].y) + (acc[j].z * acc[j].z + acc[j].w * acc[j].w); }
    ss = wave_sum(ss);
    const float rstd = rsqrtf(ss * (1.f / D) + RMS_EPS);
#pragma unroll
    for (int j = 0; j < 4; ++j) hr[64 * j] = acc[j] * rstd * ((const f32x4v*)fg)[lane + 64 * j];
}

struct Args { const float* in[16]; float* out; unsigned char* ws; };
#define CAS __attribute__((address_space(4)))
#define PHASE_PROLOGUE() \
    const CAS Args* ap = (const CAS Args*)__builtin_amdgcn_kernarg_segment_ptr(); asm volatile("" : "+s"(ap)); \
    Ctx c; { int t_ = threadIdx.x; asm volatile("" : "+v"(t_)); c.tid = t_; } c.lane = c.tid & 63; c.wave = __builtin_amdgcn_readfirstlane(c.tid >> 6); c.G = gridDim.x; \
    { const int bx = blockIdx.x; c.vcu = (c.G % 8 == 0) ? (bx % 8) * (c.G / 8) + bx / 8 : bx; } \
    c.gw = c.vcu * NWAVES + c.wave; c.NGW = c.G * NWAVES; c.lds = (LAS unsigned char*)lds_raw; c.lds_gen = lds_raw; \
    unsigned char* ws = ap->ws; (void)ws
#define IN(k) (ap->in[k])
__global__ void __launch_bounds__(NTHR, 2) fwd_megakernel(Args a_unused) {
    extern __shared__ __attribute__((aligned(16))) unsigned char lds_raw[];
    { PHASE_PROLOGUE();
      p0_weights(c, IN(2), IN(9), IN(11), (bf16_t*)(ws + WS_WIN), (bf16_t*)(ws + WS_WOUT), (bf16_t*)(ws + WS_WQ));
      for (int row = c.gw; row < NTOK; row += c.NGW) rms1_gates_row(row, c.lane, IN(0), IN(1), IN(2), IN(3), (bf16_t*)(ws + WS_XN), (float*)(ws + WS_LOGF)); }
    cg::this_grid().sync();
    { PHASE_PROLOGUE();
      if (c.gw < BATCH * FH) cumsum_seq(c.gw, c.lane, (const float*)(ws + WS_LOGF), (float*)(ws + WS_CUM));
      __syncthreads(); }
    { PHASE_PROLOGUE();
      pg8::Gemm g{(const bf16_t*)(ws + WS_XN), (const bf16_t*)(ws + WS_WIN), NTOK, NPROJ, D}; pg8::StaticOrder S; S.init(NTOK, NPROJ, c.G, (int)blockIdx.x);
      pg8::EpiBf16<0> E{(bf16_t*)(ws + WS_PROJ), NPROJ, nullptr, 0, 0, 1.f};
      pg8::gemm_phase<pg8::EpiBf16<0>, pg8::StaticOrder, true, true>(c.lds, g, S, E); }
    cg::this_grid().sync();
    { PHASE_PROLOGUE();
      for (int pu = c.vcu; pu < BATCH * FH * 8; pu += c.G) { const int bh = pu >> 3, s = pu & 7;
          fox_unit(c, bh / FH, bh % FH, 15 - s, (const bf16_t*)(ws + WS_PROJ), (const float*)(ws + WS_CUM), (bf16_t*)(ws + WS_MIXED));
          fox_unit(c, bh / FH, bh % FH, s, (const bf16_t*)(ws + WS_PROJ), (const float*)(ws + WS_CUM), (bf16_t*)(ws + WS_MIXED)); } }
    { PHASE_PROLOGUE();
      const float lam = expf(wave_sum(IN(4)[c.lane] * IN(5)[c.lane])) - expf(wave_sum(IN(6)[c.lane] * IN(7)[c.lane])) + LAMBDA_INIT;
      if (c.tid == 0) ((LAS float*)(c.lds + LDS_LAM))[0] = lam;
      __syncthreads(); }
    { PHASE_PROLOGUE();
      for (int pu = c.vcu; pu < BATCH * DH * 8; pu += c.G) { const int bh = pu >> 3, s = pu & 7;
          diff_unit(c, bh / DH, bh % DH, 15 - s, (const bf16_t*)(ws + WS_PROJ), IN(8), (bf16_t*)(ws + WS_MIXED), ws);
          diff_unit(c, bh / DH, bh % DH, s, (const bf16_t*)(ws + WS_PROJ), IN(8), (bf16_t*)(ws + WS_MIXED), ws); } }
    cg::this_grid().sync();
    { PHASE_PROLOGUE();
      pg8::Gemm g{(const bf16_t*)(ws + WS_MIXED), (const bf16_t*)(ws + WS_WOUT), NTOK, D, D}; pg8::StaticOrder S; S.init(NTOK, D, c.G, (int)blockIdx.x);
      pg8::EpiBf16<0> E{(bf16_t*)(ws + WS_Y), D, nullptr, 0, 0, 1.f};
      pg8::gemm_phase<pg8::EpiBf16<0>, pg8::StaticOrder, true, true>(c.lds, g, S, E); }
    cg::this_grid().sync();
    { PHASE_PROLOGUE();
      for (int row = c.gw; row < NTOK; row += c.NGW) resid_rms2_row(row, c.lane, IN(0), (const bf16_t*)(ws + WS_Y), IN(10), ap->out, (bf16_t*)(ws + WS_XN)); }
    cg::this_grid().sync();
    { PHASE_PROLOGUE();
      pg8::Gemm g{(const bf16_t*)(ws + WS_XN), (const bf16_t*)(ws + WS_WQ), NTOK, PQ, D}; pg8::StaticOrder S; S.init(NTOK, PQ, c.G, (int)blockIdx.x);
      pg8::EpiBf16<0> E{(bf16_t*)(ws + WS_QP), PQ, nullptr, 0, 0, 1.f};
      pg8::gemm_phase<pg8::EpiBf16<0>, pg8::StaticOrder, true, true>(c.lds, g, S, E); }
    cg::this_grid().sync();
    { PHASE_PROLOGUE();
      LAS float* qs = (LAS float*)(c.lds + c.wave * 1024);
      for (int tok = c.gw; tok < NTOK; tok += c.NGW) peer_token(tok, c.lane, qs, (const bf16_t*)(ws + WS_QP), IN(12), (const bf16_t*)(ws + WS_XN), IN(13), IN(14), IN(15), ap->out); }
}

extern "C" void kernel_launch(void* const* d_in, const int* in_sizes, int n_in, void* d_out, int out_size, void* d_ws, size_t ws_size, hipStream_t stream) {
    static int grid = 0;
    if (grid == 0) {
        if (n_in != 16 || in_sizes[0] != NTOK * D || out_size != NTOK * D || ws_size < WS_END) { fprintf(stderr, "kernel_launch: unexpected shapes (n_in %d in0 %d out %d ws %zu)\n", n_in, in_sizes[0], out_size, ws_size); grid = -1; return; }
        int dev = 0, cus = 0, per_cu = 0;
        if (hipGetDevice(&dev) != hipSuccess || hipDeviceGetAttribute(&cus, hipDeviceAttributeMultiprocessorCount, dev) != hipSuccess) { grid = -1; return; }
        if (hipFuncSetAttribute((const void*)fwd_megakernel, hipFuncAttributeMaxDynamicSharedMemorySize, LDS_BYTES) != hipSuccess) { fprintf(stderr, "hipFuncSetAttribute failed\n"); grid = -1; return; }
        if (hipOccupancyMaxActiveBlocksPerMultiprocessor(&per_cu, (const void*)fwd_megakernel, NTHR, LDS_BYTES) != hipSuccess || per_cu < 1) { fprintf(stderr, "occupancy query failed (%d)\n", per_cu); grid = -1; return; }
        grid = cus;
    }
    if (grid < 0) return;
    Args a{};
    for (int i = 0; i < 16; ++i) a.in[i] = (const float*)d_in[i];
    a.out = (float*)d_out; a.ws = (unsigned char*)d_ws;
    void* args[] = {&a};
    hipError_t e = hipLaunchCooperativeKernel((const void*)fwd_megakernel, dim3(grid), dim3(NTHR), args, LDS_BYTES, stream);
    if (e != hipSuccess) fprintf(stderr, "cooperative launch failed: %s (grid %d)\n", hipGetErrorString(e), grid);
}
```

```cpp
#include <hip/hip_runtime.h>
#include <hip/hip_cooperative_groups.h>
#include <cstdio>
#include <cstdint>
#include <cmath>
namespace pg8 {
#define PG8_LAS __attribute__((address_space(3)))
typedef unsigned short bf16_t;
typedef short bf16x8 __attribute__((ext_vector_type(8)));
typedef float f32x4 __attribute__((ext_vector_type(4)));
typedef unsigned u32x4 __attribute__((ext_vector_type(4)));
constexpr int BM = 256, BK = 64, HALF = 128, HTB = HALF * BK * 2  , STAGE_BYTES = 8 * HTB, NXCD = 8, WGM = 8;

__host__ __device__ __forceinline__ int lds_byte(int r, int c) { const int st = (r >> 4) * 2 + (c >> 5), rr = r & 15, cc = c & 31, ob = rr * 64 + cc * 2; return st * 1024 + (ob ^ (((ob >> 9) & 1) << 5)); }
__host__ __device__ __forceinline__ void stage_rc(int b, int& R, int& C) { const int st = b / 1024, sb = b % 1024, swz = sb ^ (((sb >> 9) & 1) << 5); R = (st >> 1) * 16 + swz / 64; C = (st & 1) * 32 + (swz % 64) / 2; }
__host__ __device__ __forceinline__ int perm32(int rho) { const int n = rho >> 4, i = rho & 15; return 8 * (i >> 2) + 4 * n + (i & 3); }

struct Unit { int pm, pn; };
struct Gemm { const bf16_t* A; const bf16_t* Bt; int M, N, K; };

struct StaticOrder {
    int nM, nN, nwg, G, c;
    __host__ __device__ void init(int M, int N, int G_, int c_) { nM = M / BM; nN = N / BM; nwg = nM * nN; G = G_; c = c_; }
    __host__ __device__ bool next(int i, Unit& u) const {
        const long L = (long)i * G + c; if (L >= nwg) return false;
        int wgid = (int)L; { const int q = nwg / NXCD, r = nwg % NXCD, xcd = wgid % NXCD, off = wgid / NXCD; wgid = (xcd < r ? xcd * (q + 1) : r * (q + 1) + (xcd - r) * q) + off; }
        const int nig = WGM * nN, gid = wgid / nig, fm = gid * WGM, gsz = (nM - fm) < WGM ? (nM - fm) : WGM;
        u.pm = fm + ((wgid % nig) % gsz); u.pn = (wgid % nig) / gsz; return true;
    }
    __device__ __forceinline__ void a_ready(const Unit&) const {}
    __device__ __forceinline__ void done(const Unit&) const {}
};

__device__ __forceinline__ unsigned cvt_pk_bf16(float lo, float hi) { unsigned r; asm volatile("v_cvt_pk_bf16_f32 %0, %1, %2" : "=v"(r) : "v"(lo), "v"(hi)); return r; }
typedef float f32x2 __attribute__((ext_vector_type(2)));
__device__ __forceinline__ f32x2 gelu_pk(f32x2 v) {
    const f32x2 av = __builtin_elementwise_abs(v), d = av * 0.2316418882f + 1.0f;
    f32x2 t; t.x = __builtin_amdgcn_rcpf(d.x); t.y = __builtin_amdgcn_rcpf(d.y);
    f32x2 q = t * 0.5307027145f + (-0.7265760135f); q = q * t + 0.7107068705f; q = q * t + (-0.142248368f); q = q * t + 0.127414796f; q = q * t;
    const f32x2 s = (v * v) * (-0.72134752044f);
    f32x2 e; e.x = __builtin_amdgcn_exp2f(s.x); e.y = __builtin_amdgcn_exp2f(s.y);
    const f32x2 m = v * (q * e), r = v - m;
    f32x2 o; o.x = v.x < 0.f ? m.x : r.x; o.y = v.y < 0.f ? m.y : r.y; return o;
}

template <int ACT  > struct EpiBf16 {
    static constexpr bool PERM = true, AFTER_DRAIN = false; static_assert(ACT == 0 || ACT == 1, "EpiBf16: ACT is 0 (none) or 1 (gelu_pk)");
    bf16_t* O; int ldc; const float* bias; int split_cols; size_t split_stride; float scale0;
    __device__ __forceinline__ void operator()(const f32x4 (&acc)[2][2][4][2], const Unit& u, int wr, int wc, int fr, int fq) const {
        const int row0 = u.pm * BM + wr * 64 + fr; int colt = u.pn * BM; bf16_t* base = O;
        float sc = 1.f; if (split_cols) { const int t = colt / split_cols; base += (size_t)t * split_stride; colt -= t * split_cols; if (t == 0) sc = scale0; }
        const int col0 = colt + wc * 32 + 8 * fq, bcol0 = u.pn * BM + wc * 32 + 8 * fq;
        f32x4 bv[2][2];
#pragma unroll
        for (int bj = 0; bj < 2; ++bj)
#pragma unroll
            for (int n = 0; n < 2; ++n) bv[bj][n] = bias ? *(const f32x4*)(bias + bcol0 + bj * HALF + 4 * n) : (f32x4){0.f, 0.f, 0.f, 0.f};
#pragma unroll
        for (int ai = 0; ai < 2; ++ai)
#pragma unroll
            for (int m = 0; m < 4; ++m) { bf16_t* rowp = base + (size_t)(row0 + ai * HALF + m * 16) * ldc + col0;
#pragma unroll
                for (int bj = 0; bj < 2; ++bj) { f32x4 v0 = acc[ai][bj][m][0] + bv[bj][0], v1 = acc[ai][bj][m][1] + bv[bj][1];
                    if (ACT == 1) { f32x2 a = gelu_pk((f32x2){v0[0], v0[1]}), b = gelu_pk((f32x2){v0[2], v0[3]}), c = gelu_pk((f32x2){v1[0], v1[1]}), d = gelu_pk((f32x2){v1[2], v1[3]});
                        v0 = (f32x4){a.x, a.y, b.x, b.y}; v1 = (f32x4){c.x, c.y, d.x, d.y}; }
                    v0 = v0 * sc; v1 = v1 * sc; u32x4 w; w.x = cvt_pk_bf16(v0[0], v0[1]); w.y = cvt_pk_bf16(v0[2], v0[3]); w.z = cvt_pk_bf16(v1[0], v1[1]); w.w = cvt_pk_bf16(v1[2], v1[3]);
                    *(u32x4*)(rowp + bj * HALF) = w; } }
    }
};
template <class Epi, class Sched, bool ALIGN_EPI = false, bool SP2 = false>
__device__ __forceinline__ void gemm_phase(PG8_LAS unsigned char* lds, const Gemm g, const Sched& S, const Epi& E) {
    int tid_l = threadIdx.x; asm volatile("" : "+v"(tid_l));
    const int tid = tid_l, wid = __builtin_amdgcn_readfirstlane(tid >> 6), lane = tid & 63, wr = wid >> 2, wc = wid & 3, fr = lane & 15, fq = lane >> 4;
    const int K = g.K, nt = K / BK;
    unsigned voffA[2], voffB[2];
#pragma unroll
    for (int i = 0; i < 2; ++i) { int R, C; stage_rc(tid * 16 + i * 8192, R, C); const int Rb = Epi::PERM ? ((R & ~31) + perm32(R & 31)) : R;
        voffA[i] = (unsigned)(R * K + C) * 2u; voffB[i] = (unsigned)(Rb * K + C) * 2u; }
    const size_t kstep = (size_t)(BK * 2);
    const size_t hstep = (size_t)HALF * K * 2;
    const size_t tstep = 2 * hstep;
    const unsigned ldsw = (unsigned)wid * 1024u;
    const int aoff = lds_byte(wr * 64 + fr, fq * 8), boff = lds_byte(wc * 32 + fr, fq * 8);
#define PG8_SA(b, h) (((b) * 2 + (h)) * HTB)
#define PG8_SB(b, h) ((4 + (b) * 2 + (h)) * HTB)
#define PG8_STAGE(bufoff, gbase, voff) do { _Pragma("unroll") for (int _i = 0; _i < 2; ++_i) \
        __builtin_amdgcn_global_load_lds((const unsigned*)((const char*)(gbase) + (voff)[_i]), (PG8_LAS unsigned*)(lds + (bufoff) + ldsw + _i * 8192), 16, 0, 0); } while (0)
#define PG8_LDA(dst, b, h) do { _Pragma("unroll") for (int m = 0; m < 4; ++m) _Pragma("unroll") for (int k = 0; k < 2; ++k) dst[m][k] = *(const PG8_LAS bf16x8*)(lds + PG8_SA(b, h) + aoff + m * 2048 + k * 1024); } while (0)
#define PG8_LDB(dst, b, h) do { _Pragma("unroll") for (int n = 0; n < 2; ++n) _Pragma("unroll") for (int k = 0; k < 2; ++k) dst[n][k] = *(const PG8_LAS bf16x8*)(lds + PG8_SB(b, h) + boff + n * 2048 + k * 1024); } while (0)
#define PG8_MMA(ai, bj, At, Bt) do { __builtin_amdgcn_s_setprio(1); _Pragma("unroll") for (int m = 0; m < 4; ++m) _Pragma("unroll") for (int n = 0; n < 2; ++n) _Pragma("unroll") for (int k = 0; k < 2; ++k) \
        acc[ai][bj][m][n] = __builtin_amdgcn_mfma_f32_16x16x32_bf16(Bt[n][k], At[m][k], acc[ai][bj][m][n], 0, 0, 0); __builtin_amdgcn_s_setprio(0); } while (0)
#define PG8_WAIT_V(n) asm volatile("s_waitcnt vmcnt(" #n ")" ::: "memory")
#define PG8_WAIT_L(n) asm volatile("s_waitcnt lgkmcnt(" #n ")" ::: "memory")
#define PG8_BAR __builtin_amdgcn_s_barrier()
#define PG8_SCHED __builtin_amdgcn_sched_barrier(0)
    Unit cur, nxt; int ui = 0;
    if (!S.next(0, cur)) return;
    f32x4 acc[2][2][4][2];
#pragma unroll
    for (int a = 0; a < 2; ++a)
#pragma unroll
        for (int b = 0; b < 2; ++b)
#pragma unroll
            for (int m = 0; m < 4; ++m)
#pragma unroll
                for (int n = 0; n < 2; ++n) acc[a][b][m][n] = (f32x4){0.f, 0.f, 0.f, 0.f};
    bf16x8 At[4][2], B0[2][2], B1[2][2];
    const char* cA = (const char*)g.A + (size_t)cur.pm * tstep; const char* cB = (const char*)g.Bt + (size_t)cur.pn * tstep;
    S.a_ready(cur);
    if constexpr (SP2) {
        PG8_STAGE(PG8_SB(0, 0), cB, voffB); PG8_STAGE(PG8_SB(0, 1), cB + hstep, voffB); PG8_STAGE(PG8_SA(0, 0), cA, voffA); PG8_STAGE(PG8_SA(0, 1), cA + hstep, voffA);
        if (wr == 1) PG8_BAR;
        PG8_WAIT_V(2); PG8_BAR;
        PG8_STAGE(PG8_SB(1, 0), cB + kstep, voffB); PG8_STAGE(PG8_SA(1, 0), cA + kstep, voffA); PG8_STAGE(PG8_SB(1, 1), cB + hstep + kstep, voffB);
        PG8_WAIT_V(6); PG8_BAR;
    } else {
        PG8_STAGE(PG8_SB(0, 0), cB, voffB); PG8_STAGE(PG8_SA(0, 0), cA, voffA); PG8_STAGE(PG8_SB(0, 1), cB + hstep, voffB); PG8_STAGE(PG8_SA(0, 1), cA + hstep, voffA);
        if (wr == 1) PG8_BAR;
        PG8_WAIT_V(4); PG8_BAR;
        PG8_STAGE(PG8_SB(1, 0), cB + kstep, voffB); PG8_STAGE(PG8_SA(1, 0), cA + kstep, voffA); PG8_STAGE(PG8_SB(1, 1), cB + hstep + kstep, voffB);
        PG8_WAIT_V(6); PG8_BAR;
    }
    for (;;) {
        const bool has_next = S.next(ui + 1, nxt);
        const char* nA = has_next ? (const char*)g.A + (size_t)nxt.pm * tstep : cA; const char* nB = has_next ? (const char*)g.Bt + (size_t)nxt.pn * tstep : cB;
        for (int t = 0; t < nt; t += 2) {
            const bool last = (t == nt - 2);
            const char* a1 = cA + (size_t)(t + 1) * kstep;
            const char* a2 = last ? nA : cA + (size_t)(t + 2) * kstep; const char* b2 = last ? nB : cB + (size_t)(t + 2) * kstep;
            const char* a3 = a2 + kstep; const char* b3 = b2 + kstep;
            if (last && has_next) S.a_ready(nxt);
            if constexpr (SP2) {
            PG8_LDB(B0, 0, 0); PG8_LDB(B1, 0, 1); PG8_SCHED; PG8_LDA(At, 0, 0); PG8_STAGE(PG8_SA(1, 1), a1 + hstep, voffA);
            PG8_WAIT_V(8); PG8_WAIT_L(0); PG8_BAR; PG8_MMA(0, 0, At, B0); PG8_MMA(0, 1, At, B1); PG8_BAR; PG8_SCHED;
            PG8_LDA(At, 0, 1); PG8_STAGE(PG8_SB(0, 0), b2, voffB); PG8_STAGE(PG8_SB(0, 1), b2 + hstep, voffB); PG8_STAGE(PG8_SA(0, 0), a2, voffA);
            PG8_WAIT_V(8); PG8_WAIT_L(0); PG8_BAR; PG8_MMA(1, 0, At, B0); PG8_MMA(1, 1, At, B1); PG8_BAR; PG8_SCHED;
            PG8_LDB(B0, 1, 0); PG8_LDB(B1, 1, 1); PG8_SCHED; PG8_LDA(At, 1, 0); PG8_STAGE(PG8_SA(0, 1), a2 + hstep, voffA);
            PG8_WAIT_V(8); PG8_WAIT_L(0); PG8_BAR; PG8_MMA(0, 0, At, B0); PG8_MMA(0, 1, At, B1); PG8_BAR; PG8_SCHED;
            PG8_LDA(At, 1, 1); PG8_STAGE(PG8_SB(1, 0), b3, voffB); PG8_STAGE(PG8_SB(1, 1), b3 + hstep, voffB); PG8_STAGE(PG8_SA(1, 0), a3, voffA);
            PG8_WAIT_V(8); PG8_WAIT_L(0); PG8_BAR; PG8_MMA(1, 0, At, B0); PG8_MMA(1, 1, At, B1); PG8_BAR; PG8_SCHED;
            } else {
            PG8_LDB(B0, 0, 0); PG8_SCHED; PG8_LDA(At, 0, 0); PG8_STAGE(PG8_SA(1, 1), a1 + hstep, voffA);
            PG8_WAIT_L(8); PG8_BAR; PG8_WAIT_L(0); PG8_MMA(0, 0, At, B0); PG8_BAR; PG8_SCHED;
            PG8_LDB(B1, 0, 1); PG8_STAGE(PG8_SB(0, 0), b2, voffB);
            PG8_BAR; PG8_WAIT_L(0); PG8_MMA(0, 1, At, B1); PG8_BAR;
            PG8_LDA(At, 0, 1); PG8_STAGE(PG8_SA(0, 0), a2, voffA);
            PG8_BAR; PG8_WAIT_L(0); PG8_MMA(1, 0, At, B0); PG8_BAR; PG8_SCHED;
            PG8_STAGE(PG8_SB(0, 1), b2 + hstep, voffB);
            PG8_WAIT_V(6); PG8_BAR; PG8_MMA(1, 1, At, B1); PG8_BAR;
            PG8_LDB(B0, 1, 0); PG8_SCHED; PG8_LDA(At, 1, 0); PG8_STAGE(PG8_SA(0, 1), a2 + hstep, voffA);
            PG8_WAIT_L(8); PG8_BAR; PG8_WAIT_L(0); PG8_MMA(0, 0, At, B0); PG8_BAR; PG8_SCHED;
            PG8_LDB(B1, 1, 1); PG8_STAGE(PG8_SB(1, 0), b3, voffB);
            PG8_BAR; PG8_WAIT_L(0); PG8_MMA(0, 1, At, B1); PG8_BAR;
            PG8_LDA(At, 1, 1); PG8_STAGE(PG8_SA(1, 0), a3, voffA);
            PG8_BAR; PG8_WAIT_L(0); PG8_MMA(1, 0, At, B0); PG8_BAR; PG8_SCHED;
            PG8_STAGE(PG8_SB(1, 1), b3 + hstep, voffB);
            PG8_WAIT_V(6); PG8_BAR; PG8_MMA(1, 1, At, B1); PG8_BAR;
            }
        }
        if constexpr (ALIGN_EPI) { if (wr == 0) PG8_BAR; }
        if constexpr (!Epi::AFTER_DRAIN) { E(acc, cur, wr, wc, fr, fq); S.done(cur); }
        if (!has_next) break;
#pragma unroll
        for (int a = 0; a < 2; ++a)
#pragma unroll
            for (int b = 0; b < 2; ++b)
#pragma unroll
                for (int m = 0; m < 4; ++m)
#pragma unroll
                    for (int n = 0; n < 2; ++n) acc[a][b][m][n] = (f32x4){0.f, 0.f, 0.f, 0.f};
        cur = nxt; cA = nA; cB = nB; ++ui;
        if constexpr (ALIGN_EPI) { if (wr == 1) PG8_BAR; }
    }
    PG8_WAIT_V(0);
    if constexpr (!ALIGN_EPI) { if (wr == 0) PG8_BAR; }
    PG8_BAR;
    if constexpr (Epi::AFTER_DRAIN) { E.fused(acc, cur, wr, wc, fr, fq, lds, wid, lane); S.done(cur); }
#undef PG8_SA
#undef PG8_SB
#undef PG8_STAGE
#undef PG8_LDA
#undef PG8_LDB
#undef PG8_MMA
#undef PG8_WAIT_V
#undef PG8_WAIT_L
#undef PG8_BAR
#undef PG8_SCHED
}
}
#include <hip/hip_bf16.h>
#include <cmath>
namespace attn_body {
using bf16=__hip_bfloat16;
using bf16x8=__attribute__((ext_vector_type(8)))short;
using s16x4=__attribute__((ext_vector_type(4)))short;
using f32x16=__attribute__((ext_vector_type(16)))float;
using u32x4=__attribute__((ext_vector_type(4)))unsigned;
constexpr int SEQ=4096,D=64,DM=3072;
constexpr int NW=8,QBLK=32,QB=QBLK*NW,KVBLK=64,NQB=SEQ/QB;
constexpr int ATTN_UNIT_ROWS=QB;
__device__ __forceinline__ int crow(int r,int hi){return (r&3)+8*(r>>2)+4*hi;}
#define SBAR() __builtin_amdgcn_sched_barrier(0)
__device__ __forceinline__ void cmask(f32x16&p0,f32x16&p1,int jb,int qrel,int hi){
  asm volatile("":"+v"(qrel),"+v"(hi));
  const float NEG=-INFINITY; int kb=64*jb+4*hi;
  #pragma unroll
  for(int r=0;r<16;++r){int kv=kb+(r&3)+8*(r>>2); if(kv>qrel)p0[r]=NEG; if(kv+32>qrel)p1[r]=NEG;}
}

constexpr int NSLOT=3, SLOTB=8192;
constexpr int LDS_K=0, LDS_V=NSLOT*SLOTB, LDS_WS=2*NSLOT*SLOTB, LDS_OST=LDS_WS+NW*64*4, LDS_FEAT=LDS_OST+NW*4096, LDS_BYTES=LDS_FEAT+SEQ*8;
constexpr float C2=0.125f*1.4426950408889634f;
__device__ __forceinline__ void glds16(const void*gsrc,unsigned lds_dst){unsigned keep;
  asm volatile("s_mov_b32 %0, m0\n\ts_mov_b32 m0, %2\n\ts_nop 0\n\tglobal_load_lds_dwordx4 %1, off\n\ts_mov_b32 m0, %0":"=&s"(keep):"v"(gsrc),"s"(lds_dst):"memory");}
__device__ __forceinline__ float max3f(float a,float b,float c){float r;asm("v_max3_f32 %0, %1, %2, %3":"=v"(r):"v"(a),"v"(b),"v"(c));return r;}
__device__ __forceinline__ float max2f(float a,float b){float r;asm("v_max_f32_e32 %0, %1, %2":"=v"(r):"v"(a),"v"(b));return r;}
__device__ __forceinline__ float fadd_s(float a,float b){float r;asm("v_add_f32_e32 %0, %1, %2":"=v"(r):"v"(a),"v"(b));return r;}
__device__ __forceinline__ float fsub_s(float a,float b){float r;asm("v_sub_f32_e32 %0, %1, %2":"=v"(r):"v"(a),"v"(b));return r;}
typedef float f32x2_t __attribute__((ext_vector_type(2))); typedef __bf16 bf16x2_t __attribute__((ext_vector_type(2)));
__device__ __forceinline__ unsigned cvtpk_s(float lo,float hi){f32x2_t v={lo,hi};bf16x2_t b=__builtin_convertvector(v,bf16x2_t);return __builtin_bit_cast(unsigned,b);}
#define WAIT_BAR(N) asm volatile("s_waitcnt vmcnt(" #N ") lgkmcnt(0)\n\ts_barrier":::"memory")

__device__ __forceinline__ void qkt(f32x16&p0,f32x16&p1,const char*Kslot,const bf16x8*qr,bf16x8 ax0,bf16x8 ax1,bf16x8 qx,int r32,int hi){
  const char*kb=Kslot+hi*1024+r32*16;
  const f32x16 z=f32x16{};
  p0=__builtin_amdgcn_mfma_f32_32x32x16_bf16(ax0,qx,z,0,0,0);p1=__builtin_amdgcn_mfma_f32_32x32x16_bf16(ax1,qx,z,0,0,0);
  #pragma unroll
  for(int d0=0;d0<4;++d0){
    const bf16x8 b0=*reinterpret_cast<const bf16x8*>(kb+d0*2048);
    const bf16x8 b1=*reinterpret_cast<const bf16x8*>(kb+d0*2048+512);
    p0=__builtin_amdgcn_mfma_f32_32x32x16_bf16(b0,qr[d0],p0,0,0,0);p1=__builtin_amdgcn_mfma_f32_32x32x16_bf16(b1,qr[d0],p1,0,0,0);}
}
typedef __attribute__((address_space(3))) const char* lds_cptr;
typedef short v4i16_t __attribute__((ext_vector_type(4)));
__device__ __forceinline__ void kload8(bf16x8*kf,lds_cptr kp){
  kf[0]=*(const __attribute__((address_space(3))) bf16x8*)(kp);      kf[1]=*(const __attribute__((address_space(3))) bf16x8*)(kp+512);
  kf[2]=*(const __attribute__((address_space(3))) bf16x8*)(kp+2048); kf[3]=*(const __attribute__((address_space(3))) bf16x8*)(kp+2560);
  kf[4]=*(const __attribute__((address_space(3))) bf16x8*)(kp+4096); kf[5]=*(const __attribute__((address_space(3))) bf16x8*)(kp+4608);
  kf[6]=*(const __attribute__((address_space(3))) bf16x8*)(kp+6144); kf[7]=*(const __attribute__((address_space(3))) bf16x8*)(kp+6656);
}
__device__ __forceinline__ void kload2(bf16x8*kf,lds_cptr kp,int j){ kf[2*j]=*(const __attribute__((address_space(3))) bf16x8*)(kp+j*2048); kf[2*j+1]=*(const __attribute__((address_space(3))) bf16x8*)(kp+j*2048+512); }
__device__ __forceinline__ s16x4 vtr(lds_cptr p){ return __builtin_bit_cast(s16x4,__builtin_amdgcn_ds_read_tr16_b64_v4i16((__attribute__((address_space(3))) v4i16_t*)p)); }
__device__ __forceinline__ float rowmax(const f32x16&p0,const f32x16&p1){
  float a=max3f(p0[0],p0[1],p1[0]),b=max3f(p0[2],p0[3],p1[1]);a=max3f(a,p1[2],p1[3]);
  #pragma unroll
  for(int r=4;r<16;r+=4){a=max3f(a,p0[r],p0[r+1]);b=max3f(b,p0[r+2],p0[r+3]);a=max3f(a,p1[r],p1[r+1]);b=max3f(b,p1[r+2],p1[r+3]);}
  const float m=max2f(a,b);
  auto rr=__builtin_amdgcn_permlane32_swap(__float_as_uint(m),__float_as_uint(m),false,false);
  return max2f(__uint_as_float(rr[0]),__uint_as_float(rr[1]));
}
__device__ __forceinline__ void pv(f32x16*o,int vb,bf16x8 pa0,bf16x8 pa1,bf16x8 pa2,bf16x8 pa3){
  #pragma unroll
  for(int d0=0;d0<2;++d0){s16x4 lo[4],hi[4];
    #pragma unroll
    for(int ks=0;ks<4;++ks){
      asm volatile("ds_read_b64_tr_b16 %0,%1 offset:%c2":"=&v"(lo[ks]):"v"(vb),"i"(d0*4096+ks*1024):"memory");
      asm volatile("ds_read_b64_tr_b16 %0,%1 offset:%c2":"=&v"(hi[ks]):"v"(vb),"i"(d0*4096+ks*1024+512):"memory");}
    asm volatile("s_waitcnt lgkmcnt(0)":::"memory");SBAR();
    #define PK(k) (bf16x8){lo[k][0],lo[k][1],lo[k][2],lo[k][3],hi[k][0],hi[k][1],hi[k][2],hi[k][3]}
    o[d0]=__builtin_amdgcn_mfma_f32_32x32x16_bf16(pa0,PK(0),o[d0],0,0,0);
    o[d0]=__builtin_amdgcn_mfma_f32_32x32x16_bf16(pa1,PK(1),o[d0],0,0,0);
    o[d0]=__builtin_amdgcn_mfma_f32_32x32x16_bf16(pa2,PK(2),o[d0],0,0,0);
    o[d0]=__builtin_amdgcn_mfma_f32_32x32x16_bf16(pa3,PK(3),o[d0],0,0,0);
    #undef PK
  }
}


typedef unsigned u32x2 __attribute__((ext_vector_type(2)));
__device__ __forceinline__ void split3(float v,unsigned&h16,unsigned&m16,unsigned&l16){
  const unsigned uh=__float_as_uint(v)&0xffff0000u; const float r1=v-__uint_as_float(uh);
  const unsigned um=__float_as_uint(r1)&0xffff0000u; const float r2=r1-__uint_as_float(um);
  const unsigned ul=__float_as_uint(r2); h16=uh>>16; m16=um>>16; l16=(ul+0x7fffu+((ul>>16)&1u))>>16;
}
__device__ __forceinline__ bf16x8 make_qx(float qc){ unsigned h,m,l; split3(qc,h,m,l); const u32x4 w={0x3f803f80u,0x3f80u|(h<<16),m|(l<<16),0u}; return __builtin_bit_cast(bf16x8,w); }
__device__ __forceinline__ void dmask(f32x16&p0,f32x16&p1,int jb,int wid,int r32,int hi,float slope2){
  asm volatile("":"+v"(r32),"+v"(hi));
  const int dj=wid>>1, qrel=32*(wid&1)+r32; const float slope2x2=2.f*slope2;
  if(jb>dj){
    #pragma unroll
    for(int r=0;r<16;++r){p0[r]=-INFINITY;p1[r]=-INFINITY;}
  } else if(jb==dj){
    #pragma unroll
    for(int r=0;r<16;++r){const int kv=4*hi+(r&3)+8*(r>>2); if(kv>qrel)p0[r]-=slope2x2*(float)(kv-qrel); if(kv+32>qrel)p1[r]-=slope2x2*(float)(kv+32-qrel);}
  }
}

template<int MODE,int THRL> __device__ __forceinline__ void attn_pass(int qb,const bf16*Qh,const bf16*__restrict__ Kh,const bf16*__restrict__ Vh,const float*__restrict__ cumf,float slope2,char*shm,f32x16(&o)[2]){
  int tid_l=threadIdx.x; asm volatile("":"+v"(tid_l));
  const int tid=tid_l,lane=tid&63,r32=lane&31,hi=lane>>5; const int wid=__builtin_amdgcn_readfirstlane(tid>>6);
  const int q0=qb*QB;
  const bf16*Qw=Qh+(long)(q0+wid*QBLK)*DM;
  const unsigned lds0=(unsigned)(uintptr_t)shm;
  float*wsf=(float*)(shm+LDS_WS)+wid*64;
  const int NT=(q0+QB)/KVBLK;
  const lds_cptr shm3=(lds_cptr)shm;
  { __attribute__((address_space(3))) u32x2*feat=(__attribute__((address_space(3))) u32x2*)(shm+LDS_FEAT);
    for(int s=tid;s<64*NT;s+=NW*64){ const float kx=(MODE==0)?(-cumf[s]*1.4426950408889634f):(slope2*(float)s); unsigned h,m,l; split3(kx,h,m,l); u32x2 w; w.x=h|(m<<16); w.y=l|0x3f800000u; feat[s]=w; } }
  const __attribute__((address_space(3))) u32x2*featr=(const __attribute__((address_space(3))) u32x2*)(shm3+LDS_FEAT)+lane;
  #define AXF0(f) __builtin_bit_cast(bf16x8,(u32x4){hi?0u:(f).x,hi?0u:(f).y,hi?0u:0x3f803f80u,0u})
  #define AXF1(f) __builtin_bit_cast(bf16x8,(u32x4){hi?(f).x:0u,hi?(f).y:0u,hi?0x3f803f80u:0u,0u})
  const bf16*ksrc=Kh+(long)lane*DM+wid*8;
  const bf16*vsrc=Vh+(long)(16*(wid&3)+(lane>>2))*DM+(wid>>2)*32+(lane&3)*8;
  const unsigned kdst=lds0+LDS_K+wid*1024, vdst=lds0+LDS_V+wid*1024;
  #define DMA_K(t,slot) glds16(ksrc+(long)(t)*KVBLK*DM,(unsigned)__builtin_amdgcn_readfirstlane(kdst+(slot)))
  #define DMA_V(t,slot) glds16(vsrc+(long)(t)*KVBLK*DM,(unsigned)__builtin_amdgcn_readfirstlane(vdst+(slot)))
  const int vb0=(int)(lds0+LDS_V)+((lane>>4)&1)*32+(lane&3)*8+(4*hi+((lane&15)>>2))*64;
  const char*Kbase=shm+LDS_K; bf16x8 kf[8];
  const lds_cptr kp0=shm3+LDS_K+hi*1024+r32*16; const lds_cptr vp0=shm3+LDS_V+((lane>>4)&1)*32+(lane&3)*8+(4*hi+((lane&15)>>2))*64;
  const float qc=(MODE==0)?(cumf[q0+wid*QBLK+r32]*1.4426950408889634f):(-slope2*(float)(q0+wid*QBLK+r32));
  asm volatile("s_waitcnt vmcnt(0)":::"memory");
  DMA_K(0,0);DMA_V(0,0);DMA_K(1,SLOTB);
  bf16x8 qr[4];
  #pragma unroll
  for(int d0=0;d0<4;++d0)qr[d0]=*reinterpret_cast<const bf16x8*>(&Qw[(long)r32*DM+d0*16+hi*8]);
  float qcm=qc,l_reg=0.f;o[0]=f32x16{};o[1]=f32x16{};
  bf16x8 qx=make_qx(qcm);
  const int qrel=wid*QBLK+r32;
  #define CMASK(P0,P1,t) do{int jb_=(t)-(NT-4); if(jb_>=0){ if(MODE==0)cmask(P0,P1,jb_,qrel,hi); else dmask(P0,P1,jb_,wid,r32,hi,slope2);} }while(0)
  bool resc=false;
  #define RESC() do{ if(resc){ asm volatile("s_waitcnt lgkmcnt(0)":::"memory"); \
      _Pragma("unroll") for(int d_=0;d_<2;++d_) _Pragma("unroll") for(int r=0;r<16;++r)o[d_][r]*=wsf[crow(r,hi)]; } }while(0)
  f32x16 pA0,pA1,pB0,pB1;
  int sl_prev=0,sl_cur=0,sl_next=SLOTB;
  #define ROT() do{sl_prev=sl_cur;sl_cur=sl_next;sl_next=(sl_next==(NSLOT-1)*SLOTB)?0:sl_next+SLOTB;}while(0)
  DMA_K(2,2*SLOTB);
  WAIT_BAR(3);
  u32x2 fx=featr[0];
  qkt(pA0,pA1,Kbase,qr,AXF0(fx),AXF1(fx),qx,r32,hi);asm volatile("s_nop 15\n\ts_nop 7":"+v"(pA0),"+v"(pA1));CMASK(pA0,pA1,0);
  { const float rm=rowmax(pA0,pA1); const float dl=(rm>(float)THRL)?rm:0.f; qcm-=dl;
    _Pragma("unroll") for(int r=0;r<16;++r){pA0[r]=fsub_s(pA0[r],dl);pA1[r]=fsub_s(pA1[r],dl);}
    qx=make_qx(qcm);
    _Pragma("unroll") for(int r=0;r<16;++r)pA0[r]=__builtin_amdgcn_exp2f(pA0[r]); }
  _Pragma("unroll") for(int r=0;r<16;++r)pA1[r]=__builtin_amdgcn_exp2f(pA1[r]);
  fx=featr[64];
  WAIT_BAR(0);
  DMA_K(3,0);DMA_V(1,SLOTB);
  ROT();
  kload8(kf,kp0+sl_cur);
  WAIT_BAR(2);
  s16x4 vlo[8],vhi[8]; u32x4 pw0,pw1,pw2,pw3;
  #define PKW(P,B) cvtpk_s(P[B],P[B+1])
  #define PAF(k) __builtin_bit_cast(bf16x8,pw##k)
  #define VFR(i) (bf16x8){vlo[i][0],vlo[i][1],vlo[i][2],vlo[i][3],vhi[i][0],vhi[i][1],vhi[i][2],vhi[i][3]}
  #define PIN(x) asm volatile("":"+v"(x))
  #define MX3(a,b,c) __builtin_fmaxf(__builtin_fmaxf((a),(b)),(c))
  #define GAPA(MF,A0,A1,A2,A3,W0,W1,PW) do{ MF; sacc+=A0; sacc+=A1; sacc+=A2; sacc+=A3; PIN(sacc); W0; W1; PIN(PW); SBAR(); }while(0)
  #define EX(v) __builtin_amdgcn_exp2f(v)
  #define GAPB(MF,X,B) do{ MF; X[B]=EX(X[B]); X[B+1]=EX(X[B+1]); X[B+2]=EX(X[B+2]); X[B+3]=EX(X[B+3]); PIN(X); SBAR(); }while(0)
  #define VRD(i) do{ vlo[i]=vtr(vp_+(((i)>>2)*4096+((i)&3)*1024)); vhi[i]=vtr(vp_+(((i)>>2)*4096+((i)&3)*1024+512)); }while(0)
  #define KRD(G,j) do{ if(G){ kload2(kf,kp0+sl_next,j); SBAR(); } }while(0)
  #define STEP(C0,C1,P0,P1,t,GK,GV,GL) do{ SBAR(); \
    const lds_cptr vp_=vp0+sl_prev; \
    { const bf16x8 ax0_=AXF0(fx), ax1_=AXF1(fx); const f32x16 z_=f32x16{}; \
      C0=__builtin_amdgcn_mfma_f32_32x32x16_bf16(ax0_,qx,z_,0,0,0); C1=__builtin_amdgcn_mfma_f32_32x32x16_bf16(ax1_,qx,z_,0,0,0); SBAR(); } \
    VRD(0); SBAR(); float sacc=(P0[0]+P0[1]); \
    GAPA(C0=__builtin_amdgcn_mfma_f32_32x32x16_bf16(kf[0],qr[0],C0,0,0,0), P0[2],P0[3],P0[4],P0[5],     pw0[0]=PKW(P0,0), pw0[1]=PKW(P0,2), pw0); \
    VRD(4); SBAR(); GAPA(C1=__builtin_amdgcn_mfma_f32_32x32x16_bf16(kf[1],qr[0],C1,0,0,0), P0[6],P0[7],P0[8],P0[9],     pw0[2]=PKW(P0,4), pw0[3]=PKW(P0,6), pw0); \
    VRD(1); SBAR(); GAPA(C0=__builtin_amdgcn_mfma_f32_32x32x16_bf16(kf[2],qr[1],C0,0,0,0),   P0[10],P0[11],P0[12],P0[13], pw1[0]=PKW(P0,8), pw1[1]=PKW(P0,10), pw1); \
    VRD(5); SBAR(); GAPA(C1=__builtin_amdgcn_mfma_f32_32x32x16_bf16(kf[3],qr[1],C1,0,0,0),   P0[14],P0[15],P1[0],P1[1],   pw1[2]=PKW(P0,12),pw1[3]=PKW(P0,14), pw1); \
    VRD(2); SBAR(); GAPA(C0=__builtin_amdgcn_mfma_f32_32x32x16_bf16(kf[4],qr[2],C0,0,0,0),   P1[2],P1[3],P1[4],P1[5],     pw2[0]=PKW(P1,0), pw2[1]=PKW(P1,2), pw2); \
    VRD(6); SBAR(); GAPA(C1=__builtin_amdgcn_mfma_f32_32x32x16_bf16(kf[5],qr[2],C1,0,0,0),   P1[6],P1[7],P1[8],P1[9],     pw2[2]=PKW(P1,4), pw2[3]=PKW(P1,6), pw2); \
    VRD(3); SBAR(); GAPA(C0=__builtin_amdgcn_mfma_f32_32x32x16_bf16(kf[6],qr[3],C0,0,0,0),   P1[10],P1[11],P1[12],P1[13], pw3[0]=PKW(P1,8), pw3[1]=PKW(P1,10), pw3); \
    VRD(7); SBAR(); GAPA(C1=__builtin_amdgcn_mfma_f32_32x32x16_bf16(kf[7],qr[3],C1,0,0,0),   P1[14],P1[15],0.f,0.f,       pw3[2]=PKW(P1,12),pw3[3]=PKW(P1,14), pw3); \
    l_reg+=sacc; \
    if(GK){DMA_K((t)+3,sl_cur);} if(GV){DMA_V((t)+1,sl_next);} \
    CMASK(C0,C1,t); \
    { float a=MX3(C0[0],C0[1],C1[0]),b=MX3(C0[2],C0[3],C1[1]); a=MX3(a,C1[2],C1[3]); \
      _Pragma("unroll") for(int r=4;r<16;r+=4){a=MX3(a,C0[r],C0[r+1]);b=MX3(b,C0[r+2],C0[r+3]);a=MX3(a,C1[r],C1[r+1]);b=MX3(b,C1[r+2],C1[r+3]);} \
      float rm=__builtin_fmaxf(a,b); { auto rr=__builtin_amdgcn_permlane32_swap(__float_as_uint(rm),__float_as_uint(rm),false,false); rm=__builtin_fmaxf(__uint_as_float(rr[0]),__uint_as_float(rr[1])); } \
      resc=false; \
      if(__builtin_expect(__any(rm>(float)THRL),0)){ const float dl=__builtin_fmaxf(rm,0.f); qcm-=dl; \
        _Pragma("unroll") for(int r=0;r<16;++r){C0[r]-=dl;C1[r]-=dl;} \
        qx=make_qx(qcm); \
        const float f=__builtin_amdgcn_exp2f(-dl); l_reg*=f; if(hi==0)wsf[r32]=f; resc=true; } } \
    SBAR(); \
    GAPB(o[0]=__builtin_amdgcn_mfma_f32_32x32x16_bf16(PAF(0),VFR(0),o[0],0,0,0), C0,0); \
    GAPB(o[1]=__builtin_amdgcn_mfma_f32_32x32x16_bf16(PAF(0),VFR(4),o[1],0,0,0), C0,4); \
    KRD(GL,0); GAPB(o[0]=__builtin_amdgcn_mfma_f32_32x32x16_bf16(PAF(1),VFR(1),o[0],0,0,0), C0,8); \
    KRD(GL,1); GAPB(o[1]=__builtin_amdgcn_mfma_f32_32x32x16_bf16(PAF(1),VFR(5),o[1],0,0,0), C0,12); \
    KRD(GL,2); GAPB(o[0]=__builtin_amdgcn_mfma_f32_32x32x16_bf16(PAF(2),VFR(2),o[0],0,0,0), C1,0); \
    KRD(GL,3); GAPB(o[1]=__builtin_amdgcn_mfma_f32_32x32x16_bf16(PAF(2),VFR(6),o[1],0,0,0), C1,4); \
    if(GL){ fx=featr[64*((t)+1)]; SBAR(); } \
    GAPB(o[0]=__builtin_amdgcn_mfma_f32_32x32x16_bf16(PAF(3),VFR(3),o[0],0,0,0), C1,8); \
    GAPB(o[1]=__builtin_amdgcn_mfma_f32_32x32x16_bf16(PAF(3),VFR(7),o[1],0,0,0), C1,12); \
    }while(0)
  int t=1;
  #undef CMASK
  #define CMASK(P0,P1,t) do{}while(0)
  for(;t+5<NT;t+=2){
    STEP(pB0,pB1,pA0,pA1,t,true,true,true);     WAIT_BAR(2); RESC(); ROT();
    STEP(pA0,pA1,pB0,pB1,t+1,true,true,true);   WAIT_BAR(2); RESC(); ROT();
  }
  #undef CMASK
  #define CMASK(P0,P1,t) do{int jb_=(t)-(NT-4); if(jb_>=0){ if(MODE==0)cmask(P0,P1,jb_,qrel,hi); else dmask(P0,P1,jb_,wid,r32,hi,slope2);} }while(0)
  #define ENDW(tt) do{ if((tt)+3<NT){WAIT_BAR(2);} else if((tt)+2<NT){WAIT_BAR(1);} else {WAIT_BAR(0);} }while(0)
  for(;t+1<NT;t+=2){
    STEP(pB0,pB1,pA0,pA1,t,(t+3<NT),(t+1<NT),(t+1<NT));       ENDW(t);   RESC(); ROT();
    STEP(pA0,pA1,pB0,pB1,t+1,(t+4<NT),(t+2<NT),(t+2<NT));     ENDW(t+1); RESC(); ROT();
  }
  STEP(pB0,pB1,pA0,pA1,NT-1,false,false,false); RESC();
  { float sacc=pB0[0]+pB0[1]; _Pragma("unroll") for(int r=2;r<16;++r)sacc+=pB0[r]; _Pragma("unroll") for(int r=0;r<16;++r)sacc+=pB1[r]; l_reg+=sacc;
    pw0=(u32x4){PKW(pB0,0),PKW(pB0,2),PKW(pB0,4),PKW(pB0,6)};pw1=(u32x4){PKW(pB0,8),PKW(pB0,10),PKW(pB0,12),PKW(pB0,14)};pw2=(u32x4){PKW(pB1,0),PKW(pB1,2),PKW(pB1,4),PKW(pB1,6)};pw3=(u32x4){PKW(pB1,8),PKW(pB1,10),PKW(pB1,12),PKW(pB1,14)};
    SBAR(); pv(o,vb0+sl_cur,PAF(0),PAF(1),PAF(2),PAF(3)); }
  #undef PKW
  #undef PAF
  #undef VFR
  #undef PIN
  #undef MX3
  #undef GAPA
  #undef GAPB
  #undef EX
  #undef VRD
  #undef KRD
  #undef STEP
  #undef ENDW
  {auto rr=__builtin_amdgcn_permlane32_swap(__float_as_uint(l_reg),__float_as_uint(l_reg),false,false);l_reg=__uint_as_float(rr[0])+__uint_as_float(rr[1]);}
  if(hi==0)wsf[32+r32]=l_reg;asm volatile("s_waitcnt lgkmcnt(0)":::"memory");
  #pragma unroll
  for(int r=0;r<16;++r){const float rli=__builtin_amdgcn_rcpf(wsf[32+crow(r,hi)]); o[0][r]*=rli; o[1][r]*=rli;}
  asm volatile("s_waitcnt lgkmcnt(0)\n\ts_barrier":::"memory");
  #undef DMA_K
  #undef DMA_V
  #undef CMASK
  #undef RESC
  #undef ROT
  #undef AXF0
  #undef AXF1
}
__device__ __forceinline__ void store_tile_bf16(const f32x16(&o)[2],bf16*dst,int pitch,char*shm,int wid,int lane){
  const int r32=lane&31,hi=lane>>5;
  bf16*stg=(bf16*)(shm+LDS_OST)+wid*2048;
  #pragma unroll
  for(int r=0;r<16;++r){const int orow=crow(r,hi);
    #pragma unroll
    for(int d0=0;d0<2;++d0)stg[orow*64+d0*32+r32]=__float2bfloat16(o[d0][r]);}
  asm volatile("s_waitcnt lgkmcnt(0)":::"memory");
  #pragma unroll
  for(int i=0;i<4;++i){const int row=i*8+(lane>>3),ch=lane&7; const u32x4 v=*(const u32x4*)(stg+row*64+ch*8); *(u32x4*)(dst+(long)row*pitch+ch*8)=v;}
  asm volatile("s_waitcnt lgkmcnt(0)":::"memory");
}
constexpr int ATTN_LDS_BYTES=LDS_BYTES;
#undef SBAR
#undef WAIT_BAR
}

namespace cg = cooperative_groups;
constexpr int BATCH = 16, SEQ = 4096, D = 1024, NTOK = BATCH * SEQ;
constexpr int FH = 8, DH = 4, HD = 64;
constexpr int NPROJ = 3072, IN_COLS = 3080;
constexpr int PH = 8, NKEY = 128, TOPK = 16, PQ = 2048, NEXP = 16384;
constexpr float RMS_EPS = 1e-6f, LOG2E = 1.4426950408889634f, C2 = 0.125f * LOG2E;
constexpr float LAMBDA_INIT = 0.2f;
constexpr int COL_QA = 0, COL_KA = 512, COL_VA = 1024, COL_QB = 1536, COL_KB = 2048, COL_VB = 2560;
constexpr int NWAVES = 8, NTHR = 512;

typedef unsigned short bf16_t;
typedef float f32x4v __attribute__((ext_vector_type(4)));
#define LAS __attribute__((address_space(3)))

constexpr size_t MiB = 1u << 20;
constexpr size_t WS_CTL = 0;
constexpr size_t WS_WIN = 2 * MiB;
constexpr size_t WS_WOUT = 8 * MiB;
constexpr size_t WS_WQ = 10 * MiB;
constexpr size_t WS_LOGF = 16 * MiB;
constexpr size_t WS_CUM = 18 * MiB;
constexpr size_t WS_XN = 96 * MiB;
constexpr size_t WS_PROJ = 224 * MiB;
constexpr size_t WS_Y = 224 * MiB;
constexpr size_t WS_QP = 352 * MiB;
constexpr size_t WS_MIXED = 608 * MiB;
constexpr size_t WS_END = 736 * MiB;
constexpr int LDS_BYTES = 147456;

__device__ __forceinline__ unsigned f2bf(float f) { unsigned u = __builtin_bit_cast(unsigned, f); return (u + 0x7fffu + ((u >> 16) & 1u)) >> 16; }
__device__ __forceinline__ unsigned pk2(float lo, float hi) { return f2bf(lo) | (f2bf(hi) << 16); }
__device__ __forceinline__ float bflo(unsigned w) { return __builtin_bit_cast(float, w << 16); }
__device__ __forceinline__ float bfhi(unsigned w) { return __builtin_bit_cast(float, w & 0xffff0000u); }
__device__ __forceinline__ float wave_sum(float v) {
#pragma unroll
    for (int o = 1; o < 64; o <<= 1) v += __shfl_xor(v, o);
    return v;
}

struct Ctx { int tid, lane, wave, vcu, G, gw, NGW; LAS unsigned char* lds; unsigned char* lds_gen; };

__device__ __forceinline__ void p0_transpose_item(const float* W, int ldw, int K, int ncols, bf16_t* WT, int row_off, float scale, LAS float* scr, int item, int lane) {
    const int nblk = ncols / 32, kb = item / nblk, nb = item % nblk, k0 = 64 * kb, n0 = 32 * nb;
#pragma unroll 8
    for (int i = 0; i < 32; ++i) { const int kk = 2 * i + (lane >> 5); scr[kk * 33 + (lane & 31)] = W[(size_t)(k0 + kk) * ldw + n0 + (lane & 31)] * scale; }
    asm volatile("s_waitcnt lgkmcnt(0)" ::: "memory");
    const int c = lane & 7;
#pragma unroll
    for (int j = 0; j < 4; ++j) { const int n = (lane >> 3) + 8 * j; const LAS float* s = scr + (8 * c) * 33 + n;
        uint4 o; o.x = pk2(s[0 * 33], s[1 * 33]); o.y = pk2(s[2 * 33], s[3 * 33]); o.z = pk2(s[4 * 33], s[5 * 33]); o.w = pk2(s[6 * 33], s[7 * 33]);
        *(uint4*)(WT + (size_t)(row_off + n0 + n) * K + k0 + 8 * c) = o; }
    asm volatile("s_waitcnt lgkmcnt(0)" ::: "memory");
}
__device__ __forceinline__ void p0_weights(const Ctx& c, const float* w_in, const float* w_out, const float* w_q, bf16_t* WIN, bf16_t* WOUT, bf16_t* WQ) {
    LAS float* scr = (LAS float*)(c.lds + c.wave * 16384);
    constexpr int KB = D / 64;
    constexpr int I0 = KB * (512 / 32), I1 = KB * (1024 / 32), I2 = I0, I3 = I1, I4 = KB * (D / 32), I5 = KB * (PQ / 32);
    constexpr int NIT = I0 + I1 + I2 + I3 + I4 + I5;
    for (int it = c.gw; it < NIT; it += c.NGW) {
        int r = it;
        if (r < I0) { p0_transpose_item(w_in + 0, IN_COLS, D, 512, WIN, 0, C2, scr, r, c.lane); continue; } r -= I0;
        if (r < I1) { p0_transpose_item(w_in + 512, IN_COLS, D, 1024, WIN, 512, 1.f, scr, r, c.lane); continue; } r -= I1;
        if (r < I2) { p0_transpose_item(w_in + 1544, IN_COLS, D, 512, WIN, 1536, C2, scr, r, c.lane); continue; } r -= I2;
        if (r < I3) { p0_transpose_item(w_in + 2056, IN_COLS, D, 1024, WIN, 2048, 1.f, scr, r, c.lane); continue; } r -= I3;
        if (r < I4) { p0_transpose_item(w_out, D, D, D, WOUT, 0, 1.f, scr, r, c.lane); continue; } r -= I4;
        p0_transpose_item(w_q, PQ, D, PQ, WQ, 0, 1.f, scr, r, c.lane);
    }
}

__device__ __forceinline__ void rms1_gates_row(int row, int lane, const float* __restrict__ x, const float* __restrict__ g1, const float* __restrict__ w_in, const float* __restrict__ b_f,
                                               bf16_t* __restrict__ XN, float* __restrict__ LOGF) {
    const f32x4v* xr = (const f32x4v*)(x + (size_t)row * D) + lane;
    f32x4v v[4]; float ss = 0.f;
#pragma unroll
    for (int j = 0; j < 4; ++j) { v[j] = xr[64 * j]; ss += (v[j].x * v[j].x + v[j].y * v[j].y) + (v[j].z * v[j].z + v[j].w * v[j].w); }
    ss = wave_sum(ss);
    const float rstd = rsqrtf(ss * (1.f / D) + RMS_EPS);
    float gate[8];
#pragma unroll
    for (int q = 0; q < 8; ++q) gate[q] = 0.f;
    unsigned long long* o8 = (unsigned long long*)(XN + (size_t)row * D) + lane;
#pragma unroll
    for (int j = 0; j < 4; ++j) {
        const f32x4v g = ((const f32x4v*)g1)[lane + 64 * j];
        v[j] = v[j] * rstd * g;
        o8[64 * j] = (unsigned long long)pk2(v[j].x, v[j].y) | ((unsigned long long)pk2(v[j].z, v[j].w) << 32);
#pragma unroll
        for (int e = 0; e < 4; ++e) {
            const int k = 4 * lane + 256 * j + e;
            const f32x4v* wr = (const f32x4v*)(w_in + (size_t)k * IN_COLS + 1536);
            const f32x4v w0 = wr[0], w1 = wr[1]; const float xe = v[j][e];
            gate[0] += xe * w0.x; gate[1] += xe * w0.y; gate[2] += xe * w0.z; gate[3] += xe * w0.w;
            gate[4] += xe * w1.x; gate[5] += xe * w1.y; gate[6] += xe * w1.z; gate[7] += xe * w1.w;
        }
    }
#pragma unroll
    for (int q = 0; q < 8; ++q) gate[q] = wave_sum(gate[q]);
    float gv = gate[0];
#pragma unroll
    for (int q = 1; q < 8; ++q) if (lane == q) gv = gate[q];
    if (lane < 8) {
        const float z = gv + b_f[lane];
        const float ls = fminf(z, 0.f) - log1pf(expf(-fabsf(z)));
        const int b = row / SEQ, t = row % SEQ;
        LOGF[((size_t)b * FH + lane) * SEQ + t] = ls;
    }
}

__device__ __forceinline__ void cumsum_seq(int bh, int lane, const float* __restrict__ LOGF, float* __restrict__ CUM) {
    const float* src = LOGF + (size_t)bh * SEQ + lane * 64; float* dst = CUM + (size_t)bh * SEQ + lane * 64;
    float loc[64]; float run = 0.f;
#pragma unroll
    for (int i = 0; i < 64; ++i) { run += src[i]; loc[i] = run; }
    float incl = run;
#pragma unroll
    for (int o = 1; o < 64; o <<= 1) { const float t = __shfl_up(incl, o); if (lane >= o) incl += t; }
    const float excl = incl - run;
#pragma unroll
    for (int i = 0; i < 64; ++i) dst[i] = loc[i] + excl;
}

constexpr int LDS_LAM = 131072;
constexpr size_t WS_DSCR = 32 * MiB;
__device__ __forceinline__ void fox_unit(const Ctx& c, int b, int h, int qb, const bf16_t* PROJ, const float* CUM, bf16_t* MIXED) {
    using attn_body::bf16; using attn_body::f32x16; using attn_body::attn_pass; using attn_body::store_tile_bf16;
    const bf16* P = (const bf16*)PROJ + (size_t)b * SEQ * NPROJ;
    f32x16 o[2];
    attn_pass<0, 8>(qb, P + COL_QA + h * 64, P + COL_KA + h * 64, P + COL_VA + h * 64, CUM + ((size_t)b * FH + h) * SEQ, 0.f, (char*)c.lds_gen, o);
    int tid_l = threadIdx.x; asm volatile("" : "+v"(tid_l));
    const int lane = tid_l & 63, wave = __builtin_amdgcn_readfirstlane(tid_l >> 6);
    store_tile_bf16(o, (bf16*)MIXED + ((size_t)b * SEQ + qb * 256 + wave * 32) * D + h * 64, D, (char*)c.lds_gen, wave, lane);
}
__device__ __forceinline__ void diff_unit(const Ctx& c, int b, int h, int qb, const bf16_t* PROJ, const float* subg, bf16_t* MIXED, unsigned char* ws) {
    using attn_body::bf16; using attn_body::f32x16; using attn_body::attn_pass; using attn_body::store_tile_bf16;
    f32x16 o[2];
#pragma unroll 1
    for (int pi = 0; pi < 4; ++pi) {
        const int m = pi & 1, half = pi >> 1;
        { const bf16* P = (const bf16*)PROJ + (size_t)b * SEQ * NPROJ; const float slope2 = exp2f(-2.f * (float)(h + 1)) * LOG2E;
          attn_pass<1, 8>(qb, P + COL_QB + h * 128 + m * 64, P + COL_KB + h * 128 + m * 64, P + COL_VB + h * 128 + half * 64, nullptr, slope2, (char*)c.lds_gen, o); }
        int tid_l = threadIdx.x; asm volatile("" : "+v"(tid_l));
        const int lane = tid_l & 63, wave = __builtin_amdgcn_readfirstlane(tid_l >> 6);
        f32x4v* stash = (f32x4v*)(ws + WS_DSCR + ((size_t)blockIdx.x * NWAVES + wave) * 16384) + lane;
        if (m == 0) {
#pragma unroll
            for (int i = 0; i < 8; ++i) { const int d0 = i >> 2, r = (i & 3) * 4; stash[i * 64] = (f32x4v){o[d0][r], o[d0][r + 1], o[d0][r + 2], o[d0][r + 3]}; }
        } else {
            const float lam = ((const LAS float*)(c.lds + LDS_LAM))[0];
            asm volatile("s_waitcnt vmcnt(0)" ::: "memory");
#pragma unroll
            for (int i = 0; i < 8; ++i) { const int d0 = i >> 2, r = (i & 3) * 4; const f32x4v a = stash[i * 64];
                o[d0][r] = a.x - lam * o[d0][r]; o[d0][r + 1] = a.y - lam * o[d0][r + 1]; o[d0][r + 2] = a.z - lam * o[d0][r + 2]; o[d0][r + 3] = a.w - lam * o[d0][r + 3]; }
            if (half == 0) {
#pragma unroll
                for (int i = 0; i < 8; ++i) { const int d0 = i >> 2, r = (i & 3) * 4; stash[512 + i * 64] = (f32x4v){o[d0][r], o[d0][r + 1], o[d0][r + 2], o[d0][r + 3]}; }
            } else {
                f32x16 y0[2]; const int r32 = lane & 31;
#pragma unroll
                for (int i = 0; i < 8; ++i) { const int d0 = i >> 2, r = (i & 3) * 4; const f32x4v a = stash[512 + i * 64]; y0[d0][r] = a.x; y0[d0][r + 1] = a.y; y0[d0][r + 2] = a.z; y0[d0][r + 3] = a.w; }
                const float g00 = subg[r32], g01 = subg[32 + r32], g10 = subg[64 + r32], g11 = subg[96 + r32];
#pragma unroll
                for (int r = 0; r < 16; ++r) {
                    float ss = (y0[0][r] * y0[0][r] + y0[1][r] * y0[1][r]) + (o[0][r] * o[0][r] + o[1][r] * o[1][r]);
#pragma unroll
                    for (int off = 1; off < 32; off <<= 1) ss += __shfl_xor(ss, off);
                    const float rn = rsqrtf(ss * (1.f / 128.f) + RMS_EPS) * (1.f - LAMBDA_INIT);
                    y0[0][r] *= rn * g00; y0[1][r] *= rn * g01; o[0][r] *= rn * g10; o[1][r] *= rn * g11;
                }
                bf16* dst = (bf16*)MIXED + ((size_t)b * SEQ + qb * 256 + wave * 32) * D + 512 + h * 128;
                store_tile_bf16(y0, dst, D, (char*)c.lds_gen, wave, lane);
                store_tile_bf16(o, dst + 64, D, (char*)c.lds_gen, wave, lane);
            }
        }
    }
}

__device__ __forceinline__ void resid_rms2_row(int row, int lane, const float* __restrict__ x, const bf16_t* __restrict__ Y, const float* __restrict__ g2, float* __restrict__ H, bf16_t* __restrict__ HN) {
    const f32x4v* xr = (const f32x4v*)(x + (size_t)row * D) + lane;
    const uint2* yr = (const uint2*)(Y + (size_t)row * D) + lane;
    f32x4v* hr = (f32x4v*)(H + (size_t)row * D) + lane;
    f32x4v v[4]; float ss = 0.f;
#pragma unroll
    for (int j = 0; j < 4; ++j) { const uint2 y = yr[64 * j]; v[j] = xr[64 * j]; v[j].x += bflo(y.x); v[j].y += bfhi(y.x); v[j].z += bflo(y.y); v[j].w += bfhi(y.y);
        hr[64 * j] = v[j]; ss += (v[j].x * v[j].x + v[j].y * v[j].y) + (v[j].z * v[j].z + v[j].w * v[j].w); }
    ss = wave_sum(ss);
    const float rstd = rsqrtf(ss * (1.f / D) + RMS_EPS);
    unsigned long long* o8 = (unsigned long long*)(HN + (size_t)row * D) + lane;
#pragma unroll
    for (int j = 0; j < 4; ++j) { const f32x4v g = ((const f32x4v*)g2)[lane + 64 * j]; const f32x4v w = v[j] * rstd * g;
        o8[64 * j] = (unsigned long long)pk2(w.x, w.y) | ((unsigned long long)pk2(w.z, w.w) << 32); }
}


constexpr size_t WS_UBF = 736 * MiB;
constexpr size_t WS_VBF = 768 * MiB;
constexpr size_t WS_EIDX = 608 * MiB;
constexpr size_t WS_GATE = 640 * MiB;
constexpr size_t WS_END2 = 800 * MiB;
typedef __bf16 bf16x2v __attribute__((ext_vector_type(2)));
typedef unsigned rt_u32x4 __attribute__((ext_vector_type(4)));
typedef short rt_bf16x8 __attribute__((ext_vector_type(8)));
typedef float rt_f32x16 __attribute__((ext_vector_type(16)));

__device__ __forceinline__ void p0_tables(const Ctx& c, const float* __restrict__ U, const float* __restrict__ V, bf16_t* __restrict__ UB, bf16_t* __restrict__ VB) {
    const size_t nchunk = (size_t)NEXP * D / 8; const size_t gt = (size_t)c.vcu * NTHR + c.tid, GT = (size_t)c.G * NTHR;
    for (size_t i = gt; i < 2 * nchunk; i += GT) {
        const float* src = (i < nchunk) ? U + i * 8 : V + (i - nchunk) * 8; bf16_t* dst = (i < nchunk) ? UB + i * 8 : VB + (i - nchunk) * 8;
        const f32x4v a = ((const f32x4v*)src)[0], b = ((const f32x4v*)src)[1];
        uint4 o; o.x = pk2(a.x, a.y); o.y = pk2(a.z, a.w); o.z = pk2(b.x, b.y); o.w = pk2(b.z, b.w); *(uint4*)dst = o;
    }
}

__device__ __forceinline__ void ce_desc(unsigned& a, unsigned& b) { const unsigned mx = a > b ? a : b, mn = a > b ? b : a; a = mx; b = mn; }
template <int N> __device__ __forceinline__ void bitonic_sort_desc(unsigned (&v)[N]) {
#pragma unroll
    for (int k = 2; k <= N; k <<= 1) {
#pragma unroll
        for (int j = k >> 1; j > 0; j >>= 1) {
#pragma unroll
            for (int i = 0; i < N; ++i) { const int l = i ^ j; if (l > i) { if ((i & k) == 0) ce_desc(v[i], v[l]); else ce_desc(v[l], v[i]); } }
        }
    }
}
__device__ __forceinline__ void merge_top16(unsigned (&a)[16], const unsigned (&b)[16]) {
#pragma unroll
    for (int i = 0; i < 16; ++i) a[i] = a[i] > b[15 - i] ? a[i] : b[15 - i];
#pragma unroll
    for (int j = 8; j > 0; j >>= 1) {
#pragma unroll
        for (int i = 0; i < 16; ++i) { const int l = i ^ j; if (l > i) ce_desc(a[i], a[l]); }
    }
}
__device__ __forceinline__ unsigned f2key(float f) { const unsigned b = __float_as_uint(f); return b ^ (((int)b >> 31) | 0x80000000u); }
__device__ __forceinline__ float key2f(unsigned k) { return __uint_as_float((k & 0x80000000u) ? (k ^ 0x80000000u) : ~k); }

__device__ __forceinline__ void top16_of_scores(const rt_f32x16 (&acc)[4], int hi, unsigned (&t)[16]) {
    unsigned g[16];
#pragma unroll
    for (int kb = 0; kb < 4; ++kb) {
        unsigned hi4 = (unsigned)(4 * hi); asm volatile("" : "+v"(hi4));
#pragma unroll
        for (int r = 0; r < 16; ++r) g[r] = ((f2key(acc[kb][r]) & ~127u) | hi4) | (unsigned)(32 * kb + (r & 3) + 8 * (r >> 2));
        bitonic_sort_desc<16>(g);
        if (kb == 0) {
#pragma unroll
            for (int i = 0; i < 16; ++i) t[i] = g[i];
        } else merge_top16(t, g);
    }
    unsigned lo[16], up[16];
#pragma unroll
    for (int i = 0; i < 16; ++i) { auto rr = __builtin_amdgcn_permlane32_swap(t[i], t[i], false, false); lo[i] = rr[0]; up[i] = rr[1]; }
    merge_top16(lo, up);
#pragma unroll
    for (int i = 0; i < 16; ++i) t[i] = lo[i];
}

__host__ __device__ constexpr int cand_slot(int a, int b) { int n = 0; for (int i = 0; i < 16; ++i) for (int j = 0; j < 16; ++j) { if (i == a && j == b) return n; if ((i + 1) * (j + 1) <= 16) ++n; } return n; }
static_assert(cand_slot(15, 0) == 49, "50 candidates");
constexpr int RT_SK_BYTES = 65536, RT_LUT_OFF = 65536;
__device__ __forceinline__ void route_stage_subkeys(const Ctx& c, const float* __restrict__ subk, int h) {
    for (int q = c.tid; q < 4096; q += NTHR) {
        const int p = q >> 11, key = (q >> 4) & 127, ch = q & 15;
        const float* src = subk + (((size_t)h * 2 + p) * NKEY + key) * 128 + ch * 8;
        const f32x4v a = ((const f32x4v*)src)[0], b = ((const f32x4v*)src)[1];
        rt_u32x4 o; o.x = pk2(a.x, a.y); o.y = pk2(a.z, a.w); o.z = pk2(b.x, b.y); o.w = pk2(b.z, b.w);
        *(LAS rt_u32x4*)(c.lds + p * 32768 + key * 256 + ((ch ^ (key & 15)) << 4)) = o;
    }
}
__device__ __forceinline__ void route_tile(const Ctx& c, int tile, int h, const bf16_t* __restrict__ QP, int* __restrict__ EIDX, float* __restrict__ GATE) {
    const int lane = c.lane, r32 = lane & 31, hi = lane >> 5;
    const int tok = tile * 32 + r32;
    unsigned s1[16], s2[16];
#pragma unroll
    for (int p = 0; p < 2; ++p) {
        rt_bf16x8 qf[8];
        { const uint4* qp = (const uint4*)(QP + (size_t)tok * PQ + h * 256 + p * 128) + hi;
#pragma unroll
          for (int kc = 0; kc < 8; ++kc) qf[kc] = __builtin_bit_cast(rt_bf16x8, qp[2 * kc]); }
        rt_f32x16 acc[4];
#pragma unroll
        for (int kb = 0; kb < 4; ++kb) {
            const int key = 32 * kb + r32;
            const LAS unsigned char* rowp = c.lds + p * 32768 + key * 256;
            acc[kb] = rt_f32x16{};
#pragma unroll
            for (int kc = 0; kc < 8; ++kc) {
                const rt_bf16x8 af = *(const LAS rt_bf16x8*)(rowp + (((2 * kc + hi) ^ (key & 15)) << 4));
                acc[kb] = __builtin_amdgcn_mfma_f32_32x32x16_bf16(af, qf[kc], acc[kb], 0, 0, 0);
            }
        }
        if (p == 0) top16_of_scores(acc, hi, s1); else top16_of_scores(acc, hi, s2);
    }
    unsigned cand[64];
    {
        float f1[16], f2[16];
#pragma unroll
        for (int i = 0; i < 16; ++i) { f1[i] = key2f(s1[i]); f2[i] = key2f(s2[i]); }
#pragma unroll
        for (int a = 0; a < 16; ++a)
#pragma unroll
            for (int b = 0; b < 16; ++b) if ((a + 1) * (b + 1) <= 16) cand[cand_slot(a, b)] = (f2key(f1[a] + f2[b]) & ~255u) | (unsigned)(255 - (a * 16 + b));
#pragma unroll
        for (int i = 50; i < 64; ++i) cand[i] = 0u;
    }
    unsigned top[16];
#pragma unroll
    for (int gidx = 0; gidx < 4; ++gidx) {
        unsigned g[16];
#pragma unroll
        for (int i = 0; i < 16; ++i) g[i] = cand[16 * gidx + i];
        bitonic_sort_desc<16>(g);
        if (gidx == 0) {
#pragma unroll
            for (int i = 0; i < 16; ++i) top[i] = g[i];
        } else merge_top16(top, g);
    }
    LAS unsigned char* lut = c.lds + RT_LUT_OFF + c.wave * 2048 + lane * 32;
    { unsigned w[8];
#pragma unroll
      for (int i = 0; i < 4; ++i) { w[i] = (s1[4 * i] & 127u) | ((s1[4 * i + 1] & 127u) << 8) | ((s1[4 * i + 2] & 127u) << 16) | ((s1[4 * i + 3] & 127u) << 24);
                                    w[4 + i] = (s2[4 * i] & 127u) | ((s2[4 * i + 1] & 127u) << 8) | ((s2[4 * i + 2] & 127u) << 16) | ((s2[4 * i + 3] & 127u) << 24); }
      *(LAS rt_u32x4*)(lut) = (rt_u32x4){w[0], w[1], w[2], w[3]}; *(LAS rt_u32x4*)(lut + 16) = (rt_u32x4){w[4], w[5], w[6], w[7]}; }
    asm volatile("s_waitcnt lgkmcnt(0)" ::: "memory");
    float sc[16], sum = 0.f; const float mx = key2f(top[0] & ~255u);
#pragma unroll
    for (int i = 0; i < 16; ++i) { sc[i] = __expf(key2f(top[i] & ~255u) - mx); sum += sc[i]; }
    const float rs = 1.f / sum;
    int eo[8]; float go[8];
#pragma unroll
    for (int i = 0; i < 8; ++i) {
        const unsigned k = hi ? top[8 + i] : top[i]; const unsigned pos = 255u - (k & 255u);
        const unsigned ia = lut[pos >> 4], ib = lut[16 + (pos & 15u)];
        eo[i] = (int)(ia * NKEY + ib); go[i] = (hi ? sc[8 + i] : sc[i]) * rs;
    }
    asm volatile("s_waitcnt lgkmcnt(0)" ::: "memory");
    int* ep = EIDX + (size_t)tok * 128 + h * 16 + hi * 8; float* gp = GATE + (size_t)tok * 128 + h * 16 + hi * 8;
    *(int4*)ep = (int4){eo[0], eo[1], eo[2], eo[3]}; *(int4*)(ep + 4) = (int4){eo[4], eo[5], eo[6], eo[7]};
    *(f32x4v*)gp = (f32x4v){go[0], go[1], go[2], go[3]}; *(f32x4v*)(gp + 4) = (f32x4v){go[4], go[5], go[6], go[7]};
}

__device__ __forceinline__ void peer_experts_token(int tok, int lane, const bf16_t* __restrict__ HN, const int* __restrict__ EIDX, const float* __restrict__ GATE,
                                                   const bf16_t* __restrict__ UB, const bf16_t* __restrict__ VB, const float* __restrict__ fg, float* __restrict__ H) {
    unsigned xw[8];
    { const uint4* hr = (const uint4*)(HN + (size_t)tok * D) + 2 * lane; const uint4 a = hr[0], b = hr[1]; xw[0] = a.x; xw[1] = a.y; xw[2] = a.z; xw[3] = a.w; xw[4] = b.x; xw[5] = b.y; xw[6] = b.z; xw[7] = b.w; }
    float acc[16];
#pragma unroll
    for (int i = 0; i < 16; ++i) acc[i] = 0.f;
    const int ridx = ((lane >> 5) & 1) * 8 + ((lane >> 4) & 1) * 4 + ((lane >> 3) & 1) * 2 + ((lane >> 2) & 1);
#pragma unroll 1
    for (int h = 0; h < PH; ++h) {
        const int el = EIDX[(size_t)tok * 128 + h * 16 + (lane & 15)]; const float gl = GATE[(size_t)tok * 128 + h * 16 + ridx];
        float p[16];
#pragma unroll
        for (int r = 0; r < 16; ++r) {
            const int e = __builtin_amdgcn_readlane(el, r);
            const uint4* ur = (const uint4*)(UB + (size_t)e * D) + 2 * lane; const uint4 a = ur[0], b = ur[1];
            float d = 0.f;
            d = __builtin_amdgcn_fdot2_f32_bf16(__builtin_bit_cast(bf16x2v, a.x), __builtin_bit_cast(bf16x2v, xw[0]), d, false);
            d = __builtin_amdgcn_fdot2_f32_bf16(__builtin_bit_cast(bf16x2v, a.y), __builtin_bit_cast(bf16x2v, xw[1]), d, false);
            d = __builtin_amdgcn_fdot2_f32_bf16(__builtin_bit_cast(bf16x2v, a.z), __builtin_bit_cast(bf16x2v, xw[2]), d, false);
            d = __builtin_amdgcn_fdot2_f32_bf16(__builtin_bit_cast(bf16x2v, a.w), __builtin_bit_cast(bf16x2v, xw[3]), d, false);
            d = __builtin_amdgcn_fdot2_f32_bf16(__builtin_bit_cast(bf16x2v, b.x), __builtin_bit_cast(bf16x2v, xw[4]), d, false);
            d = __builtin_amdgcn_fdot2_f32_bf16(__builtin_bit_cast(bf16x2v, b.y), __builtin_bit_cast(bf16x2v, xw[5]), d, false);
            d = __builtin_amdgcn_fdot2_f32_bf16(__builtin_bit_cast(bf16x2v, b.z), __builtin_bit_cast(bf16x2v, xw[6]), d, false);
            d = __builtin_amdgcn_fdot2_f32_bf16(__builtin_bit_cast(bf16x2v, b.w), __builtin_bit_cast(bf16x2v, xw[7]), d, false);
            p[r] = d;
        }
        float q8[8], q4[4], q2[2];
#pragma unroll
        for (int i = 0; i < 8; ++i) { const bool up = (lane & 32) != 0; const float keep = up ? p[i + 8] : p[i], send = up ? p[i] : p[i + 8]; q8[i] = keep + __shfl_xor(send, 32); }
#pragma unroll
        for (int i = 0; i < 4; ++i) { const bool up = (lane & 16) != 0; const float keep = up ? q8[i + 4] : q8[i], send = up ? q8[i] : q8[i + 4]; q4[i] = keep + __shfl_xor(send, 16); }
#pragma unroll
        for (int i = 0; i < 2; ++i) { const bool up = (lane & 8) != 0; const float keep = up ? q4[i + 2] : q4[i], send = up ? q4[i] : q4[i + 2]; q2[i] = keep + __shfl_xor(send, 8); }
        float dot; { const bool up = (lane & 4) != 0; const float keep = up ? q2[1] : q2[0], send = up ? q2[0] : q2[1]; dot = keep + __shfl_xor(send, 4); }
        dot += __shfl_xor(dot, 2); dot += __shfl_xor(dot, 1);
        const float hid = 0.5f * dot * (1.f + erff(dot * 0.70710678118654752f)) * gl;
#pragma unroll
        for (int r = 0; r < 16; ++r) {
            const int e = __builtin_amdgcn_readlane(el, r);
            const int src_lane = ((r >> 3) & 1) * 32 + ((r >> 2) & 1) * 16 + ((r >> 1) & 1) * 8 + (r & 1) * 4;
            const float hs = __builtin_bit_cast(float, __builtin_amdgcn_readlane(__builtin_bit_cast(int, hid), src_lane));
            const uint4* vr = (const uint4*)(VB + (size_t)e * D) + 2 * lane; const uint4 a = vr[0], b = vr[1];
            acc[0] += hs * bflo(a.x); acc[1] += hs * bfhi(a.x); acc[2] += hs * bflo(a.y); acc[3] += hs * bfhi(a.y);
            acc[4] += hs * bflo(a.z); acc[5] += hs * bfhi(a.z); acc[6] += hs * bflo(a.w); acc[7] += hs * bfhi(a.w);
            acc[8] += hs * bflo(b.x); acc[9] += hs * bfhi(b.x); acc[10] += hs * bflo(b.y); acc[11] += hs * bfhi(b.y);
            acc[12] += hs * bflo(b.z); acc[13] += hs * bfhi(b.z); acc[14] += hs * bflo(b.w); acc[15] += hs * bfhi(b.w);
        }
    }
    f32x4v* hr = (f32x4v*)(H + (size_t)tok * D) + 4 * lane; float ss = 0.f; f32x4v o[4];
#pragma unroll
    for (int j = 0; j < 4; ++j) { o[j] = hr[j]; o[j].x += acc[4 * j]; o[j].y += acc[4 * j + 1]; o[j].z += acc[4 * j + 2]; o[j].w += acc[4 * j + 3]; ss += (o[j].x * o[j].x + o[j].y * o[j].y) + (o[j].z * o[j].z + o[j].w * o[j].w); }
    ss = wave_sum(ss);
    const float rstd = rsqrtf(ss * (1.f / D) + RMS_EPS);
#pragma unroll
    for (int j = 0; j < 4; ++j) hr[j] = o[j] * rstd * ((const f32x4v*)fg)[4 * lane + j];
}
struct Args { const float* in[16]; float* out; unsigned char* ws; };
#define CAS __attribute__((address_space(4)))
#define PHASE_PROLOGUE() \
    const CAS Args* ap = (const CAS Args*)__builtin_amdgcn_kernarg_segment_ptr(); asm volatile("" : "+s"(ap)); \
    Ctx c; { int t_ = threadIdx.x; asm volatile("" : "+v"(t_)); c.tid = t_; } c.lane = c.tid & 63; c.wave = __builtin_amdgcn_readfirstlane(c.tid >> 6); c.G = gridDim.x; \
    { const int bx = blockIdx.x; c.vcu = (c.G % 8 == 0) ? (bx % 8) * (c.G / 8) + bx / 8 : bx; } \
    c.gw = c.vcu * NWAVES + c.wave; c.NGW = c.G * NWAVES; c.lds = (LAS unsigned char*)lds_raw; c.lds_gen = lds_raw; \
    unsigned char* ws = ap->ws; (void)ws
#define IN(k) (ap->in[k])
__global__ void __launch_bounds__(NTHR, 2) fwd_megakernel(Args a_unused) {
    extern __shared__ __attribute__((aligned(16))) unsigned char lds_raw[];
    { PHASE_PROLOGUE();
      p0_weights(c, IN(2), IN(9), IN(11), (bf16_t*)(ws + WS_WIN), (bf16_t*)(ws + WS_WOUT), (bf16_t*)(ws + WS_WQ));
      for (int row = c.gw; row < NTOK; row += c.NGW) rms1_gates_row(row, c.lane, IN(0), IN(1), IN(2), IN(3), (bf16_t*)(ws + WS_XN), (float*)(ws + WS_LOGF)); }
    { PHASE_PROLOGUE();
      p0_tables(c, IN(13), IN(14), (bf16_t*)(ws + WS_UBF), (bf16_t*)(ws + WS_VBF)); }
    cg::this_grid().sync();
    { PHASE_PROLOGUE();
      if (c.gw < BATCH * FH) cumsum_seq(c.gw, c.lane, (const float*)(ws + WS_LOGF), (float*)(ws + WS_CUM));
      __syncthreads(); }
    { PHASE_PROLOGUE();
      pg8::Gemm g{(const bf16_t*)(ws + WS_XN), (const bf16_t*)(ws + WS_WIN), NTOK, NPROJ, D}; pg8::StaticOrder S; S.init(NTOK, NPROJ, c.G, (int)blockIdx.x);
      pg8::EpiBf16<0> E{(bf16_t*)(ws + WS_PROJ), NPROJ, nullptr, 0, 0, 1.f};
      pg8::gemm_phase<pg8::EpiBf16<0>, pg8::StaticOrder, true, true>(c.lds, g, S, E); }
    cg::this_grid().sync();
    { PHASE_PROLOGUE();
      for (int pu = c.vcu; pu < BATCH * FH * 8; pu += c.G) { const int bh = pu >> 3, s = pu & 7;
          fox_unit(c, bh / FH, bh % FH, 15 - s, (const bf16_t*)(ws + WS_PROJ), (const float*)(ws + WS_CUM), (bf16_t*)(ws + WS_MIXED));
          fox_unit(c, bh / FH, bh % FH, s, (const bf16_t*)(ws + WS_PROJ), (const float*)(ws + WS_CUM), (bf16_t*)(ws + WS_MIXED)); } }
    { PHASE_PROLOGUE();
      const float lam = expf(wave_sum(IN(4)[c.lane] * IN(5)[c.lane])) - expf(wave_sum(IN(6)[c.lane] * IN(7)[c.lane])) + LAMBDA_INIT;
      if (c.tid == 0) ((LAS float*)(c.lds + LDS_LAM))[0] = lam;
      __syncthreads(); }
    { PHASE_PROLOGUE();
      for (int pu = c.vcu; pu < BATCH * DH * 8; pu += c.G) { const int bh = pu >> 3, s = pu & 7;
          diff_unit(c, bh / DH, bh % DH, 15 - s, (const bf16_t*)(ws + WS_PROJ), IN(8), (bf16_t*)(ws + WS_MIXED), ws);
          diff_unit(c, bh / DH, bh % DH, s, (const bf16_t*)(ws + WS_PROJ), IN(8), (bf16_t*)(ws + WS_MIXED), ws); } }
    cg::this_grid().sync();
    { PHASE_PROLOGUE();
      pg8::Gemm g{(const bf16_t*)(ws + WS_MIXED), (const bf16_t*)(ws + WS_WOUT), NTOK, D, D}; pg8::StaticOrder S; S.init(NTOK, D, c.G, (int)blockIdx.x);
      pg8::EpiBf16<0> E{(bf16_t*)(ws + WS_Y), D, nullptr, 0, 0, 1.f};
      pg8::gemm_phase<pg8::EpiBf16<0>, pg8::StaticOrder, true, true>(c.lds, g, S, E); }
    cg::this_grid().sync();
    { PHASE_PROLOGUE();
      for (int row = c.gw; row < NTOK; row += c.NGW) resid_rms2_row(row, c.lane, IN(0), (const bf16_t*)(ws + WS_Y), IN(10), ap->out, (bf16_t*)(ws + WS_XN)); }
    cg::this_grid().sync();
    { PHASE_PROLOGUE();
      pg8::Gemm g{(const bf16_t*)(ws + WS_XN), (const bf16_t*)(ws + WS_WQ), NTOK, PQ, D}; pg8::StaticOrder S; S.init(NTOK, PQ, c.G, (int)blockIdx.x);
      pg8::EpiBf16<0> E{(bf16_t*)(ws + WS_QP), PQ, nullptr, 0, 0, 1.f};
      pg8::gemm_phase<pg8::EpiBf16<0>, pg8::StaticOrder, true, true>(c.lds, g, S, E); }
    cg::this_grid().sync();
    { PHASE_PROLOGUE();
      for (int blk = c.vcu; blk < NTOK / 256; blk += c.G) {
          for (int h = 0; h < PH; ++h) {
              __syncthreads();
              route_stage_subkeys(c, IN(12), h);
              __syncthreads();
              route_tile(c, blk * 8 + c.wave, h, (const bf16_t*)(ws + WS_QP), (int*)(ws + WS_EIDX), (float*)(ws + WS_GATE));
          }
          asm volatile("s_waitcnt vmcnt(0)" ::: "memory");
          __syncthreads();
          for (int i = 0; i < 32; ++i)
              peer_experts_token(blk * 256 + c.wave * 32 + i, c.lane, (const bf16_t*)(ws + WS_XN), (const int*)(ws + WS_EIDX), (const float*)(ws + WS_GATE), (const bf16_t*)(ws + WS_UBF), (const bf16_t*)(ws + WS_VBF), IN(15), ap->out);
      } }
}

extern "C" void kernel_launch(void* const* d_in, const int* in_sizes, int n_in, void* d_out, int out_size, void* d_ws, size_t ws_size, hipStream_t stream) {
    static int grid = 0;
    if (grid == 0) {
        if (n_in != 16 || in_sizes[0] != NTOK * D || out_size != NTOK * D || ws_size < WS_END2) { fprintf(stderr, "kernel_launch: unexpected shapes (n_in %d in0 %d out %d ws %zu)\n", n_in, in_sizes[0], out_size, ws_size); grid = -1; return; }
        int dev = 0, cus = 0, per_cu = 0;
        if (hipGetDevice(&dev) != hipSuccess || hipDeviceGetAttribute(&cus, hipDeviceAttributeMultiprocessorCount, dev) != hipSuccess) { grid = -1; return; }
        if (hipFuncSetAttribute((const void*)fwd_megakernel, hipFuncAttributeMaxDynamicSharedMemorySize, LDS_BYTES) != hipSuccess) { fprintf(stderr, "hipFuncSetAttribute failed\n"); grid = -1; return; }
        if (hipOccupancyMaxActiveBlocksPerMultiprocessor(&per_cu, (const void*)fwd_megakernel, NTHR, LDS_BYTES) != hipSuccess || per_cu < 1) { fprintf(stderr, "occupancy query failed (%d)\n", per_cu); grid = -1; return; }
        grid = cus;
    }
    if (grid < 0) return;
    Args a{};
    for (int i = 0; i < 16; ++i) a.in[i] = (const float*)d_in[i];
    a.out = (float*)d_out; a.ws = (unsigned char*)d_ws;
    void* args[] = {&a};
    hipError_t e = hipLaunchCooperativeKernel((const void*)fwd_megakernel, dim3(grid), dim3(NTHR), args, LDS_BYTES, stream);
    if (e != hipSuccess) fprintf(stderr, "cooperative launch failed: %s (grid %d)\n", hipGetErrorString(e), grid);
}
```

```cpp
#include <hip/hip_runtime.h>
#include <hip/hip_cooperative_groups.h>
#include <cstdio>
#include <cstdint>
#include <cmath>
namespace pg8 {
#define PG8_LAS __attribute__((address_space(3)))
typedef unsigned short bf16_t;
typedef short bf16x8 __attribute__((ext_vector_type(8)));
typedef float f32x4 __attribute__((ext_vector_type(4)));
typedef unsigned u32x4 __attribute__((ext_vector_type(4)));
constexpr int BM = 256, BK = 64, HALF = 128, HTB = HALF * BK * 2  , STAGE_BYTES = 8 * HTB, NXCD = 8, WGM = 8;

__host__ __device__ __forceinline__ int lds_byte(int r, int c) { const int st = (r >> 4) * 2 + (c >> 5), rr = r & 15, cc = c & 31, ob = rr * 64 + cc * 2; return st * 1024 + (ob ^ (((ob >> 9) & 1) << 5)); }
__host__ __device__ __forceinline__ void stage_rc(int b, int& R, int& C) { const int st = b / 1024, sb = b % 1024, swz = sb ^ (((sb >> 9) & 1) << 5); R = (st >> 1) * 16 + swz / 64; C = (st & 1) * 32 + (swz % 64) / 2; }
__host__ __device__ __forceinline__ int perm32(int rho) { const int n = rho >> 4, i = rho & 15; return 8 * (i >> 2) + 4 * n + (i & 3); }

struct Unit { int pm, pn; };
struct Gemm { const bf16_t* A; const bf16_t* Bt; int M, N, K; };

struct StaticOrder {
    int nM, nN, nwg, G, c;
    __host__ __device__ void init(int M, int N, int G_, int c_) { nM = M / BM; nN = N / BM; nwg = nM * nN; G = G_; c = c_; }
    __host__ __device__ bool next(int i, Unit& u) const {
        const long L = (long)i * G + c; if (L >= nwg) return false;
        int wgid = (int)L; { const int q = nwg / NXCD, r = nwg % NXCD, xcd = wgid % NXCD, off = wgid / NXCD; wgid = (xcd < r ? xcd * (q + 1) : r * (q + 1) + (xcd - r) * q) + off; }
        const int nig = WGM * nN, gid = wgid / nig, fm = gid * WGM, gsz = (nM - fm) < WGM ? (nM - fm) : WGM;
        u.pm = fm + ((wgid % nig) % gsz); u.pn = (wgid % nig) / gsz; return true;
    }
    __device__ __forceinline__ void a_ready(const Unit&) const {}
    __device__ __forceinline__ void done(const Unit&) const {}
};

__device__ __forceinline__ unsigned cvt_pk_bf16(float lo, float hi) { unsigned r; asm volatile("v_cvt_pk_bf16_f32 %0, %1, %2" : "=v"(r) : "v"(lo), "v"(hi)); return r; }
typedef float f32x2 __attribute__((ext_vector_type(2)));
__device__ __forceinline__ f32x2 gelu_pk(f32x2 v) {
    const f32x2 av = __builtin_elementwise_abs(v), d = av * 0.2316418882f + 1.0f;
    f32x2 t; t.x = __builtin_amdgcn_rcpf(d.x); t.y = __builtin_amdgcn_rcpf(d.y);
    f32x2 q = t * 0.5307027145f + (-0.7265760135f); q = q * t + 0.7107068705f; q = q * t + (-0.142248368f); q = q * t + 0.127414796f; q = q * t;
    const f32x2 s = (v * v) * (-0.72134752044f);
    f32x2 e; e.x = __builtin_amdgcn_exp2f(s.x); e.y = __builtin_amdgcn_exp2f(s.y);
    const f32x2 m = v * (q * e), r = v - m;
    f32x2 o; o.x = v.x < 0.f ? m.x : r.x; o.y = v.y < 0.f ? m.y : r.y; return o;
}

template <int ACT  > struct EpiBf16 {
    static constexpr bool PERM = true, AFTER_DRAIN = false; static_assert(ACT == 0 || ACT == 1, "EpiBf16: ACT is 0 (none) or 1 (gelu_pk)");
    bf16_t* O; int ldc; const float* bias; int split_cols; size_t split_stride; float scale0;
    __device__ __forceinline__ void operator()(const f32x4 (&acc)[2][2][4][2], const Unit& u, int wr, int wc, int fr, int fq) const {
        const int row0 = u.pm * BM + wr * 64 + fr; int colt = u.pn * BM; bf16_t* base = O;
        float sc = 1.f; if (split_cols) { const int t = colt / split_cols; base += (size_t)t * split_stride; colt -= t * split_cols; if (t == 0) sc = scale0; }
        const int col0 = colt + wc * 32 + 8 * fq, bcol0 = u.pn * BM + wc * 32 + 8 * fq;
        f32x4 bv[2][2];
#pragma unroll
        for (int bj = 0; bj < 2; ++bj)
#pragma unroll
            for (int n = 0; n < 2; ++n) bv[bj][n] = bias ? *(const f32x4*)(bias + bcol0 + bj * HALF + 4 * n) : (f32x4){0.f, 0.f, 0.f, 0.f};
#pragma unroll
        for (int ai = 0; ai < 2; ++ai)
#pragma unroll
            for (int m = 0; m < 4; ++m) { bf16_t* rowp = base + (size_t)(row0 + ai * HALF + m * 16) * ldc + col0;
#pragma unroll
                for (int bj = 0; bj < 2; ++bj) { f32x4 v0 = acc[ai][bj][m][0] + bv[bj][0], v1 = acc[ai][bj][m][1] + bv[bj][1];
                    if (ACT == 1) { f32x2 a = gelu_pk((f32x2){v0[0], v0[1]}), b = gelu_pk((f32x2){v0[2], v0[3]}), c = gelu_pk((f32x2){v1[0], v1[1]}), d = gelu_pk((f32x2){v1[2], v1[3]});
                        v0 = (f32x4){a.x, a.y, b.x, b.y}; v1 = (f32x4){c.x, c.y, d.x, d.y}; }
                    v0 = v0 * sc; v1 = v1 * sc; u32x4 w; w.x = cvt_pk_bf16(v0[0], v0[1]); w.y = cvt_pk_bf16(v0[2], v0[3]); w.z = cvt_pk_bf16(v1[0], v1[1]); w.w = cvt_pk_bf16(v1[2], v1[3]);
                    *(u32x4*)(rowp + bj * HALF) = w; } }
    }
};
template <class Epi, class Sched, bool ALIGN_EPI = false, bool SP2 = false>
__device__ __forceinline__ void gemm_phase(PG8_LAS unsigned char* lds, const Gemm g, const Sched& S, const Epi& E) {
    int tid_l = threadIdx.x; asm volatile("" : "+v"(tid_l));
    const int tid = tid_l, wid = __builtin_amdgcn_readfirstlane(tid >> 6), lane = tid & 63, wr = wid >> 2, wc = wid & 3, fr = lane & 15, fq = lane >> 4;
    const int K = g.K, nt = K / BK;
    unsigned voffA[2], voffB[2];
#pragma unroll
    for (int i = 0; i < 2; ++i) { int R, C; stage_rc(tid * 16 + i * 8192, R, C); const int Rb = Epi::PERM ? ((R & ~31) + perm32(R & 31)) : R;
        voffA[i] = (unsigned)(R * K + C) * 2u; voffB[i] = (unsigned)(Rb * K + C) * 2u; }
    const size_t kstep = (size_t)(BK * 2);
    const size_t hstep = (size_t)HALF * K * 2;
    const size_t tstep = 2 * hstep;
    const unsigned ldsw = (unsigned)wid * 1024u;
    const int aoff = lds_byte(wr * 64 + fr, fq * 8), boff = lds_byte(wc * 32 + fr, fq * 8);
#define PG8_SA(b, h) (((b) * 2 + (h)) * HTB)
#define PG8_SB(b, h) ((4 + (b) * 2 + (h)) * HTB)
#define PG8_STAGE(bufoff, gbase, voff) do { _Pragma("unroll") for (int _i = 0; _i < 2; ++_i) \
        __builtin_amdgcn_global_load_lds((const unsigned*)((const char*)(gbase) + (voff)[_i]), (PG8_LAS unsigned*)(lds + (bufoff) + ldsw + _i * 8192), 16, 0, 0); } while (0)
#define PG8_LDA(dst, b, h) do { _Pragma("unroll") for (int m = 0; m < 4; ++m) _Pragma("unroll") for (int k = 0; k < 2; ++k) dst[m][k] = *(const PG8_LAS bf16x8*)(lds + PG8_SA(b, h) + aoff + m * 2048 + k * 1024); } while (0)
#define PG8_LDB(dst, b, h) do { _Pragma("unroll") for (int n = 0; n < 2; ++n) _Pragma("unroll") for (int k = 0; k < 2; ++k) dst[n][k] = *(const PG8_LAS bf16x8*)(lds + PG8_SB(b, h) + boff + n * 2048 + k * 1024); } while (0)
#define PG8_MMA(ai, bj, At, Bt) do { __builtin_amdgcn_s_setprio(1); _Pragma("unroll") for (int m = 0; m < 4; ++m) _Pragma("unroll") for (int n = 0; n < 2; ++n) _Pragma("unroll") for (int k = 0; k < 2; ++k) \
        acc[ai][bj][m][n] = __builtin_amdgcn_mfma_f32_16x16x32_bf16(Bt[n][k], At[m][k], acc[ai][bj][m][n], 0, 0, 0); __builtin_amdgcn_s_setprio(0); } while (0)
#define PG8_WAIT_V(n) asm volatile("s_waitcnt vmcnt(" #n ")" ::: "memory")
#define PG8_WAIT_L(n) asm volatile("s_waitcnt lgkmcnt(" #n ")" ::: "memory")
#define PG8_BAR __builtin_amdgcn_s_barrier()
#define PG8_SCHED __builtin_amdgcn_sched_barrier(0)
    Unit cur, nxt; int ui = 0;
    if (!S.next(0, cur)) return;
    f32x4 acc[2][2][4][2];
#pragma unroll
    for (int a = 0; a < 2; ++a)
#pragma unroll
        for (int b = 0; b < 2; ++b)
#pragma unroll
            for (int m = 0; m < 4; ++m)
#pragma unroll
                for (int n = 0; n < 2; ++n) acc[a][b][m][n] = (f32x4){0.f, 0.f, 0.f, 0.f};
    bf16x8 At[4][2], B0[2][2], B1[2][2];
    const char* cA = (const char*)g.A + (size_t)cur.pm * tstep; const char* cB = (const char*)g.Bt + (size_t)cur.pn * tstep;
    S.a_ready(cur);
    if constexpr (SP2) {
        PG8_STAGE(PG8_SB(0, 0), cB, voffB); PG8_STAGE(PG8_SB(0, 1), cB + hstep, voffB); PG8_STAGE(PG8_SA(0, 0), cA, voffA); PG8_STAGE(PG8_SA(0, 1), cA + hstep, voffA);
        if (wr == 1) PG8_BAR;
        PG8_WAIT_V(2); PG8_BAR;
        PG8_STAGE(PG8_SB(1, 0), cB + kstep, voffB); PG8_STAGE(PG8_SA(1, 0), cA + kstep, voffA); PG8_STAGE(PG8_SB(1, 1), cB + hstep + kstep, voffB);
        PG8_WAIT_V(6); PG8_BAR;
    } else {
        PG8_STAGE(PG8_SB(0, 0), cB, voffB); PG8_STAGE(PG8_SA(0, 0), cA, voffA); PG8_STAGE(PG8_SB(0, 1), cB + hstep, voffB); PG8_STAGE(PG8_SA(0, 1), cA + hstep, voffA);
        if (wr == 1) PG8_BAR;
        PG8_WAIT_V(4); PG8_BAR;
        PG8_STAGE(PG8_SB(1, 0), cB + kstep, voffB); PG8_STAGE(PG8_SA(1, 0), cA + kstep, voffA); PG8_STAGE(PG8_SB(1, 1), cB + hstep + kstep, voffB);
        PG8_WAIT_V(6); PG8_BAR;
    }
    for (;;) {
        const bool has_next = S.next(ui + 1, nxt);
        const char* nA = has_next ? (const char*)g.A + (size_t)nxt.pm * tstep : cA; const char* nB = has_next ? (const char*)g.Bt + (size_t)nxt.pn * tstep : cB;
        for (int t = 0; t < nt; t += 2) {
            const bool last = (t == nt - 2);
            const char* a1 = cA + (size_t)(t + 1) * kstep;
            const char* a2 = last ? nA : cA + (size_t)(t + 2) * kstep; const char* b2 = last ? nB : cB + (size_t)(t + 2) * kstep;
            const char* a3 = a2 + kstep; const char* b3 = b2 + kstep;
            if (last && has_next) S.a_ready(nxt);
            if constexpr (SP2) {
            PG8_LDB(B0, 0, 0); PG8_LDB(B1, 0, 1); PG8_SCHED; PG8_LDA(At, 0, 0); PG8_STAGE(PG8_SA(1, 1), a1 + hstep, voffA);
            PG8_WAIT_V(8); PG8_WAIT_L(0); PG8_BAR; PG8_MMA(0, 0, At, B0); PG8_MMA(0, 1, At, B1); PG8_BAR; PG8_SCHED;
            PG8_LDA(At, 0, 1); PG8_STAGE(PG8_SB(0, 0), b2, voffB); PG8_STAGE(PG8_SB(0, 1), b2 + hstep, voffB); PG8_STAGE(PG8_SA(0, 0), a2, voffA);
            PG8_WAIT_V(8); PG8_WAIT_L(0); PG8_BAR; PG8_MMA(1, 0, At, B0); PG8_MMA(1, 1, At, B1); PG8_BAR; PG8_SCHED;
            PG8_LDB(B0, 1, 0); PG8_LDB(B1, 1, 1); PG8_SCHED; PG8_LDA(At, 1, 0); PG8_STAGE(PG8_SA(0, 1), a2 + hstep, voffA);
            PG8_WAIT_V(8); PG8_WAIT_L(0); PG8_BAR; PG8_MMA(0, 0, At, B0); PG8_MMA(0, 1, At, B1); PG8_BAR; PG8_SCHED;
            PG8_LDA(At, 1, 1); PG8_STAGE(PG8_SB(1, 0), b3, voffB); PG8_STAGE(PG8_SB(1, 1), b3 + hstep, voffB); PG8_STAGE(PG8_SA(1, 0), a3, voffA);
            PG8_WAIT_V(8); PG8_WAIT_L(0); PG8_BAR; PG8_MMA(1, 0, At, B0); PG8_MMA(1, 1, At, B1); PG8_BAR; PG8_SCHED;
            } else {
            PG8_LDB(B0, 0, 0); PG8_SCHED; PG8_LDA(At, 0, 0); PG8_STAGE(PG8_SA(1, 1), a1 + hstep, voffA);
            PG8_WAIT_L(8); PG8_BAR; PG8_WAIT_L(0); PG8_MMA(0, 0, At, B0); PG8_BAR; PG8_SCHED;
            PG8_LDB(B1, 0, 1); PG8_STAGE(PG8_SB(0, 0), b2, voffB);
            PG8_BAR; PG8_WAIT_L(0); PG8_MMA(0, 1, At, B1); PG8_BAR;
            PG8_LDA(At, 0, 1); PG8_STAGE(PG8_SA(0, 0), a2, voffA);
            PG8_BAR; PG8_WAIT_L(0); PG8_MMA(1, 0, At, B0); PG8_BAR; PG8_SCHED;
            PG8_STAGE(PG8_SB(0, 1), b2 + hstep, voffB);
            PG8_WAIT_V(6); PG8_BAR; PG8_MMA(1, 1, At, B1); PG8_BAR;
            PG8_LDB(B0, 1, 0); PG8_SCHED; PG8_LDA(At, 1, 0); PG8_STAGE(PG8_SA(0, 1), a2 + hstep, voffA);
            PG8_WAIT_L(8); PG8_BAR; PG8_WAIT_L(0); PG8_MMA(0, 0, At, B0); PG8_BAR; PG8_SCHED;
            PG8_LDB(B1, 1, 1); PG8_STAGE(PG8_SB(1, 0), b3, voffB);
            PG8_BAR; PG8_WAIT_L(0); PG8_MMA(0, 1, At, B1); PG8_BAR;
            PG8_LDA(At, 1, 1); PG8_STAGE(PG8_SA(1, 0), a3, voffA);
            PG8_BAR; PG8_WAIT_L(0); PG8_MMA(1, 0, At, B0); PG8_BAR; PG8_SCHED;
            PG8_STAGE(PG8_SB(1, 1), b3 + hstep, voffB);
            PG8_WAIT_V(6); PG8_BAR; PG8_MMA(1, 1, At, B1); PG8_BAR;
            }
        }
        if constexpr (ALIGN_EPI) { if (wr == 0) PG8_BAR; }
        if constexpr (!Epi::AFTER_DRAIN) { E(acc, cur, wr, wc, fr, fq); S.done(cur); }
        if (!has_next) break;
#pragma unroll
        for (int a = 0; a < 2; ++a)
#pragma unroll
            for (int b = 0; b < 2; ++b)
#pragma unroll
                for (int m = 0; m < 4; ++m)
#pragma unroll
                    for (int n = 0; n < 2; ++n) acc[a][b][m][n] = (f32x4){0.f, 0.f, 0.f, 0.f};
        cur = nxt; cA = nA; cB = nB; ++ui;
        if constexpr (ALIGN_EPI) { if (wr == 1) PG8_BAR; }
    }
    PG8_WAIT_V(0);
    if constexpr (!ALIGN_EPI) { if (wr == 0) PG8_BAR; }
    PG8_BAR;
    if constexpr (Epi::AFTER_DRAIN) { E.fused(acc, cur, wr, wc, fr, fq, lds, wid, lane); S.done(cur); }
#undef PG8_SA
#undef PG8_SB
#undef PG8_STAGE
#undef PG8_LDA
#undef PG8_LDB
#undef PG8_MMA
#undef PG8_WAIT_V
#undef PG8_WAIT_L
#undef PG8_BAR
#undef PG8_SCHED
}
}
#include <hip/hip_bf16.h>
#include <cmath>
namespace attn_body {
using bf16=__hip_bfloat16;
using bf16x8=__attribute__((ext_vector_type(8)))short;
using s16x4=__attribute__((ext_vector_type(4)))short;
using f32x16=__attribute__((ext_vector_type(16)))float;
using u32x4=__attribute__((ext_vector_type(4)))unsigned;
constexpr int SEQ=4096,D=64,DM=3072;
constexpr int NW=8,QBLK=32,QB=QBLK*NW,KVBLK=64,NQB=SEQ/QB;
constexpr int ATTN_UNIT_ROWS=QB;
__device__ __forceinline__ int crow(int r,int hi){return (r&3)+8*(r>>2)+4*hi;}
#define SBAR() __builtin_amdgcn_sched_barrier(0)
__device__ __forceinline__ void cmask(f32x16&p0,f32x16&p1,int jb,int qrel,int hi){
  asm volatile("":"+v"(qrel),"+v"(hi));
  const float NEG=-INFINITY; int kb=64*jb+4*hi;
  #pragma unroll
  for(int r=0;r<16;++r){int kv=kb+(r&3)+8*(r>>2); if(kv>qrel)p0[r]=NEG; if(kv+32>qrel)p1[r]=NEG;}
}

constexpr int NSLOT=3, SLOTB=8192;
constexpr int LDS_K=0, LDS_V=NSLOT*SLOTB, LDS_WS=2*NSLOT*SLOTB, LDS_OST=LDS_WS+NW*64*4, LDS_FEAT=LDS_OST+NW*4096, LDS_BYTES=LDS_FEAT+SEQ*8;
constexpr float C2=0.125f*1.4426950408889634f;
__device__ __forceinline__ void glds16(const void*gsrc,unsigned lds_dst){unsigned keep;
  asm volatile("s_mov_b32 %0, m0\n\ts_mov_b32 m0, %2\n\ts_nop 0\n\tglobal_load_lds_dwordx4 %1, off\n\ts_mov_b32 m0, %0":"=&s"(keep):"v"(gsrc),"s"(lds_dst):"memory");}
__device__ __forceinline__ float max3f(float a,float b,float c){float r;asm("v_max3_f32 %0, %1, %2, %3":"=v"(r):"v"(a),"v"(b),"v"(c));return r;}
__device__ __forceinline__ float max2f(float a,float b){float r;asm("v_max_f32_e32 %0, %1, %2":"=v"(r):"v"(a),"v"(b));return r;}
__device__ __forceinline__ float fadd_s(float a,float b){float r;asm("v_add_f32_e32 %0, %1, %2":"=v"(r):"v"(a),"v"(b));return r;}
__device__ __forceinline__ float fsub_s(float a,float b){float r;asm("v_sub_f32_e32 %0, %1, %2":"=v"(r):"v"(a),"v"(b));return r;}
typedef float f32x2_t __attribute__((ext_vector_type(2))); typedef __bf16 bf16x2_t __attribute__((ext_vector_type(2)));
__device__ __forceinline__ unsigned cvtpk_s(float lo,float hi){f32x2_t v={lo,hi};bf16x2_t b=__builtin_convertvector(v,bf16x2_t);return __builtin_bit_cast(unsigned,b);}
#define WAIT_BAR(N) asm volatile("s_waitcnt vmcnt(" #N ") lgkmcnt(0)\n\ts_barrier":::"memory")

__device__ __forceinline__ void qkt(f32x16&p0,f32x16&p1,const char*Kslot,const bf16x8*qr,bf16x8 ax0,bf16x8 ax1,bf16x8 qx,int r32,int hi){
  const char*kb=Kslot+hi*1024+r32*16;
  const f32x16 z=f32x16{};
  p0=__builtin_amdgcn_mfma_f32_32x32x16_bf16(ax0,qx,z,0,0,0);p1=__builtin_amdgcn_mfma_f32_32x32x16_bf16(ax1,qx,z,0,0,0);
  #pragma unroll
  for(int d0=0;d0<4;++d0){
    const bf16x8 b0=*reinterpret_cast<const bf16x8*>(kb+d0*2048);
    const bf16x8 b1=*reinterpret_cast<const bf16x8*>(kb+d0*2048+512);
    p0=__builtin_amdgcn_mfma_f32_32x32x16_bf16(b0,qr[d0],p0,0,0,0);p1=__builtin_amdgcn_mfma_f32_32x32x16_bf16(b1,qr[d0],p1,0,0,0);}
}
typedef __attribute__((address_space(3))) const char* lds_cptr;
typedef short v4i16_t __attribute__((ext_vector_type(4)));
__device__ __forceinline__ void kload8(bf16x8*kf,lds_cptr kp){
  kf[0]=*(const __attribute__((address_space(3))) bf16x8*)(kp);      kf[1]=*(const __attribute__((address_space(3))) bf16x8*)(kp+512);
  kf[2]=*(const __attribute__((address_space(3))) bf16x8*)(kp+2048); kf[3]=*(const __attribute__((address_space(3))) bf16x8*)(kp+2560);
  kf[4]=*(const __attribute__((address_space(3))) bf16x8*)(kp+4096); kf[5]=*(const __attribute__((address_space(3))) bf16x8*)(kp+4608);
  kf[6]=*(const __attribute__((address_space(3))) bf16x8*)(kp+6144); kf[7]=*(const __attribute__((address_space(3))) bf16x8*)(kp+6656);
}
__device__ __forceinline__ void kload2(bf16x8*kf,lds_cptr kp,int j){ kf[2*j]=*(const __attribute__((address_space(3))) bf16x8*)(kp+j*2048); kf[2*j+1]=*(const __attribute__((address_space(3))) bf16x8*)(kp+j*2048+512); }
__device__ __forceinline__ s16x4 vtr(lds_cptr p){ return __builtin_bit_cast(s16x4,__builtin_amdgcn_ds_read_tr16_b64_v4i16((__attribute__((address_space(3))) v4i16_t*)p)); }
__device__ __forceinline__ float rowmax(const f32x16&p0,const f32x16&p1){
  float a=max3f(p0[0],p0[1],p1[0]),b=max3f(p0[2],p0[3],p1[1]);a=max3f(a,p1[2],p1[3]);
  #pragma unroll
  for(int r=4;r<16;r+=4){a=max3f(a,p0[r],p0[r+1]);b=max3f(b,p0[r+2],p0[r+3]);a=max3f(a,p1[r],p1[r+1]);b=max3f(b,p1[r+2],p1[r+3]);}
  const float m=max2f(a,b);
  auto rr=__builtin_amdgcn_permlane32_swap(__float_as_uint(m),__float_as_uint(m),false,false);
  return max2f(__uint_as_float(rr[0]),__uint_as_float(rr[1]));
}
__device__ __forceinline__ void pv(f32x16*o,int vb,bf16x8 pa0,bf16x8 pa1,bf16x8 pa2,bf16x8 pa3){
  #pragma unroll
  for(int d0=0;d0<2;++d0){s16x4 lo[4],hi[4];
    #pragma unroll
    for(int ks=0;ks<4;++ks){
      asm volatile("ds_read_b64_tr_b16 %0,%1 offset:%c2":"=&v"(lo[ks]):"v"(vb),"i"(d0*4096+ks*1024):"memory");
      asm volatile("ds_read_b64_tr_b16 %0,%1 offset:%c2":"=&v"(hi[ks]):"v"(vb),"i"(d0*4096+ks*1024+512):"memory");}
    asm volatile("s_waitcnt lgkmcnt(0)":::"memory");SBAR();
    #define PK(k) (bf16x8){lo[k][0],lo[k][1],lo[k][2],lo[k][3],hi[k][0],hi[k][1],hi[k][2],hi[k][3]}
    o[d0]=__builtin_amdgcn_mfma_f32_32x32x16_bf16(pa0,PK(0),o[d0],0,0,0);
    o[d0]=__builtin_amdgcn_mfma_f32_32x32x16_bf16(pa1,PK(1),o[d0],0,0,0);
    o[d0]=__builtin_amdgcn_mfma_f32_32x32x16_bf16(pa2,PK(2),o[d0],0,0,0);
    o[d0]=__builtin_amdgcn_mfma_f32_32x32x16_bf16(pa3,PK(3),o[d0],0,0,0);
    #undef PK
  }
}


typedef unsigned u32x2 __attribute__((ext_vector_type(2)));
__device__ __forceinline__ void split3(float v,unsigned&h16,unsigned&m16,unsigned&l16){
  const unsigned uh=__float_as_uint(v)&0xffff0000u; const float r1=v-__uint_as_float(uh);
  const unsigned um=__float_as_uint(r1)&0xffff0000u; const float r2=r1-__uint_as_float(um);
  const unsigned ul=__float_as_uint(r2); h16=uh>>16; m16=um>>16; l16=(ul+0x7fffu+((ul>>16)&1u))>>16;
}
__device__ __forceinline__ bf16x8 make_qx(float qc){ unsigned h,m,l; split3(qc,h,m,l); const u32x4 w={0x3f803f80u,0x3f80u|(h<<16),m|(l<<16),0u}; return __builtin_bit_cast(bf16x8,w); }
__device__ __forceinline__ void dmask(f32x16&p0,f32x16&p1,int jb,int wid,int r32,int hi,float slope2){
  asm volatile("":"+v"(r32),"+v"(hi));
  const int dj=wid>>1, qrel=32*(wid&1)+r32; const float slope2x2=2.f*slope2;
  if(jb>dj){
    #pragma unroll
    for(int r=0;r<16;++r){p0[r]=-INFINITY;p1[r]=-INFINITY;}
  } else if(jb==dj){
    #pragma unroll
    for(int r=0;r<16;++r){const int kv=4*hi+(r&3)+8*(r>>2); if(kv>qrel)p0[r]-=slope2x2*(float)(kv-qrel); if(kv+32>qrel)p1[r]-=slope2x2*(float)(kv+32-qrel);}
  }
}

template<int MODE> __device__ __forceinline__ int attn_jmin(int qb,float bound,const float*__restrict__ cumf,float slope2,int lane){
  const int NTt=4*qb+4, q0=256*qb; bool negl=false;
  if(lane<NTt-4){ const float bias=(MODE==0)?((cumf[q0]-cumf[64*lane+63])*1.4426950408889634f):(-slope2*(float)(q0-(64*lane+63))); negl=(bound+bias)<-160.f; }
  const unsigned long long m=__ballot(negl); const int n=(m==~0ull)?64:(__ffsll((long long)~m)-1);
  return n&~1;
}
template<int MODE,int THRL> __device__ __forceinline__ void attn_pass(int qb,int jmin,const bf16*Qh,const bf16*__restrict__ Kh0,const bf16*__restrict__ Vh0,const float*__restrict__ cumf,float slope2,char*shm,f32x16(&o)[2]){
  const bf16*__restrict__ Kh=Kh0+(long)jmin*KVBLK*DM; const bf16*__restrict__ Vh=Vh0+(long)jmin*KVBLK*DM;
  int tid_l=threadIdx.x; asm volatile("":"+v"(tid_l));
  const int tid=tid_l,lane=tid&63,r32=lane&31,hi=lane>>5; const int wid=__builtin_amdgcn_readfirstlane(tid>>6);
  const int q0=qb*QB;
  const bf16*Qw=Qh+(long)(q0+wid*QBLK)*DM;
  const unsigned lds0=(unsigned)(uintptr_t)shm;
  float*wsf=(float*)(shm+LDS_WS)+wid*64;
  const int NT=(q0+QB)/KVBLK-jmin;
  const lds_cptr shm3=(lds_cptr)shm;
  const __attribute__((address_space(3))) u32x2*featr=(const __attribute__((address_space(3))) u32x2*)(shm3+LDS_FEAT)+lane;
  #define AXF0(f) __builtin_bit_cast(bf16x8,(u32x4){hi?0u:(f).x,hi?0u:(f).y,hi?0u:0x3f803f80u,0u})
  #define AXF1(f) __builtin_bit_cast(bf16x8,(u32x4){hi?(f).x:0u,hi?(f).y:0u,hi?0x3f803f80u:0u,0u})
  const bf16*ksrc=Kh+(long)lane*DM+wid*8;
  const bf16*vsrc=Vh+(long)(16*(wid&3)+(lane>>2))*DM+(wid>>2)*32+(lane&3)*8;
  const unsigned kdst=lds0+LDS_K+wid*1024, vdst=lds0+LDS_V+wid*1024;
  #define DMA_K(t,slot) glds16(ksrc+(long)(t)*KVBLK*DM,(unsigned)__builtin_amdgcn_readfirstlane(kdst+(slot)))
  #define DMA_V(t,slot) glds16(vsrc+(long)(t)*KVBLK*DM,(unsigned)__builtin_amdgcn_readfirstlane(vdst+(slot)))
  const int vb0=(int)(lds0+LDS_V)+((lane>>4)&1)*32+(lane&3)*8+(4*hi+((lane&15)>>2))*64;
  const char*Kbase=shm+LDS_K; bf16x8 kf[8];
  const lds_cptr kp0=shm3+LDS_K+hi*1024+r32*16; const lds_cptr vp0=shm3+LDS_V+((lane>>4)&1)*32+(lane&3)*8+(4*hi+((lane&15)>>2))*64;
  const float qc=(MODE==0)?(cumf[q0+wid*QBLK+r32]*1.4426950408889634f):(-slope2*(float)(q0+wid*QBLK+r32));
  DMA_K(0,0);DMA_V(0,0);DMA_K(1,SLOTB);
  bf16x8 qr[4];
  #pragma unroll
  for(int d0=0;d0<4;++d0)qr[d0]=*reinterpret_cast<const bf16x8*>(&Qw[(long)r32*DM+d0*16+hi*8]);
  { __attribute__((address_space(3))) u32x2*feat=(__attribute__((address_space(3))) u32x2*)(shm+LDS_FEAT);
    if(MODE==0){ float cv[8];
      #pragma unroll
      for(int i=0;i<8;++i){ const int s=tid+NW*64*i; cv[i]=(s<64*NT)?cumf[s+64*jmin]:0.f; }
      #pragma unroll
      for(int i=0;i<8;++i){ const int s=tid+NW*64*i; if(s<64*NT){ unsigned h,m,l; split3(-cv[i]*1.4426950408889634f,h,m,l); u32x2 w; w.x=h|(m<<16); w.y=l|0x3f800000u; feat[s]=w; } } }
    else for(int s=tid;s<64*NT;s+=NW*64){ const int sg=s+64*jmin; const float kx=slope2*(float)sg; unsigned h,m,l; split3(kx,h,m,l); u32x2 w; w.x=h|(m<<16); w.y=l|0x3f800000u; feat[s]=w; } }
  float qcm=qc,l_reg=0.f;o[0]=f32x16{};o[1]=f32x16{};
  bf16x8 qx=make_qx(qcm);
  const int qrel=wid*QBLK+r32;
  #define CMASK(P0,P1,t) do{int jb_=(t)-(NT-4); if(jb_>=0){ if(MODE==0)cmask(P0,P1,jb_,qrel,hi); else dmask(P0,P1,jb_,wid,r32,hi,slope2);} }while(0)
  bool resc=false;
  #define RESC() do{ if(resc){ asm volatile("s_waitcnt lgkmcnt(0)":::"memory"); \
      _Pragma("unroll") for(int d_=0;d_<2;++d_) _Pragma("unroll") for(int r=0;r<16;++r)o[d_][r]*=wsf[crow(r,hi)]; } }while(0)
  f32x16 pA0,pA1,pB0,pB1;
  int sl_prev=0,sl_cur=0,sl_next=SLOTB;
  #define ROT() do{sl_prev=sl_cur;sl_cur=sl_next;sl_next=(sl_next==(NSLOT-1)*SLOTB)?0:sl_next+SLOTB;}while(0)
  DMA_K(2,2*SLOTB);
  WAIT_BAR(3);
  u32x2 fx=featr[0];
  qkt(pA0,pA1,Kbase,qr,AXF0(fx),AXF1(fx),qx,r32,hi);asm volatile("s_nop 15\n\ts_nop 7":"+v"(pA0),"+v"(pA1));CMASK(pA0,pA1,0);
  { const float rm=rowmax(pA0,pA1); const float dl=(rm>(float)THRL)?rm:0.f; qcm-=dl;
    _Pragma("unroll") for(int r=0;r<16;++r){pA0[r]=fsub_s(pA0[r],dl);pA1[r]=fsub_s(pA1[r],dl);}
    qx=make_qx(qcm);
    _Pragma("unroll") for(int r=0;r<16;++r)pA0[r]=__builtin_amdgcn_exp2f(pA0[r]); }
  _Pragma("unroll") for(int r=0;r<16;++r)pA1[r]=__builtin_amdgcn_exp2f(pA1[r]);
  fx=featr[64];
  WAIT_BAR(0);
  DMA_K(3,0);DMA_V(1,SLOTB);
  ROT();
  kload8(kf,kp0+sl_cur);
  WAIT_BAR(2);
  s16x4 vlo[8],vhi[8]; u32x4 pw0,pw1,pw2,pw3;
  #define PKW(P,B) cvtpk_s(P[B],P[B+1])
  #define PAF(k) __builtin_bit_cast(bf16x8,pw##k)
  #define VFR(i) (bf16x8){vlo[i][0],vlo[i][1],vlo[i][2],vlo[i][3],vhi[i][0],vhi[i][1],vhi[i][2],vhi[i][3]}
  #define PIN(x) asm volatile("":"+v"(x))
  #define MX3(a,b,c) __builtin_fmaxf(__builtin_fmaxf((a),(b)),(c))
  #define GAPA(MF,A0,A1,A2,A3,W0,W1,PW) do{ MF; sacc+=A0; sacc+=A1; sacc+=A2; sacc+=A3; PIN(sacc); W0; W1; PIN(PW); SBAR(); }while(0)
  #define EX(v) __builtin_amdgcn_exp2f(v)
  #define GAPB(MF,X,B) do{ MF; X[B]=EX(X[B]); X[B+1]=EX(X[B+1]); X[B+2]=EX(X[B+2]); X[B+3]=EX(X[B+3]); PIN(X); SBAR(); }while(0)
  #define VRD(i) do{ vlo[i]=vtr(vp_+(((i)>>2)*4096+((i)&3)*1024)); vhi[i]=vtr(vp_+(((i)>>2)*4096+((i)&3)*1024+512)); }while(0)
  #define KRD(G,j) do{ if(G){ kload2(kf,kp0+sl_next,j); SBAR(); } }while(0)
  #define STEP(C0,C1,P0,P1,t,GK,GV,GL) do{ SBAR(); \
    const lds_cptr vp_=vp0+sl_prev; \
    { const bf16x8 ax0_=AXF0(fx), ax1_=AXF1(fx); const f32x16 z_=f32x16{}; \
      C0=__builtin_amdgcn_mfma_f32_32x32x16_bf16(ax0_,qx,z_,0,0,0); C1=__builtin_amdgcn_mfma_f32_32x32x16_bf16(ax1_,qx,z_,0,0,0); SBAR(); } \
    VRD(0); SBAR(); float sacc=(P0[0]+P0[1]); \
    GAPA(C0=__builtin_amdgcn_mfma_f32_32x32x16_bf16(kf[0],qr[0],C0,0,0,0), P0[2],P0[3],P0[4],P0[5],     pw0[0]=PKW(P0,0), pw0[1]=PKW(P0,2), pw0); \
    VRD(4); SBAR(); GAPA(C1=__builtin_amdgcn_mfma_f32_32x32x16_bf16(kf[1],qr[0],C1,0,0,0), P0[6],P0[7],P0[8],P0[9],     pw0[2]=PKW(P0,4), pw0[3]=PKW(P0,6), pw0); \
    VRD(1); SBAR(); GAPA(C0=__builtin_amdgcn_mfma_f32_32x32x16_bf16(kf[2],qr[1],C0,0,0,0),   P0[10],P0[11],P0[12],P0[13], pw1[0]=PKW(P0,8), pw1[1]=PKW(P0,10), pw1); \
    VRD(5); SBAR(); GAPA(C1=__builtin_amdgcn_mfma_f32_32x32x16_bf16(kf[3],qr[1],C1,0,0,0),   P0[14],P0[15],P1[0],P1[1],   pw1[2]=PKW(P0,12),pw1[3]=PKW(P0,14), pw1); \
    VRD(2); SBAR(); GAPA(C0=__builtin_amdgcn_mfma_f32_32x32x16_bf16(kf[4],qr[2],C0,0,0,0),   P1[2],P1[3],P1[4],P1[5],     pw2[0]=PKW(P1,0), pw2[1]=PKW(P1,2), pw2); \
    VRD(6); SBAR(); GAPA(C1=__builtin_amdgcn_mfma_f32_32x32x16_bf16(kf[5],qr[2],C1,0,0,0),   P1[6],P1[7],P1[8],P1[9],     pw2[2]=PKW(P1,4), pw2[3]=PKW(P1,6), pw2); \
    VRD(3); SBAR(); GAPA(C0=__builtin_amdgcn_mfma_f32_32x32x16_bf16(kf[6],qr[3],C0,0,0,0),   P1[10],P1[11],P1[12],P1[13], pw3[0]=PKW(P1,8), pw3[1]=PKW(P1,10), pw3); \
    VRD(7); SBAR(); GAPA(C1=__builtin_amdgcn_mfma_f32_32x32x16_bf16(kf[7],qr[3],C1,0,0,0),   P1[14],P1[15],0.f,0.f,       pw3[2]=PKW(P1,12),pw3[3]=PKW(P1,14), pw3); \
    l_reg+=sacc; \
    if(GK){DMA_K((t)+3,sl_cur);} if(GV){DMA_V((t)+1,sl_next);} \
    CMASK(C0,C1,t); \
    { float a=MX3(C0[0],C0[1],C1[0]),b=MX3(C0[2],C0[3],C1[1]); a=MX3(a,C1[2],C1[3]); \
      _Pragma("unroll") for(int r=4;r<16;r+=4){a=MX3(a,C0[r],C0[r+1]);b=MX3(b,C0[r+2],C0[r+3]);a=MX3(a,C1[r],C1[r+1]);b=MX3(b,C1[r+2],C1[r+3]);} \
      float rm=__builtin_fmaxf(a,b); { auto rr=__builtin_amdgcn_permlane32_swap(__float_as_uint(rm),__float_as_uint(rm),false,false); rm=__builtin_fmaxf(__uint_as_float(rr[0]),__uint_as_float(rr[1])); } \
      resc=false; \
      if(__builtin_expect(__any(rm>(float)THRL),0)){ const float dl=__builtin_fmaxf(rm,0.f); qcm-=dl; \
        _Pragma("unroll") for(int r=0;r<16;++r){C0[r]-=dl;C1[r]-=dl;} \
        qx=make_qx(qcm); \
        const float f=__builtin_amdgcn_exp2f(-dl); l_reg*=f; if(hi==0)wsf[r32]=f; resc=true; } } \
    SBAR(); \
    GAPB(o[0]=__builtin_amdgcn_mfma_f32_32x32x16_bf16(PAF(0),VFR(0),o[0],0,0,0), C0,0); \
    GAPB(o[1]=__builtin_amdgcn_mfma_f32_32x32x16_bf16(PAF(0),VFR(4),o[1],0,0,0), C0,4); \
    KRD(GL,0); GAPB(o[0]=__builtin_amdgcn_mfma_f32_32x32x16_bf16(PAF(1),VFR(1),o[0],0,0,0), C0,8); \
    KRD(GL,1); GAPB(o[1]=__builtin_amdgcn_mfma_f32_32x32x16_bf16(PAF(1),VFR(5),o[1],0,0,0), C0,12); \
    KRD(GL,2); GAPB(o[0]=__builtin_amdgcn_mfma_f32_32x32x16_bf16(PAF(2),VFR(2),o[0],0,0,0), C1,0); \
    KRD(GL,3); GAPB(o[1]=__builtin_amdgcn_mfma_f32_32x32x16_bf16(PAF(2),VFR(6),o[1],0,0,0), C1,4); \
    if(GL){ fx=featr[64*((t)+1)]; SBAR(); } \
    GAPB(o[0]=__builtin_amdgcn_mfma_f32_32x32x16_bf16(PAF(3),VFR(3),o[0],0,0,0), C1,8); \
    GAPB(o[1]=__builtin_amdgcn_mfma_f32_32x32x16_bf16(PAF(3),VFR(7),o[1],0,0,0), C1,12); \
    }while(0)
  int t=1;
  #undef CMASK
  #define CMASK(P0,P1,t) do{}while(0)
  for(;t+5<NT;t+=2){
    STEP(pB0,pB1,pA0,pA1,t,true,true,true);     WAIT_BAR(2); RESC(); ROT();
    STEP(pA0,pA1,pB0,pB1,t+1,true,true,true);   WAIT_BAR(2); RESC(); ROT();
  }
  #undef CMASK
  #define CMASK(P0,P1,t) do{int jb_=(t)-(NT-4); if(jb_>=0){ if(MODE==0)cmask(P0,P1,jb_,qrel,hi); else dmask(P0,P1,jb_,wid,r32,hi,slope2);} }while(0)
  #define ENDW(tt) do{ if((tt)+3<NT){WAIT_BAR(2);} else if((tt)+2<NT){WAIT_BAR(1);} else {WAIT_BAR(0);} }while(0)
  for(;t+1<NT;t+=2){
    STEP(pB0,pB1,pA0,pA1,t,(t+3<NT),(t+1<NT),(t+1<NT));       ENDW(t);   RESC(); ROT();
    STEP(pA0,pA1,pB0,pB1,t+1,(t+4<NT),(t+2<NT),(t+2<NT));     ENDW(t+1); RESC(); ROT();
  }
  STEP(pB0,pB1,pA0,pA1,NT-1,false,false,false); RESC();
  { float sacc=pB0[0]+pB0[1]; _Pragma("unroll") for(int r=2;r<16;++r)sacc+=pB0[r]; _Pragma("unroll") for(int r=0;r<16;++r)sacc+=pB1[r]; l_reg+=sacc;
    pw0=(u32x4){PKW(pB0,0),PKW(pB0,2),PKW(pB0,4),PKW(pB0,6)};pw1=(u32x4){PKW(pB0,8),PKW(pB0,10),PKW(pB0,12),PKW(pB0,14)};pw2=(u32x4){PKW(pB1,0),PKW(pB1,2),PKW(pB1,4),PKW(pB1,6)};pw3=(u32x4){PKW(pB1,8),PKW(pB1,10),PKW(pB1,12),PKW(pB1,14)};
    SBAR(); pv(o,vb0+sl_cur,PAF(0),PAF(1),PAF(2),PAF(3)); }
  #undef PKW
  #undef PAF
  #undef VFR
  #undef PIN
  #undef MX3
  #undef GAPA
  #undef GAPB
  #undef EX
  #undef VRD
  #undef KRD
  #undef STEP
  #undef ENDW
  {auto rr=__builtin_amdgcn_permlane32_swap(__float_as_uint(l_reg),__float_as_uint(l_reg),false,false);l_reg=__uint_as_float(rr[0])+__uint_as_float(rr[1]);}
  if(hi==0)wsf[32+r32]=l_reg;asm volatile("s_waitcnt lgkmcnt(0)":::"memory");
  #pragma unroll
  for(int r=0;r<16;++r){const float rli=__builtin_amdgcn_rcpf(wsf[32+crow(r,hi)]); o[0][r]*=rli; o[1][r]*=rli;}
  asm volatile("s_waitcnt lgkmcnt(0)\n\ts_barrier":::"memory");
  #undef DMA_K
  #undef DMA_V
  #undef CMASK
  #undef RESC
  #undef ROT
  #undef AXF0
  #undef AXF1
}
constexpr int D2_K=0, D2_V=4*8192, D2_VS=16384, D2_WS=D2_V+3*D2_VS, D2_FEAT=D2_WS+NW*64*4, D2_BYTES=D2_FEAT+SEQ*8;
template<int THRL> __device__ __forceinline__ void attn_pass_dv128(int qb,int jmin,const bf16*Qh,const bf16*__restrict__ Kh0,const bf16*__restrict__ Vh0,float slope2,char*shm,f32x16(&o)[4]){
  constexpr int MODE=1; const float*cumf=nullptr;
  const bf16*__restrict__ Kh=Kh0+(long)jmin*KVBLK*DM; const bf16*__restrict__ Vh=Vh0+(long)jmin*KVBLK*DM;
  int tid_l=threadIdx.x; asm volatile("":"+v"(tid_l));
  const int tid=tid_l,lane=tid&63,r32=lane&31,hi=lane>>5; const int wid=__builtin_amdgcn_readfirstlane(tid>>6);
  const int q0=qb*QB;
  const bf16*Qw=Qh+(long)(q0+wid*QBLK)*DM;
  const unsigned lds0=(unsigned)(uintptr_t)shm;
  float*wsf=(float*)(shm+D2_WS)+wid*64;
  const int NT=(q0+QB)/KVBLK-jmin;
  const lds_cptr shm3=(lds_cptr)shm;
  const __attribute__((address_space(3))) u32x2*featr=(const __attribute__((address_space(3))) u32x2*)(shm3+D2_FEAT)+lane;
  #define AXF0(f) __builtin_bit_cast(bf16x8,(u32x4){hi?0u:(f).x,hi?0u:(f).y,hi?0u:0x3f803f80u,0u})
  #define AXF1(f) __builtin_bit_cast(bf16x8,(u32x4){hi?(f).x:0u,hi?(f).y:0u,hi?0x3f803f80u:0u,0u})
  const bf16*ksrc=Kh+(long)lane*DM+wid*8;
  const bf16*vsrc=Vh+(long)(16*(wid&3)+(lane>>2))*DM+(wid>>2)*32+(lane&3)*8;
  const unsigned kdst=lds0+D2_K+wid*1024, vdst=lds0+D2_V+wid*1024;
  #define DMA_K(t,slot) glds16(ksrc+(long)(t)*KVBLK*DM,(unsigned)__builtin_amdgcn_readfirstlane(kdst+(slot)))
  #define DMA_V(t,slot) do{ glds16(vsrc+(long)(t)*KVBLK*DM,(unsigned)__builtin_amdgcn_readfirstlane(vdst+(slot))); glds16(vsrc+(long)(t)*KVBLK*DM+64,(unsigned)__builtin_amdgcn_readfirstlane(vdst+(slot)+8192)); }while(0)
  const int vb0=(int)(lds0+D2_V)+((lane>>4)&1)*32+(lane&3)*8+(4*hi+((lane&15)>>2))*64;
  const char*Kbase=shm+D2_K;
  const lds_cptr kp0=shm3+D2_K+hi*1024+r32*16; const lds_cptr vp0=shm3+D2_V+((lane>>4)&1)*32+(lane&3)*8+(4*hi+((lane&15)>>2))*64;
  const float qc=(MODE==0)?(cumf[q0+wid*QBLK+r32]*1.4426950408889634f):(-slope2*(float)(q0+wid*QBLK+r32));
  DMA_K(0,0);DMA_V(0,0);DMA_K(1,8192);
  bf16x8 qr[4];
  #pragma unroll
  for(int d0=0;d0<4;++d0)qr[d0]=*reinterpret_cast<const bf16x8*>(&Qw[(long)r32*DM+d0*16+hi*8]);
  { __attribute__((address_space(3))) u32x2*feat=(__attribute__((address_space(3))) u32x2*)(shm+D2_FEAT);
    for(int s=tid;s<64*NT;s+=NW*64){ const int sg=s+64*jmin; const float kx=(MODE==0)?(-cumf[sg]*1.4426950408889634f):(slope2*(float)sg); unsigned h,m,l; split3(kx,h,m,l); u32x2 w; w.x=h|(m<<16); w.y=l|0x3f800000u; feat[s]=w; } }
  float qcm=qc,l_reg=0.f;o[0]=f32x16{};o[1]=f32x16{};o[2]=f32x16{};o[3]=f32x16{};
  bf16x8 qx=make_qx(qcm);
  const int qrel=wid*QBLK+r32;
  #define CMASK(P0,P1,t) do{int jb_=(t)-(NT-4); if(jb_>=0){ if(MODE==0)cmask(P0,P1,jb_,qrel,hi); else dmask(P0,P1,jb_,wid,r32,hi,slope2);} }while(0)
  bool resc=false;
  #define RESC() do{ if(resc){ asm volatile("s_waitcnt lgkmcnt(0)":::"memory"); \
      _Pragma("unroll") for(int d_=0;d_<4;++d_) _Pragma("unroll") for(int r=0;r<16;++r)o[d_][r]*=wsf[crow(r,hi)]; } }while(0)
  f32x16 pA0,pA1,pB0,pB1;
  int sl_prev=0,sl_cur=0,sl_next=D2_VS;
  #define ROT() do{sl_prev=sl_cur;sl_cur=sl_next;sl_next=(sl_next==2*D2_VS)?0:sl_next+D2_VS;}while(0)
  #define KSL(t) (((t)&3)*8192)
  DMA_K(2,2*8192);
  WAIT_BAR(4);
  u32x2 fx=featr[0];
  qkt(pA0,pA1,Kbase,qr,AXF0(fx),AXF1(fx),qx,r32,hi);asm volatile("s_nop 15\n\ts_nop 7":"+v"(pA0),"+v"(pA1));CMASK(pA0,pA1,0);
  { const float rm=rowmax(pA0,pA1); const float dl=(rm>(float)THRL)?rm:0.f; qcm-=dl;
    _Pragma("unroll") for(int r=0;r<16;++r){pA0[r]=fsub_s(pA0[r],dl);pA1[r]=fsub_s(pA1[r],dl);}
    qx=make_qx(qcm);
    _Pragma("unroll") for(int r=0;r<16;++r)pA0[r]=__builtin_amdgcn_exp2f(pA0[r]); }
  _Pragma("unroll") for(int r=0;r<16;++r)pA1[r]=__builtin_amdgcn_exp2f(pA1[r]);
  fx=featr[64];
  WAIT_BAR(0);
  DMA_K(3,3*8192);DMA_V(1,D2_VS);
  ROT();
  s16x4 vlo[8],vhi[8]; u32x4 pw0,pw1,pw2,pw3;
  #define PKW(P,B) cvtpk_s(P[B],P[B+1])
  #define PAF(k) __builtin_bit_cast(bf16x8,pw##k)
  #define VFR(i) (bf16x8){vlo[i][0],vlo[i][1],vlo[i][2],vlo[i][3],vhi[i][0],vhi[i][1],vhi[i][2],vhi[i][3]}
  #define PIN(x) asm volatile("":"+v"(x))
  #define MX3(a,b,c) __builtin_fmaxf(__builtin_fmaxf((a),(b)),(c))
  #define GAPA(MF,A0,A1,A2,A3,W0,W1,PW) do{ MF; sacc+=A0; sacc+=A1; sacc+=A2; sacc+=A3; PIN(sacc); W0; W1; PIN(PW); SBAR(); }while(0)
  #define EX(v) __builtin_amdgcn_exp2f(v)
  #define GAPB(MF,X,B) do{ MF; X[B]=EX(X[B]); X[B+1]=EX(X[B+1]); X[B+2]=EX(X[B+2]); X[B+3]=EX(X[B+3]); PIN(X); SBAR(); }while(0)
  #define GAPB2(MF,X,B) do{ MF; X[B]=EX(X[B]); X[B+1]=EX(X[B+1]); PIN(X); SBAR(); }while(0)
  #define VRD(i) do{ vlo[i]=vtr(vp_+(((i)>>2)*4096+((i)&3)*1024)); vhi[i]=vtr(vp_+(((i)>>2)*4096+((i)&3)*1024+512)); }while(0)
  #define VRC(i) do{ vlo[i]=vtr(vp_+8192+(((i)>>2)*4096+((i)&3)*1024)); vhi[i]=vtr(vp_+8192+(((i)>>2)*4096+((i)&3)*1024+512)); }while(0)
  #define KF(j) do{ kA[(j)&1]=*(const __attribute__((address_space(3))) bf16x8*)(kq_+(j)*2048); kB[(j)&1]=*(const __attribute__((address_space(3))) bf16x8*)(kq_+(j)*2048+512); }while(0)
  #define STEP(C0,C1,P0,P1,t,GK,GV,GL) do{ SBAR(); \
    const lds_cptr vp_=vp0+sl_prev; const lds_cptr kq_=kp0+KSL(t); bf16x8 kA[2],kB[2]; \
    KF(0); SBAR(); \
    { const bf16x8 ax0_=AXF0(fx), ax1_=AXF1(fx); const f32x16 z_=f32x16{}; \
      C0=__builtin_amdgcn_mfma_f32_32x32x16_bf16(ax0_,qx,z_,0,0,0); C1=__builtin_amdgcn_mfma_f32_32x32x16_bf16(ax1_,qx,z_,0,0,0); SBAR(); } \
    KF(1); VRD(0); SBAR(); float sacc=(P0[0]+P0[1]); \
    GAPA(C0=__builtin_amdgcn_mfma_f32_32x32x16_bf16(kA[0],qr[0],C0,0,0,0), P0[2],P0[3],P0[4],P0[5],     pw0[0]=PKW(P0,0), pw0[1]=PKW(P0,2), pw0); \
    VRD(4); SBAR(); GAPA(C1=__builtin_amdgcn_mfma_f32_32x32x16_bf16(kB[0],qr[0],C1,0,0,0), P0[6],P0[7],P0[8],P0[9],     pw0[2]=PKW(P0,4), pw0[3]=PKW(P0,6), pw0); \
    KF(2); VRD(1); SBAR(); GAPA(C0=__builtin_amdgcn_mfma_f32_32x32x16_bf16(kA[1],qr[1],C0,0,0,0),   P0[10],P0[11],P0[12],P0[13], pw1[0]=PKW(P0,8), pw1[1]=PKW(P0,10), pw1); \
    VRD(5); SBAR(); GAPA(C1=__builtin_amdgcn_mfma_f32_32x32x16_bf16(kB[1],qr[1],C1,0,0,0),   P0[14],P0[15],P1[0],P1[1],   pw1[2]=PKW(P0,12),pw1[3]=PKW(P0,14), pw1); \
    KF(3); VRD(2); SBAR(); GAPA(C0=__builtin_amdgcn_mfma_f32_32x32x16_bf16(kA[0],qr[2],C0,0,0,0),   P1[2],P1[3],P1[4],P1[5],     pw2[0]=PKW(P1,0), pw2[1]=PKW(P1,2), pw2); \
    VRD(6); SBAR(); GAPA(C1=__builtin_amdgcn_mfma_f32_32x32x16_bf16(kB[0],qr[2],C1,0,0,0),   P1[6],P1[7],P1[8],P1[9],     pw2[2]=PKW(P1,4), pw2[3]=PKW(P1,6), pw2); \
    VRD(3); SBAR(); GAPA(C0=__builtin_amdgcn_mfma_f32_32x32x16_bf16(kA[1],qr[3],C0,0,0,0),   P1[10],P1[11],P1[12],P1[13], pw3[0]=PKW(P1,8), pw3[1]=PKW(P1,10), pw3); \
    VRD(7); SBAR(); GAPA(C1=__builtin_amdgcn_mfma_f32_32x32x16_bf16(kB[1],qr[3],C1,0,0,0),   P1[14],P1[15],0.f,0.f,       pw3[2]=PKW(P1,12),pw3[3]=PKW(P1,14), pw3); \
    l_reg+=sacc; \
    if(GK){DMA_K((t)+3,KSL((t)+3));} if(GV){DMA_V((t)+1,sl_next);} \
    CMASK(C0,C1,t); \
    { float a=MX3(C0[0],C0[1],C1[0]),b=MX3(C0[2],C0[3],C1[1]); a=MX3(a,C1[2],C1[3]); \
      _Pragma("unroll") for(int r=4;r<16;r+=4){a=MX3(a,C0[r],C0[r+1]);b=MX3(b,C0[r+2],C0[r+3]);a=MX3(a,C1[r],C1[r+1]);b=MX3(b,C1[r+2],C1[r+3]);} \
      float rm=__builtin_fmaxf(a,b); { auto rr=__builtin_amdgcn_permlane32_swap(__float_as_uint(rm),__float_as_uint(rm),false,false); rm=__builtin_fmaxf(__uint_as_float(rr[0]),__uint_as_float(rr[1])); } \
      resc=false; \
      if(__builtin_expect(__any(rm>(float)THRL),0)){ const float dl=__builtin_fmaxf(rm,0.f); qcm-=dl; \
        _Pragma("unroll") for(int r=0;r<16;++r){C0[r]-=dl;C1[r]-=dl;} \
        qx=make_qx(qcm); \
        const float f=__builtin_amdgcn_exp2f(-dl); l_reg*=f; if(hi==0)wsf[r32]=f; resc=true; } } \
    SBAR(); \
    GAPB2(o[0]=__builtin_amdgcn_mfma_f32_32x32x16_bf16(PAF(0),VFR(0),o[0],0,0,0), C0,0); \
    GAPB2(o[1]=__builtin_amdgcn_mfma_f32_32x32x16_bf16(PAF(0),VFR(4),o[1],0,0,0), C0,2); \
    GAPB2(o[0]=__builtin_amdgcn_mfma_f32_32x32x16_bf16(PAF(1),VFR(1),o[0],0,0,0), C0,4); \
    GAPB2(o[1]=__builtin_amdgcn_mfma_f32_32x32x16_bf16(PAF(1),VFR(5),o[1],0,0,0), C0,6); \
    GAPB2(o[0]=__builtin_amdgcn_mfma_f32_32x32x16_bf16(PAF(2),VFR(2),o[0],0,0,0), C0,8); \
    GAPB2(o[1]=__builtin_amdgcn_mfma_f32_32x32x16_bf16(PAF(2),VFR(6),o[1],0,0,0), C0,10); \
    if(GL){ fx=featr[64*((t)+1)]; SBAR(); } \
    GAPB2(o[0]=__builtin_amdgcn_mfma_f32_32x32x16_bf16(PAF(3),VFR(3),o[0],0,0,0), C0,12); \
    GAPB2(o[1]=__builtin_amdgcn_mfma_f32_32x32x16_bf16(PAF(3),VFR(7),o[1],0,0,0), C0,14); \
      \
    VRC(0); VRC(4); VRC(1); VRC(5); SBAR(); \
    VRC(2); VRC(6); GAPB2(o[2]=__builtin_amdgcn_mfma_f32_32x32x16_bf16(PAF(0),VFR(0),o[2],0,0,0), C1,0); \
    VRC(3); VRC(7); GAPB2(o[3]=__builtin_amdgcn_mfma_f32_32x32x16_bf16(PAF(0),VFR(4),o[3],0,0,0), C1,2); \
    GAPB2(o[2]=__builtin_amdgcn_mfma_f32_32x32x16_bf16(PAF(1),VFR(1),o[2],0,0,0), C1,4); \
    GAPB2(o[3]=__builtin_amdgcn_mfma_f32_32x32x16_bf16(PAF(1),VFR(5),o[3],0,0,0), C1,6); \
    GAPB2(o[2]=__builtin_amdgcn_mfma_f32_32x32x16_bf16(PAF(2),VFR(2),o[2],0,0,0), C1,8); \
    GAPB2(o[3]=__builtin_amdgcn_mfma_f32_32x32x16_bf16(PAF(2),VFR(6),o[3],0,0,0), C1,10); \
    GAPB2(o[2]=__builtin_amdgcn_mfma_f32_32x32x16_bf16(PAF(3),VFR(3),o[2],0,0,0), C1,12); \
    GAPB2(o[3]=__builtin_amdgcn_mfma_f32_32x32x16_bf16(PAF(3),VFR(7),o[3],0,0,0), C1,14); \
    }while(0)
  int t=1;
  #undef CMASK
  #define CMASK(P0,P1,t) do{}while(0)
  for(;t+5<NT;t+=2){
    STEP(pB0,pB1,pA0,pA1,t,true,true,true);     WAIT_BAR(3); RESC(); ROT();
    STEP(pA0,pA1,pB0,pB1,t+1,true,true,true);   WAIT_BAR(3); RESC(); ROT();
  }
  #undef CMASK
  #define CMASK(P0,P1,t) do{int jb_=(t)-(NT-4); if(jb_>=0){ if(MODE==0)cmask(P0,P1,jb_,qrel,hi); else dmask(P0,P1,jb_,wid,r32,hi,slope2);} }while(0)
  #define ENDW(tt) do{ if((tt)+3<NT){WAIT_BAR(3);} else if((tt)+2<NT){WAIT_BAR(2);} else {WAIT_BAR(0);} }while(0)
  for(;t+1<NT;t+=2){
    STEP(pB0,pB1,pA0,pA1,t,(t+3<NT),(t+1<NT),(t+1<NT));       ENDW(t);   RESC(); ROT();
    STEP(pA0,pA1,pB0,pB1,t+1,(t+4<NT),(t+2<NT),(t+2<NT));     ENDW(t+1); RESC(); ROT();
  }
  STEP(pB0,pB1,pA0,pA1,NT-1,false,false,false); RESC();
  { float sacc=pB0[0]+pB0[1]; _Pragma("unroll") for(int r=2;r<16;++r)sacc+=pB0[r]; _Pragma("unroll") for(int r=0;r<16;++r)sacc+=pB1[r]; l_reg+=sacc;
    pw0=(u32x4){PKW(pB0,0),PKW(pB0,2),PKW(pB0,4),PKW(pB0,6)};pw1=(u32x4){PKW(pB0,8),PKW(pB0,10),PKW(pB0,12),PKW(pB0,14)};pw2=(u32x4){PKW(pB1,0),PKW(pB1,2),PKW(pB1,4),PKW(pB1,6)};pw3=(u32x4){PKW(pB1,8),PKW(pB1,10),PKW(pB1,12),PKW(pB1,14)};
    SBAR(); pv(o,vb0+sl_cur,PAF(0),PAF(1),PAF(2),PAF(3)); pv(o+2,vb0+sl_cur+8192,PAF(0),PAF(1),PAF(2),PAF(3)); }
  #undef PKW
  #undef PAF
  #undef VFR
  #undef PIN
  #undef MX3
  #undef GAPA
  #undef GAPB
  #undef GAPB2
  #undef EX
  #undef VRD
  #undef KF
  #undef VRC
  #undef STEP
  #undef ENDW
  {auto rr=__builtin_amdgcn_permlane32_swap(__float_as_uint(l_reg),__float_as_uint(l_reg),false,false);l_reg=__uint_as_float(rr[0])+__uint_as_float(rr[1]);}
  if(hi==0)wsf[32+r32]=l_reg;asm volatile("s_waitcnt lgkmcnt(0)":::"memory");
  #pragma unroll
  for(int r=0;r<16;++r){const float rli=__builtin_amdgcn_rcpf(wsf[32+crow(r,hi)]); o[0][r]*=rli; o[1][r]*=rli; o[2][r]*=rli; o[3][r]*=rli;}
  asm volatile("s_waitcnt lgkmcnt(0)\n\ts_barrier":::"memory");
  #undef DMA_K
  #undef DMA_V
  #undef CMASK
  #undef RESC
  #undef ROT
  #undef KSL
  #undef AXF0
  #undef AXF1
}
__device__ __forceinline__ void store_tile_bf16_at(const f32x16*o,bf16*dst,int pitch,char*shm,int stage,int wid,int lane){
  const int r32=lane&31,hi=lane>>5;
  bf16*stg=(bf16*)(shm+stage)+wid*2048;
  #pragma unroll
  for(int r=0;r<16;++r){const int orow=crow(r,hi);
    #pragma unroll
    for(int d0=0;d0<2;++d0)stg[orow*64+d0*32+r32]=__float2bfloat16(o[d0][r]);}
  asm volatile("s_waitcnt lgkmcnt(0)":::"memory");
  #pragma unroll
  for(int i=0;i<4;++i){const int row=i*8+(lane>>3),ch=lane&7; const u32x4 v=*(const u32x4*)(stg+row*64+ch*8); *(u32x4*)(dst+(long)row*pitch+ch*8)=v;}
  asm volatile("s_waitcnt lgkmcnt(0)":::"memory");
}
__device__ __forceinline__ void store_tile_bf16(const f32x16(&o)[2],bf16*dst,int pitch,char*shm,int wid,int lane){
  const int r32=lane&31,hi=lane>>5;
  bf16*stg=(bf16*)(shm+LDS_OST)+wid*2048;
  #pragma unroll
  for(int r=0;r<16;++r){const int orow=crow(r,hi);
    #pragma unroll
    for(int d0=0;d0<2;++d0)stg[orow*64+d0*32+r32]=__float2bfloat16(o[d0][r]);}
  asm volatile("s_waitcnt lgkmcnt(0)":::"memory");
  #pragma unroll
  for(int i=0;i<4;++i){const int row=i*8+(lane>>3),ch=lane&7; const u32x4 v=*(const u32x4*)(stg+row*64+ch*8); *(u32x4*)(dst+(long)row*pitch+ch*8)=v;}
  asm volatile("s_waitcnt lgkmcnt(0)":::"memory");
}
constexpr int ATTN_LDS_BYTES=LDS_BYTES;
#undef SBAR
#undef WAIT_BAR
}

namespace cg = cooperative_groups;
constexpr int BATCH = 16, SEQ = 4096, D = 1024, NTOK = BATCH * SEQ;
constexpr int FH = 8, DH = 4, HD = 64;
constexpr int NPROJ = 3072, IN_COLS = 3080;
constexpr int PH = 8, NKEY = 128, TOPK = 16, PQ = 2048, NEXP = 16384;
constexpr float RMS_EPS = 1e-6f, LOG2E = 1.4426950408889634f, C2 = 0.125f * LOG2E;
constexpr float LAMBDA_INIT = 0.2f;
constexpr int COL_QA = 0, COL_KA = 512, COL_VA = 1024, COL_QB = 1536, COL_KB = 2048, COL_VB = 2560;
constexpr int NWAVES = 8, NTHR = 512;

typedef unsigned short bf16_t;
typedef float f32x4v __attribute__((ext_vector_type(4)));
#define LAS __attribute__((address_space(3)))

constexpr size_t MiB = 1u << 20;
constexpr size_t WS_CTL = 0;
constexpr size_t WS_WIN = 2 * MiB;
constexpr size_t WS_WOUT = 8 * MiB;
constexpr size_t WS_WQ = 10 * MiB;
constexpr size_t WS_LOGF = 16 * MiB;
constexpr size_t WS_CUM = 18 * MiB;
constexpr size_t WS_XN = 96 * MiB;
constexpr size_t WS_PROJ = 224 * MiB;
constexpr size_t WS_Y = 224 * MiB;
constexpr size_t WS_QP = 352 * MiB;
constexpr size_t WS_MIXED = 608 * MiB;
constexpr size_t WS_END = 736 * MiB;
constexpr int LDS_BYTES = 147456;

__device__ __forceinline__ unsigned f2bf(float f) { unsigned u = __builtin_bit_cast(unsigned, f); return (u + 0x7fffu + ((u >> 16) & 1u)) >> 16; }
__device__ __forceinline__ unsigned pk2(float lo, float hi) { return f2bf(lo) | (f2bf(hi) << 16); }
__device__ __forceinline__ float bflo(unsigned w) { return __builtin_bit_cast(float, w << 16); }
__device__ __forceinline__ float bfhi(unsigned w) { return __builtin_bit_cast(float, w & 0xffff0000u); }
__device__ __forceinline__ float wave_sum(float v) {
#pragma unroll
    for (int o = 1; o < 64; o <<= 1) v += __shfl_xor(v, o);
    return v;
}

struct Ctx { int tid, lane, wave, vcu, G, gw, NGW; LAS unsigned char* lds; unsigned char* lds_gen; };

__device__ __forceinline__ void p0_transpose_item(const float* W, int ldw, int K, int ncols, bf16_t* WT, int row_off, float scale, const float* ksc, LAS float* scr, int item, int lane) {
    const int nblk = ncols / 32, kb = item / nblk, nb = item % nblk, k0 = 64 * kb, n0 = 32 * nb;
#pragma unroll 8
    for (int i = 0; i < 32; ++i) { const int kk = 2 * i + (lane >> 5); scr[kk * 33 + (lane & 31)] = W[(size_t)(k0 + kk) * ldw + n0 + (lane & 31)] * (ksc ? scale * ksc[k0 + kk] : scale); }
    asm volatile("s_waitcnt lgkmcnt(0)" ::: "memory");
    const int c = lane & 7;
#pragma unroll
    for (int j = 0; j < 4; ++j) { const int n = (lane >> 3) + 8 * j; const LAS float* s = scr + (8 * c) * 33 + n;
        uint4 o; o.x = pk2(s[0 * 33], s[1 * 33]); o.y = pk2(s[2 * 33], s[3 * 33]); o.z = pk2(s[4 * 33], s[5 * 33]); o.w = pk2(s[6 * 33], s[7 * 33]);
        *(uint4*)(WT + (size_t)(row_off + n0 + n) * K + k0 + 8 * c) = o; }
    asm volatile("s_waitcnt lgkmcnt(0)" ::: "memory");
}
__device__ __forceinline__ void p0_weights(const Ctx& c, const float* w_in, const float* w_out, const float* w_q, const float* g2, bf16_t* WIN, bf16_t* WOUT, bf16_t* WQ) {
    LAS float* scr = (LAS float*)(c.lds + c.wave * 16384);
    constexpr int KB = D / 64;
    constexpr int I0 = KB * (512 / 32), I1 = KB * (1024 / 32), I2 = I0, I3 = I1, I4 = KB * (D / 32), I5 = KB * (PQ / 32);
    constexpr int NIT = I0 + I1 + I2 + I3 + I4 + I5;
    for (int it = c.gw; it < NIT; it += c.NGW) {
        int r = it;
        if (r < I0) { p0_transpose_item(w_in + 0, IN_COLS, D, 512, WIN, 0, C2, nullptr, scr, r, c.lane); continue; } r -= I0;
        if (r < I1) { p0_transpose_item(w_in + 512, IN_COLS, D, 1024, WIN, 512, 1.f, nullptr, scr, r, c.lane); continue; } r -= I1;
        if (r < I2) { p0_transpose_item(w_in + 1544, IN_COLS, D, 512, WIN, 1536, C2, nullptr, scr, r, c.lane); continue; } r -= I2;
        if (r < I3) { p0_transpose_item(w_in + 2056, IN_COLS, D, 1024, WIN, 2048, 1.f, nullptr, scr, r, c.lane); continue; } r -= I3;
        if (r < I4) { p0_transpose_item(w_out, D, D, D, WOUT, 0, 1.f, nullptr, scr, r, c.lane); continue; } r -= I4;
        p0_transpose_item(w_q, PQ, D, PQ, WQ, 0, 1.f, g2, scr, r, c.lane);
    }
}

__device__ __forceinline__ void rms1_gates_wave(int row0, int step, int lane, const float* __restrict__ x, const float* __restrict__ g1, const float* __restrict__ w_in, const float* __restrict__ b_f,
                                                bf16_t* __restrict__ XN, float* __restrict__ LOGF) {
    f32x4v wg[16][2], gn[4];
#pragma unroll
    for (int j = 0; j < 4; ++j) { gn[j] = ((const f32x4v*)g1)[lane + 64 * j];
#pragma unroll
        for (int e = 0; e < 4; ++e) { const f32x4v* wr = (const f32x4v*)(w_in + (size_t)(4 * lane + 256 * j + e) * IN_COLS + 1536); wg[4 * j + e][0] = wr[0]; wg[4 * j + e][1] = wr[1]; } }
    const float bfl = b_f[lane >> 3];
    f32x4v va[4], vb[4];
    { const f32x4v* xr = (const f32x4v*)(x + (size_t)row0 * D) + lane;
#pragma unroll
      for (int j = 0; j < 4; ++j) va[j] = xr[64 * j];
      const int r1 = (row0 + step < NTOK) ? row0 + step : row0; const f32x4v* xs = (const f32x4v*)(x + (size_t)r1 * D) + lane;
#pragma unroll
      for (int j = 0; j < 4; ++j) vb[j] = xs[64 * j]; }
    const bool b5 = (lane & 32) != 0, b4 = (lane & 16) != 0, b3 = (lane & 8) != 0;
#define RMS1_ROW(BUF, row_) do { const int rr = (row_); \
        f32x4v v[4]; float ss = 0.f; \
        _Pragma("unroll") for (int j = 0; j < 4; ++j) { v[j] = BUF[j]; ss += (v[j].x * v[j].x + v[j].y * v[j].y) + (v[j].z * v[j].z + v[j].w * v[j].w); } \
        { const int rn = (rr + 2 * step < NTOK) ? rr + 2 * step : rr; const f32x4v* xr = (const f32x4v*)(x + (size_t)rn * D) + lane; \
          _Pragma("unroll") for (int j = 0; j < 4; ++j) BUF[j] = xr[64 * j]; } \
        ss = wave_sum(ss); \
        const float rstd = rsqrtf(ss * (1.f / D) + RMS_EPS); \
        f32x4v ga = {0.f, 0.f, 0.f, 0.f}, gb = {0.f, 0.f, 0.f, 0.f}; \
        unsigned long long* o8 = (unsigned long long*)(XN + (size_t)rr * D) + lane; \
        _Pragma("unroll") for (int j = 0; j < 4; ++j) { \
            v[j] = v[j] * rstd * gn[j]; \
            o8[64 * j] = (unsigned long long)pk2(v[j].x, v[j].y) | ((unsigned long long)pk2(v[j].z, v[j].w) << 32); \
            _Pragma("unroll") for (int e = 0; e < 4; ++e) { ga += v[j][e] * wg[4 * j + e][0]; gb += v[j][e] * wg[4 * j + e][1]; } \
        } \
          \
        float h0, h1, h2, h3; \
        { const float s0 = b5 ? ga.x : gb.x, s1 = b5 ? ga.y : gb.y, s2 = b5 ? ga.z : gb.z, s3 = b5 ? ga.w : gb.w; \
          h0 = (b5 ? gb.x : ga.x) + __shfl_xor(s0, 32); h1 = (b5 ? gb.y : ga.y) + __shfl_xor(s1, 32); h2 = (b5 ? gb.z : ga.z) + __shfl_xor(s2, 32); h3 = (b5 ? gb.w : ga.w) + __shfl_xor(s3, 32); } \
        float k0, k1; \
        { const float s0 = b4 ? h0 : h2, s1 = b4 ? h1 : h3; k0 = (b4 ? h2 : h0) + __shfl_xor(s0, 16); k1 = (b4 ? h3 : h1) + __shfl_xor(s1, 16); } \
        float gv; { const float s0 = b3 ? k0 : k1; gv = (b3 ? k1 : k0) + __shfl_xor(s0, 8); } \
        gv += __shfl_xor(gv, 4); gv += __shfl_xor(gv, 2); gv += __shfl_xor(gv, 1); \
        if ((lane & 7) == 0) { \
            const float z = gv + bfl; \
            const float ls = fminf(z, 0.f) - log1pf(expf(-fabsf(z))); \
            const int b = rr / SEQ, t = rr % SEQ; \
            LOGF[((size_t)b * FH + (lane >> 3)) * SEQ + t] = ls; \
        } } while (0)
#pragma unroll 1
    for (int row = row0; row < NTOK; row += 2 * step) {
        RMS1_ROW(va, row);
        if (row + step < NTOK) RMS1_ROW(vb, row + step);
    }
#undef RMS1_ROW
}

__device__ __forceinline__ void cumsum_seq(int bh, int lane, const float* __restrict__ LOGF, float* __restrict__ CUM) {
    const float* src = LOGF + (size_t)bh * SEQ + lane * 64; float* dst = CUM + (size_t)bh * SEQ + lane * 64;
    float loc[64]; float run = 0.f;
#pragma unroll
    for (int i = 0; i < 64; ++i) { run += src[i]; loc[i] = run; }
    float incl = run;
#pragma unroll
    for (int o = 1; o < 64; o <<= 1) { const float t = __shfl_up(incl, o); if (lane >= o) incl += t; }
    const float excl = incl - run;
#pragma unroll
    for (int i = 0; i < 64; ++i) dst[i] = loc[i] + excl;
}

namespace pg8 {
struct EpiBf16RowScale {
    static constexpr bool PERM = true, AFTER_DRAIN = false;
    bf16_t* O; int ldc; const unsigned long long* ss; float inv_n, eps;
    __device__ __forceinline__ void operator()(const f32x4 (&acc)[2][2][4][2], const Unit& u, int wr, int wc, int fr, int fq) const {
        const int row0 = u.pm * BM + wr * 64 + fr, col0 = u.pn * BM + wc * 32 + 8 * fq;
#pragma unroll
        for (int ai = 0; ai < 2; ++ai)
#pragma unroll
            for (int m = 0; m < 4; ++m) { const int row = row0 + ai * HALF + m * 16; const float sc = rsqrtf((float)ss[row] * (inv_n * 5.9604644775390625e-8f) + eps); bf16_t* rowp = O + (size_t)row * ldc + col0;
#pragma unroll
                for (int bj = 0; bj < 2; ++bj) { const f32x4 v0 = acc[ai][bj][m][0] * sc, v1 = acc[ai][bj][m][1] * sc;
                    u32x4 w; w.x = cvt_pk_bf16(v0[0], v0[1]); w.y = cvt_pk_bf16(v0[2], v0[3]); w.z = cvt_pk_bf16(v1[0], v1[1]); w.w = cvt_pk_bf16(v1[2], v1[3]);
                    *(u32x4*)(rowp + bj * HALF) = w; } }
    }
};
struct EpiBf16Norm {
    static constexpr bool PERM = true, AFTER_DRAIN = false;
    bf16_t* O; int ldc; unsigned* NRM;
    __device__ __forceinline__ void operator()(const f32x4 (&acc)[2][2][4][2], const Unit& u, int wr, int wc, int fr, int fq) const {
        const int row0 = u.pm * BM + wr * 64 + fr, col0 = u.pn * BM + wc * 32 + 8 * fq;
        const int pn = u.pn; const bool isq = (pn < 2) || (pn == 6) || (pn == 7), isk = (pn == 2) || (pn == 3) || (pn == 8) || (pn == 9);
        float mx0 = 0.f, mx1 = 0.f;
#pragma unroll
        for (int ai = 0; ai < 2; ++ai)
#pragma unroll
            for (int m = 0; m < 4; ++m) { bf16_t* rowp = O + (size_t)(row0 + ai * HALF + m * 16) * ldc + col0;
#pragma unroll
                for (int bj = 0; bj < 2; ++bj) { const f32x4 v0 = acc[ai][bj][m][0], v1 = acc[ai][bj][m][1];
                    u32x4 w; w.x = cvt_pk_bf16(v0[0], v0[1]); w.y = cvt_pk_bf16(v0[2], v0[3]); w.z = cvt_pk_bf16(v1[0], v1[1]); w.w = cvt_pk_bf16(v1[2], v1[3]);
                    *(u32x4*)(rowp + bj * HALF) = w;
                    if (isq || isk) { float ss = ((v0[0] * v0[0] + v0[1] * v0[1]) + (v0[2] * v0[2] + v0[3] * v0[3])) + ((v1[0] * v1[0] + v1[1] * v1[1]) + (v1[2] * v1[2] + v1[3] * v1[3]));
                        ss += __shfl_xor(ss, 16); ss += __shfl_xor(ss, 32);
                        if (bj == 0) mx0 = fmaxf(mx0, ss); else mx1 = fmaxf(mx1, ss); } } }
        if (isq || isk) {
#pragma unroll
            for (int off = 1; off < 16; off <<= 1) { mx0 = fmaxf(mx0, __shfl_xor(mx0, off)); mx1 = fmaxf(mx1, __shfl_xor(mx1, off)); }
            if (fr == 0 && fq == 0) {
                const int b = u.pm >> 4, qb = u.pm & 15, half = wc & 1;
                const int base = isq ? (pn < 2 ? pn * 4 : 8 + (pn - 6) * 4) : (pn < 4 ? (pn - 2) * 4 : 8 + (pn - 8) * 4);
#pragma unroll
                for (int bj = 0; bj < 2; ++bj) { const int vq = base + 2 * bj + (wc >> 1); const float mv = (bj == 0 ? mx0 : mx1) * 1.02f;
                    const int idx = isq ? (512 + (((b * 16 + qb) * 16 + vq) << 1) + half) : ((((b * 16) + vq) << 1) + half);
                    atomicMax(NRM + idx, __float_as_uint(mv)); }
            }
        }
    }
};
struct EpiResidual {
    static constexpr bool PERM = false, AFTER_DRAIN = false;
    const float* __restrict__ X; bf16_t* __restrict__ HB; unsigned long long* __restrict__ SS; int ldc;
    __device__ __forceinline__ void operator()(const f32x4 (&acc)[2][2][4][2], const Unit& u, int wr, int wc, int fr, int fq) const {
        typedef unsigned u32x2e __attribute__((ext_vector_type(2)));
        const int col0 = u.pn * BM + wc * 32 + 4 * fq;
#pragma unroll
        for (int ai = 0; ai < 2; ++ai) {
            f32x4 pre[4][2][2];
#pragma unroll
            for (int m = 0; m < 4; ++m) { const size_t off = (size_t)(u.pm * BM + ai * HALF + wr * 64 + m * 16 + fr) * ldc + col0;
#pragma unroll
                for (int bj = 0; bj < 2; ++bj)
#pragma unroll
                    for (int n = 0; n < 2; ++n) pre[m][bj][n] = *(const f32x4*)(X + off + bj * HALF + n * 16); }
#pragma unroll
            for (int m = 0; m < 4; ++m) { const int row = u.pm * BM + ai * HALF + wr * 64 + m * 16 + fr; const size_t off = (size_t)row * ldc + col0; float part = 0.f;
#pragma unroll
                for (int bj = 0; bj < 2; ++bj)
#pragma unroll
                    for (int n = 0; n < 2; ++n) { const f32x4 v = acc[ai][bj][m][n] + pre[m][bj][n];
                        part += (v[0] * v[0] + v[1] * v[1]) + (v[2] * v[2] + v[3] * v[3]);
                        u32x2e w; w.x = cvt_pk_bf16(v[0], v[1]); w.y = cvt_pk_bf16(v[2], v[3]); *(u32x2e*)(HB + off + bj * HALF + n * 16) = w; }
                part += __shfl_xor(part, 16); part += __shfl_xor(part, 32);
                if (fq == 0) atomicAdd(SS + row, (unsigned long long)(part * 16777216.f)); }
        }
    }
};
}
constexpr size_t WS_SS = 20 * MiB + 65536;
constexpr size_t WS_PO = 224 * MiB;
constexpr int LDS_LAM = 131072;
constexpr size_t WS_NRM = 20 * MiB;
#define NRM_K(b, vq) (((b) * 16 + (vq)) * 2)
#define NRM_Q(b, qb, vq) (512 + (((b) * 16 + (qb)) * 16 + (vq)) * 2)
constexpr int NRM_WORDS = 512 + 8192;
__device__ __forceinline__ void norms_wave(int t0, int lane, const bf16_t* __restrict__ PROJ, float* __restrict__ NRM) {
    const int slot = lane >> 1, half = lane & 1, vq = slot & 15;
    const int col = (slot < 16 ? (vq < 8 ? COL_QA + vq * 64 : COL_QB + (vq - 8) * 64) : (vq < 8 ? COL_KA + vq * 64 : COL_KB + (vq - 8) * 64)) + half * 32;
    float mx = 0.f;
    for (int i = 0; i < 32; ++i) {
        const uint4* p = (const uint4*)(PROJ + (size_t)(t0 + i) * NPROJ + col); float ss = 0.f;
#pragma unroll
        for (int j = 0; j < 4; ++j) { const uint4 w = p[j]; const float a0 = bflo(w.x), a1 = bfhi(w.x), a2 = bflo(w.y), a3 = bfhi(w.y), a4 = bflo(w.z), a5 = bfhi(w.z), a6 = bflo(w.w), a7 = bfhi(w.w);
            ss += (a0 * a0 + a1 * a1) + (a2 * a2 + a3 * a3) + (a4 * a4 + a5 * a5) + (a6 * a6 + a7 * a7); }
        ss += __shfl_xor(ss, 1);
        mx = fmaxf(mx, ss);
    }
    if (half == 0) { const int b = t0 / SEQ, qb = (t0 % SEQ) / 256;
        atomicMax((unsigned*)NRM + (slot < 16 ? NRM_Q(b, qb, vq) : NRM_K(b, vq)), __float_as_uint(mx * 1.02f)); }
}
constexpr size_t WS_DSCR = 32 * MiB;
__device__ __forceinline__ void fox_unit(const Ctx& c, int b, int h, int qb, const bf16_t* PROJ, const float* CUM, const float* NRM, bf16_t* MIXED) {
    using attn_body::bf16; using attn_body::f32x16; using attn_body::attn_pass; using attn_body::store_tile_bf16;
    const bf16* P = (const bf16*)PROJ + (size_t)b * SEQ * NPROJ;
    f32x16 o[2];
    const float* cumf = CUM + ((size_t)b * FH + h) * SEQ;
    const float bound = sqrtf((NRM[NRM_Q(b, qb, h)] + NRM[NRM_Q(b, qb, h) + 1]) * (NRM[NRM_K(b, h)] + NRM[NRM_K(b, h) + 1]));
    const int jmin = attn_body::attn_jmin<0>(qb, bound, cumf, 0.f, threadIdx.x & 63);
    attn_pass<0, 8>(qb, jmin, P + COL_QA + h * 64, P + COL_KA + h * 64, P + COL_VA + h * 64, cumf, 0.f, (char*)c.lds_gen, o);
    int tid_l = threadIdx.x; asm volatile("" : "+v"(tid_l));
    const int lane = tid_l & 63, wave = __builtin_amdgcn_readfirstlane(tid_l >> 6);
    store_tile_bf16(o, (bf16*)MIXED + ((size_t)b * SEQ + qb * 256 + wave * 32) * D + h * 64, D, (char*)c.lds_gen, wave, lane);
}
__device__ __forceinline__ void diff_unit(const Ctx& c, int b, int h, int qb, const bf16_t* PROJ, const float* NRM, const float* subg, bf16_t* MIXED, unsigned char* ws) {
    using attn_body::bf16; using attn_body::f32x16; using attn_body::attn_pass_dv128; using attn_body::store_tile_bf16_at;
    f32x16 o[4];
#pragma unroll 1
    for (int m = 0; m < 2; ++m) {
        { const bf16* P = (const bf16*)PROJ + (size_t)b * SEQ * NPROJ; const float slope2 = exp2f(-2.f * (float)(h + 1)) * LOG2E;
          const float bound = sqrtf((NRM[NRM_Q(b, qb, 8 + 2 * h + m)] + NRM[NRM_Q(b, qb, 8 + 2 * h + m) + 1]) * (NRM[NRM_K(b, 8 + 2 * h + m)] + NRM[NRM_K(b, 8 + 2 * h + m) + 1]));
          const int jmin = attn_body::attn_jmin<1>(qb, bound, nullptr, slope2, threadIdx.x & 63);
          attn_pass_dv128<8>(qb, jmin, P + COL_QB + h * 128 + m * 64, P + COL_KB + h * 128 + m * 64, P + COL_VB + h * 128, slope2, (char*)c.lds_gen, o); }
        int tid_l = threadIdx.x; asm volatile("" : "+v"(tid_l));
        const int lane = tid_l & 63, wave = __builtin_amdgcn_readfirstlane(tid_l >> 6);
        f32x4v* stash = (f32x4v*)(ws + WS_DSCR + ((size_t)blockIdx.x * NWAVES + wave) * 16384) + lane;
        if (m == 0) {
#pragma unroll
            for (int i = 0; i < 16; ++i) { const int d0 = i >> 2, r = (i & 3) * 4; stash[i * 64] = (f32x4v){o[d0][r], o[d0][r + 1], o[d0][r + 2], o[d0][r + 3]}; }
        } else {
            const float lam = ((const LAS float*)(c.lds + LDS_LAM))[0];
            asm volatile("s_waitcnt vmcnt(0)" ::: "memory");
#pragma unroll
            for (int i = 0; i < 16; ++i) { const int d0 = i >> 2, r = (i & 3) * 4; const f32x4v a = stash[i * 64];
                o[d0][r] = a.x - lam * o[d0][r]; o[d0][r + 1] = a.y - lam * o[d0][r + 1]; o[d0][r + 2] = a.z - lam * o[d0][r + 2]; o[d0][r + 3] = a.w - lam * o[d0][r + 3]; }
            const int r32 = lane & 31;
            const float g0 = subg[r32], g1 = subg[32 + r32], g2 = subg[64 + r32], g3 = subg[96 + r32];
#pragma unroll
            for (int r = 0; r < 16; ++r) {
                float ss = (o[0][r] * o[0][r] + o[1][r] * o[1][r]) + (o[2][r] * o[2][r] + o[3][r] * o[3][r]);
#pragma unroll
                for (int off = 1; off < 32; off <<= 1) ss += __shfl_xor(ss, off);
                const float rn = rsqrtf(ss * (1.f / 128.f) + RMS_EPS) * (1.f - LAMBDA_INIT);
                o[0][r] *= rn * g0; o[1][r] *= rn * g1; o[2][r] *= rn * g2; o[3][r] *= rn * g3;
            }
            bf16* dst = (bf16*)MIXED + ((size_t)b * SEQ + qb * 256 + wave * 32) * D + 512 + h * 128;
            store_tile_bf16_at(o, dst, D, (char*)c.lds_gen, attn_body::D2_K, wave, lane);
            store_tile_bf16_at(o + 2, dst + 64, D, (char*)c.lds_gen, attn_body::D2_K, wave, lane);
        }
    }
}

__device__ __forceinline__ void resid_rms2_row(int row, int lane, const float* __restrict__ x, const bf16_t* __restrict__ Y, const float* __restrict__ g2, bf16_t* __restrict__ HN) {
    const f32x4v* xr = (const f32x4v*)(x + (size_t)row * D) + lane;
    const uint2* yr = (const uint2*)(Y + (size_t)row * D) + lane;
    f32x4v v[4]; float ss = 0.f;
#pragma unroll
    for (int j = 0; j < 4; ++j) { const uint2 y = yr[64 * j]; v[j] = xr[64 * j]; v[j].x += bflo(y.x); v[j].y += bfhi(y.x); v[j].z += bflo(y.y); v[j].w += bfhi(y.y);
        ss += (v[j].x * v[j].x + v[j].y * v[j].y) + (v[j].z * v[j].z + v[j].w * v[j].w); }
    ss = wave_sum(ss);
    const float rstd = rsqrtf(ss * (1.f / D) + RMS_EPS);
    unsigned long long* o8 = (unsigned long long*)(HN + (size_t)row * D) + lane;
#pragma unroll
    for (int j = 0; j < 4; ++j) { const f32x4v g = ((const f32x4v*)g2)[lane + 64 * j]; const f32x4v w = v[j] * rstd * g;
        o8[64 * j] = (unsigned long long)pk2(w.x, w.y) | ((unsigned long long)pk2(w.z, w.w) << 32); }
}


constexpr size_t WS_UF8 = 736 * MiB;
constexpr size_t WS_VF8 = 752 * MiB;
constexpr size_t WS_SCU = 768 * MiB;
constexpr size_t WS_SCV = 768 * MiB + 65536;
constexpr size_t WS_SUA = 672 * MiB;
constexpr size_t WS_EIDX = 608 * MiB;
constexpr size_t WS_GATE = 640 * MiB;
constexpr size_t WS_END2 = 800 * MiB;
typedef __bf16 bf16x2v __attribute__((ext_vector_type(2)));
typedef unsigned rt_u32x4 __attribute__((ext_vector_type(4)));
typedef short rt_bf16x8 __attribute__((ext_vector_type(8)));
typedef float rt_f32x16 __attribute__((ext_vector_type(16)));

typedef float rt_f32x2 __attribute__((ext_vector_type(2)));
__device__ __forceinline__ void p0_table_row(int lane, const float* __restrict__ src, const float* __restrict__ colgain, unsigned char* __restrict__ dst_base, int row, float* __restrict__ sc) {
    const f32x4v* sr = (const f32x4v*)src + 4 * lane; f32x4v v[4]; float am = 0.f;
#pragma unroll
    for (int j = 0; j < 4; ++j) { v[j] = sr[j]; if (colgain) v[j] = v[j] * ((const f32x4v*)colgain)[4 * lane + j]; am = fmaxf(am, fmaxf(fmaxf(fabsf(v[j].x), fabsf(v[j].y)), fmaxf(fabsf(v[j].z), fabsf(v[j].w)))); }
#pragma unroll
    for (int o = 1; o < 64; o <<= 1) am = fmaxf(am, __shfl_xor(am, o));
    const float q = am > 0.f ? 448.f / am : 1.f;
    unsigned w[4];
#pragma unroll
    for (int j = 0; j < 4; ++j) { int p = __builtin_amdgcn_cvt_pk_fp8_f32(v[j].x * q, v[j].y * q, 0, false); p = __builtin_amdgcn_cvt_pk_fp8_f32(v[j].z * q, v[j].w * q, p, true); w[j] = (unsigned)p; }
    *(uint4*)(dst_base + (size_t)(lane >> 3) * ((size_t)NEXP * 128) + (size_t)row * 128 + (lane & 7) * 16) = (uint4){w[0], w[1], w[2], w[3]};
    if (lane == 0) *sc = am > 0.f ? am * (1.f / 448.f) : 1.f;
}
__device__ __forceinline__ void p0_tables(const Ctx& c, const float* __restrict__ U, const float* __restrict__ V, const float* __restrict__ g2, unsigned char* __restrict__ UF, unsigned char* __restrict__ VF, float* __restrict__ SCU, float* __restrict__ SCV) {
    for (int r = c.gw; r < 2 * NEXP; r += c.NGW) {
        if (r < NEXP) p0_table_row(c.lane, U + (size_t)r * D, g2, UF, r, SCU + r);
        else p0_table_row(c.lane, V + (size_t)(r - NEXP) * D, nullptr, VF, r - NEXP, SCV + (r - NEXP));
    }
}

__device__ __forceinline__ void ce_desc(unsigned& a, unsigned& b) { const unsigned mx = a > b ? a : b, mn = a > b ? b : a; a = mx; b = mn; }
template <int N> __device__ __forceinline__ void bitonic_sort_desc(unsigned (&v)[N]) {
#pragma unroll
    for (int k = 2; k <= N; k <<= 1) {
#pragma unroll
        for (int j = k >> 1; j > 0; j >>= 1) {
#pragma unroll
            for (int i = 0; i < N; ++i) { const int l = i ^ j; if (l > i) { if ((i & k) == 0) ce_desc(v[i], v[l]); else ce_desc(v[l], v[i]); } }
        }
    }
}
__device__ __forceinline__ void sort16_desc(unsigned (&v)[16]) { ce_desc(v[0], v[1]); ce_desc(v[2], v[3]); ce_desc(v[0], v[2]); ce_desc(v[1], v[3]); ce_desc(v[1], v[2]); ce_desc(v[4], v[5]); ce_desc(v[6], v[7]); ce_desc(v[4], v[6]); ce_desc(v[5], v[7]); ce_desc(v[5], v[6]); ce_desc(v[0], v[4]); ce_desc(v[2], v[6]); ce_desc(v[2], v[4]); ce_desc(v[1], v[5]); ce_desc(v[3], v[7]); ce_desc(v[3], v[5]); ce_desc(v[1], v[2]); ce_desc(v[3], v[4]); ce_desc(v[5], v[6]); ce_desc(v[8], v[9]); ce_desc(v[10], v[11]); ce_desc(v[8], v[10]); ce_desc(v[9], v[11]); ce_desc(v[9], v[10]); ce_desc(v[12], v[13]); ce_desc(v[14], v[15]); ce_desc(v[12], v[14]); ce_desc(v[13], v[15]); ce_desc(v[13], v[14]); ce_desc(v[8], v[12]); ce_desc(v[10], v[14]); ce_desc(v[10], v[12]); ce_desc(v[9], v[13]); ce_desc(v[11], v[15]); ce_desc(v[11], v[13]); ce_desc(v[9], v[10]); ce_desc(v[11], v[12]); ce_desc(v[13], v[14]); ce_desc(v[0], v[8]); ce_desc(v[4], v[12]); ce_desc(v[4], v[8]); ce_desc(v[2], v[10]); ce_desc(v[6], v[14]); ce_desc(v[6], v[10]); ce_desc(v[2], v[4]); ce_desc(v[6], v[8]); ce_desc(v[10], v[12]); ce_desc(v[1], v[9]); ce_desc(v[5], v[13]); ce_desc(v[5], v[9]); ce_desc(v[3], v[11]); ce_desc(v[7], v[15]); ce_desc(v[7], v[11]); ce_desc(v[3], v[5]); ce_desc(v[7], v[9]); ce_desc(v[11], v[13]); ce_desc(v[1], v[2]); ce_desc(v[3], v[4]); ce_desc(v[5], v[6]); ce_desc(v[7], v[8]); ce_desc(v[9], v[10]); ce_desc(v[11], v[12]); ce_desc(v[13], v[14]); }
__device__ __forceinline__ void merge_top16(unsigned (&a)[16], const unsigned (&b)[16]) {
#pragma unroll
    for (int i = 0; i < 16; ++i) a[i] = a[i] > b[15 - i] ? a[i] : b[15 - i];
#pragma unroll
    for (int j = 8; j > 0; j >>= 1) {
#pragma unroll
        for (int i = 0; i < 16; ++i) { const int l = i ^ j; if (l > i) ce_desc(a[i], a[l]); }
    }
}
__device__ __forceinline__ unsigned f2key(float f) { const unsigned b = __float_as_uint(f); return b ^ (((int)b >> 31) | 0x80000000u); }
__device__ __forceinline__ float key2f(unsigned k) { return __uint_as_float((k & 0x80000000u) ? (k ^ 0x80000000u) : ~k); }

__device__ __forceinline__ void top16_of_scores(const rt_f32x16 (&acc)[4], int hi, unsigned (&t)[16]) {
    unsigned g[16];
#pragma unroll
    for (int kb = 0; kb < 4; ++kb) {
        unsigned hi4 = (unsigned)(4 * hi); asm volatile("" : "+v"(hi4));
#pragma unroll
        for (int r = 0; r < 16; ++r) g[r] = ((f2key(acc[kb][r]) & ~127u) | hi4) | (unsigned)(32 * kb + (r & 3) + 8 * (r >> 2));
        sort16_desc(g);
        if (kb == 0) {
#pragma unroll
            for (int i = 0; i < 16; ++i) t[i] = g[i];
        } else merge_top16(t, g);
    }
    unsigned lo[16], up[16];
#pragma unroll
    for (int i = 0; i < 16; ++i) { auto rr = __builtin_amdgcn_permlane32_swap(t[i], t[i], false, false); lo[i] = rr[0]; up[i] = rr[1]; }
    merge_top16(lo, up);
#pragma unroll
    for (int i = 0; i < 16; ++i) t[i] = lo[i];
}

__host__ __device__ constexpr int cand_slot(int a, int b) { int n = 0; for (int i = 0; i < 16; ++i) for (int j = 0; j < 16; ++j) { if (i == a && j == b) return n; if ((i + 1) * (j + 1) <= 16) ++n; } return n; }
static_assert(cand_slot(15, 0) == 49, "50 candidates");
__host__ __device__ constexpr int cand_a(int slot) { int n = 0; for (int i = 0; i < 16; ++i) for (int j = 0; j < 16; ++j) if ((i + 1) * (j + 1) <= 16) { if (n == slot) return i; ++n; } return 0; }
__host__ __device__ constexpr int cand_b(int slot) { int n = 0; for (int i = 0; i < 16; ++i) for (int j = 0; j < 16; ++j) if ((i + 1) * (j + 1) <= 16) { if (n == slot) return j; ++n; } return 0; }
static_assert(cand_a(49) == 15 && cand_b(49) == 0 && cand_a(0) == 0 && cand_b(1) == 1, "candidate slot inverse");
constexpr int RT_SK_BYTES = 65536, RT_LUT_OFF = 65536;
__device__ __forceinline__ void route_stage_subkeys(const Ctx& c, const float* __restrict__ subk, int h) {
    f32x4v a[8], b[8];
#pragma unroll
    for (int i = 0; i < 8; ++i) { const int q = c.tid + i * NTHR; const int p = q >> 11, key = (q >> 4) & 127, ch = q & 15;
        const float* src = subk + (((size_t)h * 2 + p) * NKEY + key) * 128 + ch * 8; a[i] = ((const f32x4v*)src)[0]; b[i] = ((const f32x4v*)src)[1]; }
#pragma unroll
    for (int i = 0; i < 8; ++i) { const int q = c.tid + i * NTHR; const int p = q >> 11, key = (q >> 4) & 127, ch = q & 15;
        rt_u32x4 o; o.x = pk2(a[i].x, a[i].y); o.y = pk2(a[i].z, a[i].w); o.z = pk2(b[i].x, b[i].y); o.w = pk2(b[i].z, b[i].w);
        *(LAS rt_u32x4*)(c.lds + p * 32768 + key * 256 + ((ch ^ (key & 15)) << 4)) = o; }
}
__device__ __forceinline__ void route_tile(const Ctx& c, int tile, int h, const bf16_t* __restrict__ QP, const float* __restrict__ SCU, const float* __restrict__ SCV, int* __restrict__ EIDX, float* __restrict__ GATE, float* __restrict__ SUA) {
    int lane = c.lane; asm volatile("" : "+v"(lane));
    const int r32 = lane & 31, hi = lane >> 5;
    const int tok = tile * 32 + r32;
    unsigned s1[16], s2[16];
#pragma unroll
    for (int p = 0; p < 2; ++p) {
        rt_bf16x8 qf[8];
        { const uint4* qp = (const uint4*)(QP + (size_t)tok * PQ + h * 256 + p * 128) + hi;
#pragma unroll
          for (int kc = 0; kc < 8; ++kc) qf[kc] = __builtin_bit_cast(rt_bf16x8, qp[2 * kc]); }
        rt_f32x16 acc[4];
#pragma unroll
        for (int kb = 0; kb < 4; ++kb) {
            const int key = 32 * kb + r32;
            const LAS unsigned char* rowp = c.lds + p * 32768 + key * 256;
            acc[kb] = rt_f32x16{};
#pragma unroll
            for (int kc = 0; kc < 8; ++kc) {
                const rt_bf16x8 af = *(const LAS rt_bf16x8*)(rowp + (((2 * kc + hi) ^ (key & 15)) << 4));
                acc[kb] = __builtin_amdgcn_mfma_f32_32x32x16_bf16(af, qf[kc], acc[kb], 0, 0, 0);
            }
        }
        if (p == 0) top16_of_scores(acc, hi, s1); else top16_of_scores(acc, hi, s2);
    }
    unsigned top[16];
    {
        float f1[16], f2[16];
#pragma unroll
        for (int i = 0; i < 16; ++i) { f1[i] = key2f(s1[i]); f2[i] = key2f(s2[i]); }
        unsigned ga[16], gb[16];
#pragma unroll
        for (int j = 0; j < 32; ++j) {
            unsigned key = 0u;
            if (j < 25) { constexpr int dummy = 0; (void)dummy;
                const int a0 = cand_a(2 * j), b0 = cand_b(2 * j), a1 = cand_a(2 * j + 1), b1 = cand_b(2 * j + 1);
                const float fa = hi ? f1[a1] : f1[a0], fb = hi ? f2[b1] : f2[b0];
                const unsigned pos = hi ? (unsigned)(255 - (a1 * 16 + b1)) : (unsigned)(255 - (a0 * 16 + b0));
                key = (f2key(fa + fb) & ~255u) | pos; }
            if (j < 16) ga[j] = key; else gb[j - 16] = key;
        }
        sort16_desc(ga); sort16_desc(gb); merge_top16(ga, gb);
        unsigned lo[16], up[16];
#pragma unroll
        for (int i = 0; i < 16; ++i) { auto rr = __builtin_amdgcn_permlane32_swap(ga[i], ga[i], false, false); lo[i] = rr[0]; up[i] = rr[1]; }
        merge_top16(lo, up);
#pragma unroll
        for (int i = 0; i < 16; ++i) top[i] = lo[i];
    }
    LAS unsigned char* lut = c.lds + RT_LUT_OFF + c.wave * 2048 + lane * 32;
    { unsigned w[8];
#pragma unroll
      for (int i = 0; i < 4; ++i) { w[i] = (s1[4 * i] & 127u) | ((s1[4 * i + 1] & 127u) << 8) | ((s1[4 * i + 2] & 127u) << 16) | ((s1[4 * i + 3] & 127u) << 24);
                                    w[4 + i] = (s2[4 * i] & 127u) | ((s2[4 * i + 1] & 127u) << 8) | ((s2[4 * i + 2] & 127u) << 16) | ((s2[4 * i + 3] & 127u) << 24); }
      *(LAS rt_u32x4*)(lut) = (rt_u32x4){w[0], w[1], w[2], w[3]}; *(LAS rt_u32x4*)(lut + 16) = (rt_u32x4){w[4], w[5], w[6], w[7]}; }
    asm volatile("s_waitcnt lgkmcnt(0)" ::: "memory");
    float sc[16], sum = 0.f; const float mx = key2f(top[0] & ~255u);
#pragma unroll
    for (int i = 0; i < 16; ++i) { sc[i] = __expf(key2f(top[i] & ~255u) - mx); sum += sc[i]; }
    const float rs = 1.f / sum;
    int eo[8]; float go[8], so[8];
#pragma unroll
    for (int i = 0; i < 8; ++i) {
        const unsigned k = hi ? top[8 + i] : top[i]; const unsigned pos = 255u - (k & 255u);
        const unsigned ia = lut[pos >> 4], ib = lut[16 + (pos & 15u)];
        eo[i] = (int)(ia * NKEY + ib); go[i] = (hi ? sc[8 + i] : sc[i]) * rs;
    }
#pragma unroll
    for (int i = 0; i < 8; ++i) { so[i] = SCU[eo[i]]; go[i] *= SCV[eo[i]]; }
    asm volatile("s_waitcnt lgkmcnt(0)" ::: "memory");
    int* ep = EIDX + (size_t)tok * 128 + h * 16 + hi * 8; float* gp = GATE + (size_t)tok * 128 + h * 16 + hi * 8;
    *(int4*)ep = (int4){eo[0], eo[1], eo[2], eo[3]}; *(int4*)(ep + 4) = (int4){eo[4], eo[5], eo[6], eo[7]};
    *(f32x4v*)gp = (f32x4v){go[0], go[1], go[2], go[3]}; *(f32x4v*)(gp + 4) = (f32x4v){go[4], go[5], go[6], go[7]};
    float* sp = SUA + (size_t)tok * 128 + h * 16 + hi * 8;
    *(f32x4v*)sp = (f32x4v){so[0], so[1], so[2], so[3]}; *(f32x4v*)(sp + 4) = (f32x4v){so[4], so[5], so[6], so[7]};
}

constexpr size_t WS_PART = 352 * MiB;
__device__ __forceinline__ float dpp_f(float v, const int ctrl_sel) {
    const int x = __builtin_bit_cast(int, v);
    const int r = ctrl_sel == 0 ? __builtin_amdgcn_update_dpp(x, x, 0xB1, 0xf, 0xf, false) : ctrl_sel == 1 ? __builtin_amdgcn_update_dpp(x, x, 0x4E, 0xf, 0xf, false) : __builtin_amdgcn_update_dpp(x, x, 0x141, 0xf, 0xf, false);
    return __builtin_bit_cast(float, r);
}
#define FP8X16(W_, F_) do { const uint4 q_ = (W_); const rt_f32x2 t0_ = __builtin_amdgcn_cvt_pk_f32_fp8((int)q_.x, false), t1_ = __builtin_amdgcn_cvt_pk_f32_fp8((int)q_.x, true), t2_ = __builtin_amdgcn_cvt_pk_f32_fp8((int)q_.y, false), t3_ = __builtin_amdgcn_cvt_pk_f32_fp8((int)q_.y, true); \
    const rt_f32x2 t4_ = __builtin_amdgcn_cvt_pk_f32_fp8((int)q_.z, false), t5_ = __builtin_amdgcn_cvt_pk_f32_fp8((int)q_.z, true), t6_ = __builtin_amdgcn_cvt_pk_f32_fp8((int)q_.w, false), t7_ = __builtin_amdgcn_cvt_pk_f32_fp8((int)q_.w, true); \
    F_[0] = t0_.x; F_[1] = t0_.y; F_[2] = t1_.x; F_[3] = t1_.y; F_[4] = t2_.x; F_[5] = t2_.y; F_[6] = t3_.x; F_[7] = t3_.y; F_[8] = t4_.x; F_[9] = t4_.y; F_[10] = t5_.x; F_[11] = t5_.y; F_[12] = t6_.x; F_[13] = t6_.y; F_[14] = t7_.x; F_[15] = t7_.y; } while (0)
typedef int rt_i32x4 __attribute__((ext_vector_type(4)));
#define U_DOT(Wq, XW, D_) do { const uint4 q_ = (Wq); float d_ = 0.f; \
    d_ = __builtin_amdgcn_fdot2_f32_bf16(__builtin_amdgcn_cvt_scalef32_pk_bf16_fp8(q_.x, 1.0f, false), __builtin_bit_cast(bf16x2v, XW[0]), d_, false); \
    d_ = __builtin_amdgcn_fdot2_f32_bf16(__builtin_amdgcn_cvt_scalef32_pk_bf16_fp8(q_.x, 1.0f, true),  __builtin_bit_cast(bf16x2v, XW[1]), d_, false); \
    d_ = __builtin_amdgcn_fdot2_f32_bf16(__builtin_amdgcn_cvt_scalef32_pk_bf16_fp8(q_.y, 1.0f, false), __builtin_bit_cast(bf16x2v, XW[2]), d_, false); \
    d_ = __builtin_amdgcn_fdot2_f32_bf16(__builtin_amdgcn_cvt_scalef32_pk_bf16_fp8(q_.y, 1.0f, true),  __builtin_bit_cast(bf16x2v, XW[3]), d_, false); \
    d_ = __builtin_amdgcn_fdot2_f32_bf16(__builtin_amdgcn_cvt_scalef32_pk_bf16_fp8(q_.z, 1.0f, false), __builtin_bit_cast(bf16x2v, XW[4]), d_, false); \
    d_ = __builtin_amdgcn_fdot2_f32_bf16(__builtin_amdgcn_cvt_scalef32_pk_bf16_fp8(q_.z, 1.0f, true),  __builtin_bit_cast(bf16x2v, XW[5]), d_, false); \
    d_ = __builtin_amdgcn_fdot2_f32_bf16(__builtin_amdgcn_cvt_scalef32_pk_bf16_fp8(q_.w, 1.0f, false), __builtin_bit_cast(bf16x2v, XW[6]), d_, false); \
    d_ = __builtin_amdgcn_fdot2_f32_bf16(__builtin_amdgcn_cvt_scalef32_pk_bf16_fp8(q_.w, 1.0f, true),  __builtin_bit_cast(bf16x2v, XW[7]), d_, false); \
    D_ = d_; } while (0)
__device__ __forceinline__ void peer_u_wave(int tok0, int step, int k, int lane, const bf16_t* __restrict__ HN, const int* __restrict__ EIDX, const unsigned char* __restrict__ UF, unsigned* __restrict__ PARTB) {
    asm volatile("" : "+v"(lane));
    const int g = lane >> 3, c = lane & 7;
    const unsigned uoff = (unsigned)(k * (NEXP * 128) + 16 * c);
    const int last = tok0 + ((NTOK - 1 - tok0) / step) * step;
#define U_IDS(DST, tok_, half_) do { const int tt_ = (tok_) <= last ? (tok_) : last; const rt_i32x4* e_ = (const rt_i32x4*)(EIDX + (size_t)tt_ * 128 + 16 * g + 8 * (half_)); const rt_i32x4 a_ = e_[0], b_ = e_[1]; \
        DST[0] = a_.x; DST[1] = a_.y; DST[2] = a_.z; DST[3] = a_.w; DST[4] = b_.x; DST[5] = b_.y; DST[6] = b_.z; DST[7] = b_.w; } while (0)
#define U_GATHER(W, IDS) do { _Pragma("unroll") for (int i_ = 0; i_ < 8; ++i_) W[i_] = *(const uint4*)(UF + ((unsigned)IDS[i_] * 128u + uoff)); } while (0)
#define U_X(XW, tok_) do { const int tt_ = (tok_) <= last ? (tok_) : last; const uint4* h_ = (const uint4*)(HN + (size_t)tt_ * D + 128 * k + 16 * c); const uint4 a_ = h_[0], b_ = h_[1]; \
        XW[0] = a_.x; XW[1] = a_.y; XW[2] = a_.z; XW[3] = a_.w; XW[4] = b_.x; XW[5] = b_.y; XW[6] = b_.z; XW[7] = b_.w; } while (0)
#define U_COMPUTE(W, XW, R_) do { float d8_[8]; _Pragma("unroll") for (int i_ = 0; i_ < 8; ++i_) U_DOT(W[i_], XW, d8_[i_]); \
        float d4_[4], d2_[2]; \
        _Pragma("unroll") for (int j_ = 0; j_ < 4; ++j_) { const float keep_ = b2_ ? d8_[j_ + 4] : d8_[j_], send_ = b2_ ? d8_[j_] : d8_[j_ + 4]; d4_[j_] = keep_ + dpp_f(send_, 2); } \
        _Pragma("unroll") for (int j_ = 0; j_ < 2; ++j_) { const float keep_ = b0_ ? d4_[j_ + 2] : d4_[j_], send_ = b0_ ? d4_[j_] : d4_[j_ + 2]; d2_[j_] = keep_ + dpp_f(send_, 0); } \
        const float keep_ = b1_ ? d2_[1] : d2_[0], send_ = b1_ ? d2_[0] : d2_[1]; \
        R_ = keep_ + dpp_f(send_, 1); } while (0)
    const bool b0_ = (lane & 1) != 0, b1_ = (lane & 2) != 0, b2_ = (lane & 4) != 0; const int isel = 4 * (int)b2_ + 2 * (int)b0_ + (int)b1_;
    int idsA[8], idsB[8]; uint4 WA[8], WB[8]; unsigned xc[8], xn[8];
    U_IDS(idsA, tok0, 0); U_IDS(idsB, tok0, 1);
    U_GATHER(WA, idsA); U_X(xc, tok0); U_IDS(idsA, tok0 + step, 0);
#pragma unroll 1
    for (int tok = tok0; tok < NTOK; tok += step) {
        U_GATHER(WB, idsB); U_IDS(idsB, tok + step, 1);
        float r0_, r1_;
        U_COMPUTE(WA, xc, r0_);
        U_GATHER(WA, idsA); U_X(xn, tok + step); U_IDS(idsA, tok + 2 * step, 0);
        U_COMPUTE(WB, xc, r1_);
        PARTB[(size_t)tok * 512 + k * 64 + lane] = pk2(r0_, r1_);
#pragma unroll
        for (int j = 0; j < 8; ++j) xc[j] = xn[j];
    }
#undef U_IDS
#undef U_GATHER
#undef U_X
#undef U_COMPUTE
}
__device__ __forceinline__ void peer_hid_token(int tok, int lane, const float* __restrict__ PART, const float* __restrict__ SUA, const unsigned long long* __restrict__ SS, float* __restrict__ GATE_HID) {
    const float* pp = PART + (size_t)tok * 1024 + lane; float a = 0.f, b = 0.f;
#pragma unroll
    for (int k = 0; k < 8; ++k) { a += pp[128 * k]; b += pp[128 * k + 64]; }
    const float rstd = rsqrtf((float)SS[tok] * (5.9604644775390625e-8f / D) + RMS_EPS);
    a *= SUA[(size_t)tok * 128 + lane] * rstd; b *= SUA[(size_t)tok * 128 + 64 + lane] * rstd;
    float* gp = GATE_HID + (size_t)tok * 128 + lane;
    gp[0] = 0.5f * a * (1.f + erff(a * 0.70710678118654752f)) * gp[0];
    gp[64] = 0.5f * b * (1.f + erff(b * 0.70710678118654752f)) * gp[64];
}
__device__ __forceinline__ void peer_hid_token2(int t0, int t1, int lane, const unsigned* __restrict__ PARTB, const float* __restrict__ SUA, const unsigned long long* __restrict__ SS, float* __restrict__ GATE_HID) {
    const unsigned* p0 = PARTB + (size_t)t0 * 512 + lane; const unsigned* p1 = PARTB + (size_t)t1 * 512 + lane;
    unsigned w0[8], w1[8];
#pragma unroll
    for (int k = 0; k < 8; ++k) { w0[k] = p0[64 * k]; w1[k] = p1[64 * k]; }
    const int s0 = 16 * (lane >> 3) + 4 * ((lane >> 2) & 1) + 2 * (lane & 1) + ((lane >> 1) & 1);
    float* g0 = GATE_HID + (size_t)t0 * 128 + s0; float* g1 = GATE_HID + (size_t)t1 * 128 + s0;
    const float ga0 = g0[0], gb0 = g0[8], ga1 = g1[0], gb1 = g1[8];
    const float sa0 = SUA[(size_t)t0 * 128 + s0], sb0 = SUA[(size_t)t0 * 128 + s0 + 8], sa1 = SUA[(size_t)t1 * 128 + s0], sb1 = SUA[(size_t)t1 * 128 + s0 + 8];
    const float r0 = rsqrtf((float)SS[t0] * (5.9604644775390625e-8f / D) + RMS_EPS), r1 = rsqrtf((float)SS[t1] * (5.9604644775390625e-8f / D) + RMS_EPS);
    float a0 = 0.f, b0 = 0.f, a1 = 0.f, b1 = 0.f;
#pragma unroll
    for (int k = 0; k < 8; ++k) { a0 += bflo(w0[k]); b0 += bfhi(w0[k]); a1 += bflo(w1[k]); b1 += bfhi(w1[k]); }
    a0 *= sa0 * r0; b0 *= sb0 * r0; a1 *= sa1 * r1; b1 *= sb1 * r1;
    const float h00 = 0.5f * a0 * (1.f + erff(a0 * 0.70710678118654752f)) * ga0, h01 = 0.5f * b0 * (1.f + erff(b0 * 0.70710678118654752f)) * gb0;
    const float h10 = 0.5f * a1 * (1.f + erff(a1 * 0.70710678118654752f)) * ga1, h11 = 0.5f * b1 * (1.f + erff(b1 * 0.70710678118654752f)) * gb1;
    g0[0] = h00; g0[8] = h01; g1[0] = h10; g1[8] = h11;
}
__device__ __forceinline__ void peer_v_wave(int tok0, int step, int k, int lane, const int* __restrict__ EIDX, const float* __restrict__ HID, const unsigned char* __restrict__ VF, bf16_t* __restrict__ PO) {
    asm volatile("" : "+v"(lane));
    const int g = lane >> 3, c = lane & 7;
    const unsigned voff = (unsigned)(k * (NEXP * 128) + 16 * c);
    const int dim = 128 * k + 16 * c + ((lane >> 5) & 1) * 8 + ((lane >> 4) & 1) * 4 + ((lane >> 3) & 1) * 2;
    const int last = tok0 + ((NTOK - 1 - tok0) / step) * step;
#define V_IDS(DST, tok_, half_) do { const int tt_ = (tok_) <= last ? (tok_) : last; const rt_i32x4* e_ = (const rt_i32x4*)(EIDX + (size_t)tt_ * 128 + 16 * g + 8 * (half_)); const rt_i32x4 a_ = e_[0], b_ = e_[1]; \
        DST[0] = a_.x; DST[1] = a_.y; DST[2] = a_.z; DST[3] = a_.w; DST[4] = b_.x; DST[5] = b_.y; DST[6] = b_.z; DST[7] = b_.w; } while (0)
#define V_HID(DST, tok_, half_) do { const int tt_ = (tok_) <= last ? (tok_) : last; const f32x4v* e_ = (const f32x4v*)(HID + (size_t)tt_ * 128 + 16 * g + 8 * (half_)); const f32x4v a_ = e_[0], b_ = e_[1]; \
        DST[0] = a_.x; DST[1] = a_.y; DST[2] = a_.z; DST[3] = a_.w; DST[4] = b_.x; DST[5] = b_.y; DST[6] = b_.z; DST[7] = b_.w; } while (0)
#define V_GATHER(W, IDS) do { _Pragma("unroll") for (int i_ = 0; i_ < 8; ++i_) W[i_] = *(const uint4*)(VF + ((unsigned)IDS[i_] * 128u + voff)); } while (0)
#define V_FMA2(j_, word_, hi_) acc2[j_] = __builtin_amdgcn_cvt_pk_f32_fp8((int)(word_), hi_) * hh_ + acc2[j_]
#define V_COMPUTE(W, HL) do { _Pragma("unroll") for (int i_ = 0; i_ < 8; ++i_) { const uint4 q_ = W[i_]; const rt_f32x2 hh_ = {HL[i_], HL[i_]}; \
        V_FMA2(0, q_.x, false); V_FMA2(1, q_.x, true); V_FMA2(2, q_.y, false); V_FMA2(3, q_.y, true); V_FMA2(4, q_.z, false); V_FMA2(5, q_.z, true); V_FMA2(6, q_.w, false); V_FMA2(7, q_.w, true); \
        asm volatile("" : "+v"(acc2[0]), "+v"(acc2[1]), "+v"(acc2[2]), "+v"(acc2[3]), "+v"(acc2[4]), "+v"(acc2[5]), "+v"(acc2[6]), "+v"(acc2[7]));   \
        __builtin_amdgcn_sched_barrier(0); } } while (0)
    int idsA[8], idsB[8]; uint4 WA[8], WB[8]; float hA[8], hB[8];
    V_IDS(idsA, tok0, 0); V_IDS(idsB, tok0, 1);
    V_GATHER(WA, idsA); V_HID(hA, tok0, 0); V_IDS(idsA, tok0 + step, 0);
#pragma unroll 1
    for (int tok = tok0; tok < NTOK; tok += step) {
        V_GATHER(WB, idsB); V_HID(hB, tok, 1); V_IDS(idsB, tok + step, 1);
        rt_f32x2 acc2[8];
#pragma unroll
        for (int j = 0; j < 8; ++j) acc2[j] = (rt_f32x2){0.f, 0.f};
        V_COMPUTE(WA, hA);
        V_GATHER(WA, idsA); V_HID(hA, tok + step, 0); V_IDS(idsA, tok + 2 * step, 0);
        V_COMPUTE(WB, hB);
        float acc[16];
#pragma unroll
        for (int j = 0; j < 8; ++j) { acc[2 * j] = acc2[j].x; acc[2 * j + 1] = acc2[j].y; }
        float a8[8], a4[4], a2[2];
#pragma unroll
        for (int j = 0; j < 8; ++j) { auto rr = __builtin_amdgcn_permlane32_swap(__float_as_uint(acc[j]), __float_as_uint(acc[j + 8]), false, false); a8[j] = __uint_as_float(rr[0]) + __uint_as_float(rr[1]); }
#pragma unroll
        for (int j = 0; j < 4; ++j) { auto rr = __builtin_amdgcn_permlane16_swap(__float_as_uint(a8[j]), __float_as_uint(a8[j + 4]), false, false); a4[j] = __uint_as_float(rr[0]) + __uint_as_float(rr[1]); }
#pragma unroll
        for (int j = 0; j < 2; ++j) { const bool up = (lane & 8) != 0; const float keep = up ? a4[j + 2] : a4[j], send = up ? a4[j] : a4[j + 2];
            a2[j] = keep + __builtin_bit_cast(float, __builtin_amdgcn_update_dpp(0, __builtin_bit_cast(int, send), 0x128, 0xf, 0xf, false)); }
        *(unsigned*)(PO + (size_t)tok * D + dim) = pk2(a2[0], a2[1]);
    }
#undef V_IDS
#undef V_HID
#undef V_GATHER
#undef V_COMPUTE
#undef V_FMA2
}
__device__ __forceinline__ void final_norm_row(int row, int lane, const bf16_t* __restrict__ HB, const bf16_t* __restrict__ PO, const float* __restrict__ fg, float* __restrict__ out) {
    const uint2* hr = (const uint2*)(HB + (size_t)row * D) + lane; const uint2* pr = (const uint2*)(PO + (size_t)row * D) + lane;
    f32x4v* orow = (f32x4v*)(out + (size_t)row * D) + lane; f32x4v v[4]; float ss = 0.f;
#pragma unroll
    for (int j = 0; j < 4; ++j) { const uint2 y = hr[64 * j], p = pr[64 * j];
        v[j].x = bflo(y.x) + bflo(p.x); v[j].y = bfhi(y.x) + bfhi(p.x); v[j].z = bflo(y.y) + bflo(p.y); v[j].w = bfhi(y.y) + bfhi(p.y);
        ss += (v[j].x * v[j].x + v[j].y * v[j].y) + (v[j].z * v[j].z + v[j].w * v[j].w); }
    ss = wave_sum(ss);
    const float rstd = rsqrtf(ss * (1.f / D) + RMS_EPS);
#pragma unroll
    for (int j = 0; j < 4; ++j) orow[64 * j] = v[j] * rstd * ((const f32x4v*)fg)[lane + 64 * j];
}

struct Args { const float* in[16]; float* out; unsigned char* ws; };
#define XB_TMO      128
#define XB_XCNT(j)  (256  + 64 * (j))
#define XB_XSUB(j)  (1280 + 64 * (j))
#define XB_XGEN(j)  (2304 + 64 * (j))
#define XB_TOP      3328
#define XB_TOPGEN   3392
#define XCD_BAR_WORDS 3456
#define XB_SPIN_CAP (1u << 18)

__device__ __forceinline__ unsigned xb_ld(unsigned* p)              { return __hip_atomic_load(p, __ATOMIC_RELAXED, __HIP_MEMORY_SCOPE_AGENT); }
__device__ __forceinline__ unsigned xb_add(unsigned* p, unsigned v) { return __hip_atomic_fetch_add(p, v, __ATOMIC_RELAXED, __HIP_MEMORY_SCOPE_AGENT); }
__device__ __forceinline__ unsigned xb_xcc_id() { return (unsigned)__builtin_amdgcn_s_getreg((3 << 11) | 20) & 0xFu; }
#define XB_SPIN(cond, bar) do { unsigned _sp = 0; while (cond) { __builtin_amdgcn_s_sleep(1); \
    if ((++_sp & 255u) == 0u) { if (xb_ld(&(bar)[XB_TMO])) break; if (_sp > XB_SPIN_CAP) { atomicAdd(&(bar)[XB_TMO], 1u); break; } } } } while (0)

struct XcdBarrier {
    unsigned* bar; unsigned x;
    volatile LAS unsigned* st;
};

__device__ __forceinline__ XcdBarrier xcd_barrier_post(unsigned* bar, volatile LAS unsigned* st) {
    XcdBarrier b; b.bar = bar; b.x = xb_xcc_id(); b.st = st;
    if (threadIdx.x == 0) (void)xb_add(&bar[XB_XCNT(b.x)], 1u);
    return b;
}
__device__ __forceinline__ void xcd_barrier_complete(unsigned* bar, unsigned x, unsigned& nloc, unsigned& nx) {
    const unsigned G = gridDim.x * gridDim.y * gridDim.z;
    unsigned sum, cnt, mine, sp = 0u;
    for (;;) {
        sum = 0u; cnt = 0u; mine = 0u;
#pragma unroll
        for (unsigned j = 0; j < 16; ++j) { const unsigned c = xb_ld(&bar[XB_XCNT(j)]); sum += c; cnt += (c > 0u) ? 1u : 0u; mine = (j == x) ? c : mine; }
        if (sum == G) break;
        __builtin_amdgcn_s_sleep(1);
        if ((++sp & 255u) == 0u) { if (xb_ld(&bar[XB_TMO])) break; if (sp > XB_SPIN_CAP) { atomicAdd(&bar[XB_TMO], 1u); break; } }
    }
    nloc = mine > 0u ? mine : 1u; nx = cnt > 0u ? cnt : 1u;
}

__device__ __forceinline__ void xcd_barrier(const XcdBarrier& b) {
    asm volatile("s_waitcnt vmcnt(0)" ::: "memory");
    __syncthreads();
    if (threadIdx.x == 0) {
        unsigned* bar = b.bar;
        __builtin_amdgcn_s_waitcnt(0);
        unsigned nloc = b.st[0], nx = b.st[1];
        if (nloc == 0u) { xcd_barrier_complete(bar, b.x, nloc, nx); b.st[0] = nloc; b.st[1] = nx; }
        const unsigned old = xb_add(&bar[XB_XSUB(b.x)], 1u);
        const unsigned gen = old / nloc;
        if (old + 1u == (gen + 1u) * nloc) {
            __builtin_amdgcn_fence(__ATOMIC_RELEASE, "agent");
            asm volatile("s_waitcnt vmcnt(0)" ::: "memory");
            const unsigned og = xb_add(&bar[XB_TOP], 1u);
            const unsigned tg = og / nx;
            if (og + 1u == (tg + 1u) * nx) xb_add(&bar[XB_TOPGEN], 1u);
            else XB_SPIN(xb_ld(&bar[XB_TOPGEN]) == tg, bar);
            __builtin_amdgcn_fence(__ATOMIC_ACQUIRE, "agent");
            xb_add(&bar[XB_XGEN(b.x)], 1u);
            asm volatile("s_waitcnt vmcnt(0)" ::: "memory");
        } else {
            XB_SPIN(xb_ld(&bar[XB_XGEN(b.x)]) == gen, bar);
            __builtin_amdgcn_fence(__ATOMIC_ACQUIRE, "agent");
            asm volatile("s_waitcnt vmcnt(0)" ::: "memory");
        }
    }
    __syncthreads();
}

constexpr int CW_QUEUE = 1024, LDS_QW = 131072 + 128;
constexpr int CW_BAR = 4096;
constexpr int LDS_BARST = 131072 + 64;
#define CAS __attribute__((address_space(4)))
#define PHASE_PROLOGUE() \
    const CAS Args* ap = (const CAS Args*)__builtin_amdgcn_kernarg_segment_ptr(); asm volatile("" : "+s"(ap)); \
    Ctx c; { int t_ = threadIdx.x; asm volatile("" : "+v"(t_)); c.tid = t_; } c.lane = c.tid & 63; c.wave = __builtin_amdgcn_readfirstlane(c.tid >> 6); c.G = gridDim.x; \
    { const int bx = blockIdx.x; c.vcu = (c.G % 8 == 0) ? (bx % 8) * (c.G / 8) + bx / 8 : bx; } \
    c.gw = c.vcu * NWAVES + c.wave; c.NGW = c.G * NWAVES; c.lds = (LAS unsigned char*)lds_raw; c.lds_gen = lds_raw; \
    unsigned char* ws = ap->ws; (void)ws
#define IN(k) (ap->in[k])
#define GRID_BAR() do { XcdBarrier b_; b_.bar = (unsigned*)(((const CAS Args*)__builtin_amdgcn_kernarg_segment_ptr())->ws + WS_CTL) + CW_BAR; b_.x = xb_xcc_id(); b_.st = (volatile LAS unsigned*)((LAS unsigned char*)lds_raw + LDS_BARST); xcd_barrier(b_); } while (0)
#ifndef PROBE_PHASE
#define PROBE_PHASE -1
#endif
#define STAMP(k) do { if (PROBE_PHASE >= 0 && blockIdx.x == 0 && threadIdx.x == 0) ((unsigned long long*)(((const CAS Args*)__builtin_amdgcn_kernarg_segment_ptr())->ws + WS_CTL))[k] = __builtin_amdgcn_s_memrealtime(); } while (0)
__global__ void __launch_bounds__(NTHR, 2) fwd_megakernel(Args a_unused) {
    extern __shared__ __attribute__((aligned(16))) unsigned char lds_raw[];
    { volatile LAS unsigned* st_ = (volatile LAS unsigned*)((LAS unsigned char*)lds_raw + LDS_BARST); if (threadIdx.x == 0) { st_[0] = 0u; st_[1] = 0u; } }
    STAMP(0);
    if (blockIdx.x == 0) { unsigned* ctl_ = (unsigned*)(((const CAS Args*)__builtin_amdgcn_kernarg_segment_ptr())->ws + WS_CTL);
        for (int i = 64 + (int)threadIdx.x; i < 16384; i += NTHR) ctl_[i] = 0u; }
    { PHASE_PROLOGUE();
      p0_weights(c, IN(2), IN(9), IN(11), IN(10), (bf16_t*)(ws + WS_WIN), (bf16_t*)(ws + WS_WOUT), (bf16_t*)(ws + WS_WQ));
      rms1_gates_wave(c.gw, c.NGW, c.lane, IN(0), IN(1), IN(2), IN(3), (bf16_t*)(ws + WS_XN), (float*)(ws + WS_LOGF)); }
    { PHASE_PROLOGUE();
      for (int i = c.vcu * NTHR + c.tid; i < NRM_WORDS; i += c.G * NTHR) ((float*)(ws + WS_NRM))[i] = 0.f;
      for (int i = c.vcu * NTHR + c.tid; i < NTOK; i += c.G * NTHR) ((unsigned long long*)(ws + WS_SS))[i] = 0ull; }
    cg::this_grid().sync();
    (void)xcd_barrier_post((unsigned*)(((const CAS Args*)__builtin_amdgcn_kernarg_segment_ptr())->ws + WS_CTL) + CW_BAR, (volatile LAS unsigned*)((LAS unsigned char*)lds_raw + LDS_BARST));
    STAMP(1);
    { PHASE_PROLOGUE();
      if (c.gw < BATCH * FH) cumsum_seq(c.gw, c.lane, (const float*)(ws + WS_LOGF), (float*)(ws + WS_CUM));
      __syncthreads(); }
    { PHASE_PROLOGUE();
      pg8::Gemm g{(const bf16_t*)(ws + WS_XN), (const bf16_t*)(ws + WS_WIN), NTOK, NPROJ, D}; pg8::StaticOrder S; S.init(NTOK, NPROJ, c.G, (int)blockIdx.x);
      pg8::EpiBf16Norm E{(bf16_t*)(ws + WS_PROJ), NPROJ, (unsigned*)(ws + WS_NRM)};
      pg8::gemm_phase<pg8::EpiBf16Norm, pg8::StaticOrder, true, true>(c.lds, g, S, E); }
    GRID_BAR(); STAMP(2);
    STAMP(3);
    { PHASE_PROLOGUE();
      const float lam = expf(wave_sum(IN(4)[c.lane] * IN(5)[c.lane])) - expf(wave_sum(IN(6)[c.lane] * IN(7)[c.lane])) + LAMBDA_INIT;
      if (c.tid == 0) ((LAS float*)(c.lds + LDS_LAM))[0] = lam;
      __syncthreads(); }
    { PHASE_PROLOGUE();
      const int xg = (int)blockIdx.x & 7;
      unsigned* qctr = (unsigned*)(ws + WS_CTL) + CW_QUEUE + 64 * xg;
      for (;;) {
          __syncthreads();
          if (c.tid == 0) ((LAS unsigned*)(c.lds + LDS_QW))[0] = atomicAdd(qctr, 1u);
          __syncthreads();
          const int u = __builtin_amdgcn_readfirstlane((int)((LAS unsigned*)(c.lds + LDS_QW))[0]);
          if (u >= 2 * 16 * (DH + FH)) break;
          if (u < 2 * 16 * DH) { const int bl = u >> 4; diff_unit(c, xg + 8 * (bl >> 2), bl & 3, 15 - (u & 15), (const bf16_t*)(ws + WS_PROJ), (const float*)(ws + WS_NRM), IN(8), (bf16_t*)(ws + WS_MIXED), ws); }
          else { const int v = u - 2 * 16 * DH, bl = v >> 4; fox_unit(c, xg + 8 * (bl >> 3), bl & 7, 15 - (v & 15), (const bf16_t*)(ws + WS_PROJ), (const float*)(ws + WS_CUM), (const float*)(ws + WS_NRM), (bf16_t*)(ws + WS_MIXED)); }
      } }
    { PHASE_PROLOGUE();
      unsigned* tctr = (unsigned*)(ws + WS_CTL) + CW_QUEUE + 64 * 8;
      for (;;) {
          __syncthreads();
          if (c.tid == 0) ((LAS unsigned*)(c.lds + LDS_QW))[0] = atomicAdd(tctr, 1u);
          __syncthreads();
          const int u = __builtin_amdgcn_readfirstlane((int)((LAS unsigned*)(c.lds + LDS_QW))[0]);
          if (u >= 2 * NEXP / 64) break;
#pragma unroll 1
          for (int i = 0; i < 8; ++i) { const int r = u * 64 + c.wave * 8 + i;
              if (r < NEXP) p0_table_row(c.lane, IN(13) + (size_t)r * D, IN(10), ws + WS_UF8, r, (float*)(ws + WS_SCU) + r);
              else p0_table_row(c.lane, IN(14) + (size_t)(r - NEXP) * D, nullptr, ws + WS_VF8, r - NEXP, (float*)(ws + WS_SCV) + (r - NEXP)); }
      } }
    GRID_BAR(); STAMP(4);
    { PHASE_PROLOGUE();
      pg8::Gemm g{(const bf16_t*)(ws + WS_MIXED), (const bf16_t*)(ws + WS_WOUT), NTOK, D, D}; pg8::StaticOrder S; S.init(NTOK, D, c.G, (int)blockIdx.x);
      pg8::EpiResidual E{IN(0), (bf16_t*)(ws + WS_XN), (unsigned long long*)(ws + WS_SS), D};
      pg8::gemm_phase<pg8::EpiResidual, pg8::StaticOrder, true, true>(c.lds, g, S, E); }
    GRID_BAR(); STAMP(5); STAMP(6);
    { PHASE_PROLOGUE();
      pg8::Gemm g{(const bf16_t*)(ws + WS_XN), (const bf16_t*)(ws + WS_WQ), NTOK, PQ, D}; pg8::StaticOrder S; S.init(NTOK, PQ, c.G, (int)blockIdx.x);
      pg8::EpiBf16RowScale E{(bf16_t*)(ws + WS_QP), PQ, (const unsigned long long*)(ws + WS_SS), 1.f / D, RMS_EPS};
      pg8::gemm_phase<pg8::EpiBf16RowScale, pg8::StaticOrder, true, true>(c.lds, g, S, E); }
    GRID_BAR(); STAMP(7);
    { PHASE_PROLOGUE();
      for (int blk = c.vcu; blk < NTOK / 256; blk += c.G) {
          for (int h = 0; h < PH; ++h) {
              __syncthreads();
              route_stage_subkeys(c, IN(12), h);
              __syncthreads();
              route_tile(c, blk * 8 + c.wave, h, (const bf16_t*)(ws + WS_QP), (const float*)(ws + WS_SCU), (const float*)(ws + WS_SCV), (int*)(ws + WS_EIDX), (float*)(ws + WS_GATE), (float*)(ws + WS_SUA));
          }
      } }
    GRID_BAR(); STAMP(8);
    asm volatile(".rept 4\n s_nop 0\n .endr" ::: "memory");
    { PHASE_PROLOGUE();
      const int k = (int)blockIdx.x & 7, nw = (c.G >> 3) * NWAVES, wx = ((int)blockIdx.x >> 3) * NWAVES + c.wave;
      peer_u_wave(wx, nw, k, c.lane, (const bf16_t*)(ws + WS_XN), (const int*)(ws + WS_EIDX), ws + WS_UF8, (unsigned*)(ws + WS_PART)); }
    GRID_BAR(); STAMP(9);
    { PHASE_PROLOGUE();
      for (int tok = c.gw; tok < NTOK; tok += 2 * c.NGW) peer_hid_token2(tok, (tok + c.NGW < NTOK) ? tok + c.NGW : tok, c.lane, (const unsigned*)(ws + WS_PART), (const float*)(ws + WS_SUA), (const unsigned long long*)(ws + WS_SS), (float*)(ws + WS_GATE)); }
    GRID_BAR(); STAMP(10);
    asm volatile(".rept 6\n s_nop 0\n .endr" ::: "memory");
    { PHASE_PROLOGUE();
      const int k = (int)blockIdx.x & 7, nw = (c.G >> 3) * NWAVES, wx = ((int)blockIdx.x >> 3) * NWAVES + c.wave;
      peer_v_wave(wx, nw, k, c.lane, (const int*)(ws + WS_EIDX), (const float*)(ws + WS_GATE), ws + WS_VF8, (bf16_t*)(ws + WS_PO)); }
    GRID_BAR(); STAMP(11);
    { PHASE_PROLOGUE();
      for (int row = c.gw; row < NTOK; row += c.NGW) final_norm_row(row, c.lane, (const bf16_t*)(ws + WS_XN), (const bf16_t*)(ws + WS_PO), IN(15), ap->out);
      STAMP(12);
      if (PROBE_PHASE >= 0 && blockIdx.x == 0 && threadIdx.x == 0) { asm volatile("s_waitcnt vmcnt(0)" ::: "memory"); const unsigned long long* ts = (const unsigned long long*)(ws + WS_CTL);
          ap->out[0] += (float)(PROBE_PHASE == 100 ? ts[12] - ts[0] : ts[PROBE_PHASE + 1] - ts[PROBE_PHASE]) * 1e-4f; } }
}

extern "C" void kernel_launch(void* const* d_in, const int* in_sizes, int n_in, void* d_out, int out_size, void* d_ws, size_t ws_size, hipStream_t stream) {
    static int grid = 0;
    if (grid == 0) {
        if (n_in != 16 || in_sizes[0] != NTOK * D || out_size != NTOK * D || ws_size < WS_END2) { fprintf(stderr, "kernel_launch: unexpected shapes (n_in %d in0 %d out %d ws %zu)\n", n_in, in_sizes[0], out_size, ws_size); grid = -1; return; }
        int dev = 0, cus = 0, per_cu = 0;
        if (hipGetDevice(&dev) != hipSuccess || hipDeviceGetAttribute(&cus, hipDeviceAttributeMultiprocessorCount, dev) != hipSuccess) { grid = -1; return; }
        if (hipFuncSetAttribute((const void*)fwd_megakernel, hipFuncAttributeMaxDynamicSharedMemorySize, LDS_BYTES) != hipSuccess) { fprintf(stderr, "hipFuncSetAttribute failed\n"); grid = -1; return; }
        if (hipOccupancyMaxActiveBlocksPerMultiprocessor(&per_cu, (const void*)fwd_megakernel, NTHR, LDS_BYTES) != hipSuccess || per_cu < 1) { fprintf(stderr, "occupancy query failed (%d)\n", per_cu); grid = -1; return; }
        grid = cus;
    }
    if (grid < 0) return;
    Args a{};
    for (int i = 0; i < 16; ++i) a.in[i] = (const float*)d_in[i];
    a.out = (float*)d_out; a.ws = (unsigned char*)d_ws;
    void* args[] = {&a};
    hipError_t e = hipLaunchCooperativeKernel((const void*)fwd_megakernel, dim3(grid), dim3(NTHR), args, LDS_BYTES, stream);
    if (e != hipSuccess) fprintf(stderr, "cooperative launch failed: %s (grid %d)\n", hipGetErrorString(e), grid);
}
```

```cpp
#include <hip/hip_runtime.h>
#include <hip/hip_cooperative_groups.h>
#include <cstdio>
#include <cstdint>
#include <cmath>
namespace pg8 {
#define PG8_LAS __attribute__((address_space(3)))
typedef unsigned short bf16_t;
typedef short bf16x8 __attribute__((ext_vector_type(8)));
typedef float f32x4 __attribute__((ext_vector_type(4)));
typedef unsigned u32x4 __attribute__((ext_vector_type(4)));
constexpr int BM = 256, BK = 64, HALF = 128, HTB = HALF * BK * 2  , STAGE_BYTES = 8 * HTB, NXCD = 8, WGM = 8;

__host__ __device__ __forceinline__ int lds_byte(int r, int c) { const int st = (r >> 4) * 2 + (c >> 5), rr = r & 15, cc = c & 31, ob = rr * 64 + cc * 2; return st * 1024 + (ob ^ (((ob >> 9) & 1) << 5)); }
__host__ __device__ __forceinline__ void stage_rc(int b, int& R, int& C) { const int st = b / 1024, sb = b % 1024, swz = sb ^ (((sb >> 9) & 1) << 5); R = (st >> 1) * 16 + swz / 64; C = (st & 1) * 32 + (swz % 64) / 2; }
__host__ __device__ __forceinline__ int perm32(int rho) { const int n = rho >> 4, i = rho & 15; return 8 * (i >> 2) + 4 * n + (i & 3); }

struct Unit { int pm, pn; };
struct Gemm { const bf16_t* A; const bf16_t* Bt; int M, N, K; };

struct StaticOrder {
    int nM, nN, nwg, G, c;
    __host__ __device__ void init(int M, int N, int G_, int c_) { nM = M / BM; nN = N / BM; nwg = nM * nN; G = G_; c = c_; }
    __host__ __device__ bool next(int i, Unit& u) const {
        const long L = (long)i * G + c; if (L >= nwg) return false;
        int wgid = (int)L; { const int q = nwg / NXCD, r = nwg % NXCD, xcd = wgid % NXCD, off = wgid / NXCD; wgid = (xcd < r ? xcd * (q + 1) : r * (q + 1) + (xcd - r) * q) + off; }
        const int nig = WGM * nN, gid = wgid / nig, fm = gid * WGM, gsz = (nM - fm) < WGM ? (nM - fm) : WGM;
        u.pm = fm + ((wgid % nig) % gsz); u.pn = (wgid % nig) / gsz; return true;
    }
    __device__ __forceinline__ void a_ready(const Unit&) const {}
    __device__ __forceinline__ void done(const Unit&) const {}
};

__device__ __forceinline__ unsigned cvt_pk_bf16(float lo, float hi) { unsigned r; asm volatile("v_cvt_pk_bf16_f32 %0, %1, %2" : "=v"(r) : "v"(lo), "v"(hi)); return r; }
typedef float f32x2 __attribute__((ext_vector_type(2)));
__device__ __forceinline__ f32x2 gelu_pk(f32x2 v) {
    const f32x2 av = __builtin_elementwise_abs(v), d = av * 0.2316418882f + 1.0f;
    f32x2 t; t.x = __builtin_amdgcn_rcpf(d.x); t.y = __builtin_amdgcn_rcpf(d.y);
    f32x2 q = t * 0.5307027145f + (-0.7265760135f); q = q * t + 0.7107068705f; q = q * t + (-0.142248368f); q = q * t + 0.127414796f; q = q * t;
    const f32x2 s = (v * v) * (-0.72134752044f);
    f32x2 e; e.x = __builtin_amdgcn_exp2f(s.x); e.y = __builtin_amdgcn_exp2f(s.y);
    const f32x2 m = v * (q * e), r = v - m;
    f32x2 o; o.x = v.x < 0.f ? m.x : r.x; o.y = v.y < 0.f ? m.y : r.y; return o;
}

template <int ACT  > struct EpiBf16 {
    static constexpr bool PERM = true, AFTER_DRAIN = false; static_assert(ACT == 0 || ACT == 1, "EpiBf16: ACT is 0 (none) or 1 (gelu_pk)");
    bf16_t* O; int ldc; const float* bias; int split_cols; size_t split_stride; float scale0;
    __device__ __forceinline__ void operator()(const f32x4 (&acc)[2][2][4][2], const Unit& u, int wr, int wc, int fr, int fq) const {
        const int row0 = u.pm * BM + wr * 64 + fr; int colt = u.pn * BM; bf16_t* base = O;
        float sc = 1.f; if (split_cols) { const int t = colt / split_cols; base += (size_t)t * split_stride; colt -= t * split_cols; if (t == 0) sc = scale0; }
        const int col0 = colt + wc * 32 + 8 * fq, bcol0 = u.pn * BM + wc * 32 + 8 * fq;
        f32x4 bv[2][2];
#pragma unroll
        for (int bj = 0; bj < 2; ++bj)
#pragma unroll
            for (int n = 0; n < 2; ++n) bv[bj][n] = bias ? *(const f32x4*)(bias + bcol0 + bj * HALF + 4 * n) : (f32x4){0.f, 0.f, 0.f, 0.f};
#pragma unroll
        for (int ai = 0; ai < 2; ++ai)
#pragma unroll
            for (int m = 0; m < 4; ++m) { bf16_t* rowp = base + (size_t)(row0 + ai * HALF + m * 16) * ldc + col0;
#pragma unroll
                for (int bj = 0; bj < 2; ++bj) { f32x4 v0 = acc[ai][bj][m][0] + bv[bj][0], v1 = acc[ai][bj][m][1] + bv[bj][1];
                    if (ACT == 1) { f32x2 a = gelu_pk((f32x2){v0[0], v0[1]}), b = gelu_pk((f32x2){v0[2], v0[3]}), c = gelu_pk((f32x2){v1[0], v1[1]}), d = gelu_pk((f32x2){v1[2], v1[3]});
                        v0 = (f32x4){a.x, a.y, b.x, b.y}; v1 = (f32x4){c.x, c.y, d.x, d.y}; }
                    v0 = v0 * sc; v1 = v1 * sc; u32x4 w; w.x = cvt_pk_bf16(v0[0], v0[1]); w.y = cvt_pk_bf16(v0[2], v0[3]); w.z = cvt_pk_bf16(v1[0], v1[1]); w.w = cvt_pk_bf16(v1[2], v1[3]);
                    *(u32x4*)(rowp + bj * HALF) = w; } }
    }
};
template <class Epi, class Sched, bool ALIGN_EPI = false, bool SP2 = false>
__device__ __forceinline__ void gemm_phase(PG8_LAS unsigned char* lds, const Gemm g, const Sched& S, const Epi& E) {
    int tid_l = threadIdx.x; asm volatile("" : "+v"(tid_l));
    const int tid = tid_l, wid = __builtin_amdgcn_readfirstlane(tid >> 6), lane = tid & 63, wr = wid >> 2, wc = wid & 3, fr = lane & 15, fq = lane >> 4;
    const int K = g.K, nt = K / BK;
    unsigned voffA[2], voffB[2];
#pragma unroll
    for (int i = 0; i < 2; ++i) { int R, C; stage_rc(tid * 16 + i * 8192, R, C); const int Rb = Epi::PERM ? ((R & ~31) + perm32(R & 31)) : R;
        voffA[i] = (unsigned)(R * K + C) * 2u; voffB[i] = (unsigned)(Rb * K + C) * 2u; }
    const size_t kstep = (size_t)(BK * 2);
    const size_t hstep = (size_t)HALF * K * 2;
    const size_t tstep = 2 * hstep;
    const unsigned ldsw = (unsigned)wid * 1024u;
    const int aoff = lds_byte(wr * 64 + fr, fq * 8), boff = lds_byte(wc * 32 + fr, fq * 8);
#define PG8_SA(b, h) (((b) * 2 + (h)) * HTB)
#define PG8_SB(b, h) ((4 + (b) * 2 + (h)) * HTB)
#define PG8_STAGE(bufoff, gbase, voff) do { _Pragma("unroll") for (int _i = 0; _i < 2; ++_i) \
        __builtin_amdgcn_global_load_lds((const unsigned*)((const char*)(gbase) + (voff)[_i]), (PG8_LAS unsigned*)(lds + (bufoff) + ldsw + _i * 8192), 16, 0, 0); } while (0)
#define PG8_LDA(dst, b, h) do { _Pragma("unroll") for (int m = 0; m < 4; ++m) _Pragma("unroll") for (int k = 0; k < 2; ++k) dst[m][k] = *(const PG8_LAS bf16x8*)(lds + PG8_SA(b, h) + aoff + m * 2048 + k * 1024); } while (0)
#define PG8_LDB(dst, b, h) do { _Pragma("unroll") for (int n = 0; n < 2; ++n) _Pragma("unroll") for (int k = 0; k < 2; ++k) dst[n][k] = *(const PG8_LAS bf16x8*)(lds + PG8_SB(b, h) + boff + n * 2048 + k * 1024); } while (0)
#define PG8_MMA(ai, bj, At, Bt) do { __builtin_amdgcn_s_setprio(1); _Pragma("unroll") for (int m = 0; m < 4; ++m) _Pragma("unroll") for (int n = 0; n < 2; ++n) _Pragma("unroll") for (int k = 0; k < 2; ++k) \
        acc[ai][bj][m][n] = __builtin_amdgcn_mfma_f32_16x16x32_bf16(Bt[n][k], At[m][k], acc[ai][bj][m][n], 0, 0, 0); __builtin_amdgcn_s_setprio(0); } while (0)
#define PG8_WAIT_V(n) asm volatile("s_waitcnt vmcnt(" #n ")" ::: "memory")
#define PG8_WAIT_L(n) asm volatile("s_waitcnt lgkmcnt(" #n ")" ::: "memory")
#define PG8_BAR __builtin_amdgcn_s_barrier()
#define PG8_SCHED __builtin_amdgcn_sched_barrier(0)
    Unit cur, nxt; int ui = 0;
    if (!S.next(0, cur)) return;
    f32x4 acc[2][2][4][2];
#pragma unroll
    for (int a = 0; a < 2; ++a)
#pragma unroll
        for (int b = 0; b < 2; ++b)
#pragma unroll
            for (int m = 0; m < 4; ++m)
#pragma unroll
                for (int n = 0; n < 2; ++n) acc[a][b][m][n] = (f32x4){0.f, 0.f, 0.f, 0.f};
    bf16x8 At[4][2], B0[2][2], B1[2][2];
    const char* cA = (const char*)g.A + (size_t)cur.pm * tstep; const char* cB = (const char*)g.Bt + (size_t)cur.pn * tstep;
    S.a_ready(cur);
    if constexpr (SP2) {
        PG8_STAGE(PG8_SB(0, 0), cB, voffB); PG8_STAGE(PG8_SB(0, 1), cB + hstep, voffB); PG8_STAGE(PG8_SA(0, 0), cA, voffA); PG8_STAGE(PG8_SA(0, 1), cA + hstep, voffA);
        if (wr == 1) PG8_BAR;
        PG8_WAIT_V(2); PG8_BAR;
        PG8_STAGE(PG8_SB(1, 0), cB + kstep, voffB); PG8_STAGE(PG8_SA(1, 0), cA + kstep, voffA); PG8_STAGE(PG8_SB(1, 1), cB + hstep + kstep, voffB);
        PG8_WAIT_V(6); PG8_BAR;
    } else {
        PG8_STAGE(PG8_SB(0, 0), cB, voffB); PG8_STAGE(PG8_SA(0, 0), cA, voffA); PG8_STAGE(PG8_SB(0, 1), cB + hstep, voffB); PG8_STAGE(PG8_SA(0, 1), cA + hstep, voffA);
        if (wr == 1) PG8_BAR;
        PG8_WAIT_V(4); PG8_BAR;
        PG8_STAGE(PG8_SB(1, 0), cB + kstep, voffB); PG8_STAGE(PG8_SA(1, 0), cA + kstep, voffA); PG8_STAGE(PG8_SB(1, 1), cB + hstep + kstep, voffB);
        PG8_WAIT_V(6); PG8_BAR;
    }
    for (;;) {
        const bool has_next = S.next(ui + 1, nxt);
        const char* nA = has_next ? (const char*)g.A + (size_t)nxt.pm * tstep : cA; const char* nB = has_next ? (const char*)g.Bt + (size_t)nxt.pn * tstep : cB;
        for (int t = 0; t < nt; t += 2) {
            const bool last = (t == nt - 2);
            const char* a1 = cA + (size_t)(t + 1) * kstep;
            const char* a2 = last ? nA : cA + (size_t)(t + 2) * kstep; const char* b2 = last ? nB : cB + (size_t)(t + 2) * kstep;
            const char* a3 = a2 + kstep; const char* b3 = b2 + kstep;
            if (last && has_next) S.a_ready(nxt);
            if constexpr (SP2) {
            PG8_LDB(B0, 0, 0); PG8_LDB(B1, 0, 1); PG8_SCHED; PG8_LDA(At, 0, 0); PG8_STAGE(PG8_SA(1, 1), a1 + hstep, voffA);
            PG8_WAIT_V(8); PG8_WAIT_L(0); PG8_BAR; PG8_MMA(0, 0, At, B0); PG8_MMA(0, 1, At, B1); PG8_BAR; PG8_SCHED;
            PG8_LDA(At, 0, 1); PG8_STAGE(PG8_SB(0, 0), b2, voffB); PG8_STAGE(PG8_SB(0, 1), b2 + hstep, voffB); PG8_STAGE(PG8_SA(0, 0), a2, voffA);
            PG8_WAIT_V(8); PG8_WAIT_L(0); PG8_BAR; PG8_MMA(1, 0, At, B0); PG8_MMA(1, 1, At, B1); PG8_BAR; PG8_SCHED;
            PG8_LDB(B0, 1, 0); PG8_LDB(B1, 1, 1); PG8_SCHED; PG8_LDA(At, 1, 0); PG8_STAGE(PG8_SA(0, 1), a2 + hstep, voffA);
            PG8_WAIT_V(8); PG8_WAIT_L(0); PG8_BAR; PG8_MMA(0, 0, At, B0); PG8_MMA(0, 1, At, B1); PG8_BAR; PG8_SCHED;
            PG8_LDA(At, 1, 1); PG8_STAGE(PG8_SB(1, 0), b3, voffB); PG8_STAGE(PG8_SB(1, 1), b3 + hstep, voffB); PG8_STAGE(PG8_SA(1, 0), a3, voffA);
            PG8_WAIT_V(8); PG8_WAIT_L(0); PG8_BAR; PG8_MMA(1, 0, At, B0); PG8_MMA(1, 1, At, B1); PG8_BAR; PG8_SCHED;
            } else {
            PG8_LDB(B0, 0, 0); PG8_SCHED; PG8_LDA(At, 0, 0); PG8_STAGE(PG8_SA(1, 1), a1 + hstep, voffA);
            PG8_WAIT_L(8); PG8_BAR; PG8_WAIT_L(0); PG8_MMA(0, 0, At, B0); PG8_BAR; PG8_SCHED;
            PG8_LDB(B1, 0, 1); PG8_STAGE(PG8_SB(0, 0), b2, voffB);
            PG8_BAR; PG8_WAIT_L(0); PG8_MMA(0, 1, At, B1); PG8_BAR;
            PG8_LDA(At, 0, 1); PG8_STAGE(PG8_SA(0, 0), a2, voffA);
            PG8_BAR; PG8_WAIT_L(0); PG8_MMA(1, 0, At, B0); PG8_BAR; PG8_SCHED;
            PG8_STAGE(PG8_SB(0, 1), b2 + hstep, voffB);
            PG8_WAIT_V(6); PG8_BAR; PG8_MMA(1, 1, At, B1); PG8_BAR;
            PG8_LDB(B0, 1, 0); PG8_SCHED; PG8_LDA(At, 1, 0); PG8_STAGE(PG8_SA(0, 1), a2 + hstep, voffA);
            PG8_WAIT_L(8); PG8_BAR; PG8_WAIT_L(0); PG8_MMA(0, 0, At, B0); PG8_BAR; PG8_SCHED;
            PG8_LDB(B1, 1, 1); PG8_STAGE(PG8_SB(1, 0), b3, voffB);
            PG8_BAR; PG8_WAIT_L(0); PG8_MMA(0, 1, At, B1); PG8_BAR;
            PG8_LDA(At, 1, 1); PG8_STAGE(PG8_SA(1, 0), a3, voffA);
            PG8_BAR; PG8_WAIT_L(0); PG8_MMA(1, 0, At, B0); PG8_BAR; PG8_SCHED;
            PG8_STAGE(PG8_SB(1, 1), b3 + hstep, voffB);
            PG8_WAIT_V(6); PG8_BAR; PG8_MMA(1, 1, At, B1); PG8_BAR;
            }
        }
        if constexpr (ALIGN_EPI) { if (wr == 0) PG8_BAR; }
        if constexpr (!Epi::AFTER_DRAIN) { E(acc, cur, wr, wc, fr, fq); S.done(cur); }
        if (!has_next) break;
#pragma unroll
        for (int a = 0; a < 2; ++a)
#pragma unroll
            for (int b = 0; b < 2; ++b)
#pragma unroll
                for (int m = 0; m < 4; ++m)
#pragma unroll
                    for (int n = 0; n < 2; ++n) acc[a][b][m][n] = (f32x4){0.f, 0.f, 0.f, 0.f};
        cur = nxt; cA = nA; cB = nB; ++ui;
        if constexpr (ALIGN_EPI) { if (wr == 1) PG8_BAR; }
    }
    PG8_WAIT_V(0);
    if constexpr (!ALIGN_EPI) { if (wr == 0) PG8_BAR; }
    PG8_BAR;
    if constexpr (Epi::AFTER_DRAIN) { E.fused(acc, cur, wr, wc, fr, fq, lds, wid, lane); S.done(cur); }
#undef PG8_SA
#undef PG8_SB
#undef PG8_STAGE
#undef PG8_LDA
#undef PG8_LDB
#undef PG8_MMA
#undef PG8_WAIT_V
#undef PG8_WAIT_L
#undef PG8_BAR
#undef PG8_SCHED
}
}
#include <hip/hip_bf16.h>
#include <cmath>
namespace attn_body {
using bf16=__hip_bfloat16;
using bf16x8=__attribute__((ext_vector_type(8)))short;
using s16x4=__attribute__((ext_vector_type(4)))short;
using f32x16=__attribute__((ext_vector_type(16)))float;
using u32x4=__attribute__((ext_vector_type(4)))unsigned;
constexpr int SEQ=4096,D=64,DM=3072;
constexpr int NW=8,QBLK=32,QB=QBLK*NW,KVBLK=64,NQB=SEQ/QB;
constexpr int ATTN_UNIT_ROWS=QB;
__device__ __forceinline__ int crow(int r,int hi){return (r&3)+8*(r>>2)+4*hi;}
#define SBAR() __builtin_amdgcn_sched_barrier(0)
__device__ __forceinline__ void cmask(f32x16&p0,f32x16&p1,int jb,int qrel,int hi){
  asm volatile("":"+v"(qrel),"+v"(hi));
  const float NEG=-INFINITY; int kb=64*jb+4*hi;
  #pragma unroll
  for(int r=0;r<16;++r){int kv=kb+(r&3)+8*(r>>2); if(kv>qrel)p0[r]=NEG; if(kv+32>qrel)p1[r]=NEG;}
}

constexpr int NSLOT=3, SLOTB=8192;
constexpr int LDS_K=0, LDS_V=NSLOT*SLOTB, LDS_WS=2*NSLOT*SLOTB, LDS_OST=LDS_WS+NW*64*4, LDS_FEAT=LDS_OST+NW*4096, LDS_BYTES=LDS_FEAT+SEQ*8;
constexpr float C2=0.125f*1.4426950408889634f;
__device__ __forceinline__ void glds16(const void*gsrc,unsigned lds_dst){unsigned keep;
  asm volatile("s_mov_b32 %0, m0\n\ts_mov_b32 m0, %2\n\ts_nop 0\n\tglobal_load_lds_dwordx4 %1, off\n\ts_mov_b32 m0, %0":"=&s"(keep):"v"(gsrc),"s"(lds_dst):"memory");}
__device__ __forceinline__ float max3f(float a,float b,float c){float r;asm("v_max3_f32 %0, %1, %2, %3":"=v"(r):"v"(a),"v"(b),"v"(c));return r;}
__device__ __forceinline__ float max2f(float a,float b){float r;asm("v_max_f32_e32 %0, %1, %2":"=v"(r):"v"(a),"v"(b));return r;}
__device__ __forceinline__ float fadd_s(float a,float b){float r;asm("v_add_f32_e32 %0, %1, %2":"=v"(r):"v"(a),"v"(b));return r;}
__device__ __forceinline__ float fsub_s(float a,float b){float r;asm("v_sub_f32_e32 %0, %1, %2":"=v"(r):"v"(a),"v"(b));return r;}
typedef float f32x2_t __attribute__((ext_vector_type(2))); typedef __bf16 bf16x2_t __attribute__((ext_vector_type(2)));
__device__ __forceinline__ unsigned cvtpk_s(float lo,float hi){f32x2_t v={lo,hi};bf16x2_t b=__builtin_convertvector(v,bf16x2_t);return __builtin_bit_cast(unsigned,b);}
#define WAIT_BAR(N) asm volatile("s_waitcnt vmcnt(" #N ") lgkmcnt(0)\n\ts_barrier":::"memory")

__device__ __forceinline__ void qkt(f32x16&p0,f32x16&p1,const char*Kslot,const bf16x8*qr,bf16x8 ax0,bf16x8 ax1,bf16x8 qx,int r32,int hi){
  const char*kb=Kslot+hi*1024+r32*16;
  const f32x16 z=f32x16{};
  p0=__builtin_amdgcn_mfma_f32_32x32x16_bf16(ax0,qx,z,0,0,0);p1=__builtin_amdgcn_mfma_f32_32x32x16_bf16(ax1,qx,z,0,0,0);
  #pragma unroll
  for(int d0=0;d0<4;++d0){
    const bf16x8 b0=*reinterpret_cast<const bf16x8*>(kb+d0*2048);
    const bf16x8 b1=*reinterpret_cast<const bf16x8*>(kb+d0*2048+512);
    p0=__builtin_amdgcn_mfma_f32_32x32x16_bf16(b0,qr[d0],p0,0,0,0);p1=__builtin_amdgcn_mfma_f32_32x32x16_bf16(b1,qr[d0],p1,0,0,0);}
}
typedef __attribute__((address_space(3))) const char* lds_cptr;
typedef short v4i16_t __attribute__((ext_vector_type(4)));
__device__ __forceinline__ void kload8(bf16x8*kf,lds_cptr kp){
  kf[0]=*(const __attribute__((address_space(3))) bf16x8*)(kp);      kf[1]=*(const __attribute__((address_space(3))) bf16x8*)(kp+512);
  kf[2]=*(const __attribute__((address_space(3))) bf16x8*)(kp+2048); kf[3]=*(const __attribute__((address_space(3))) bf16x8*)(kp+2560);
  kf[4]=*(const __attribute__((address_space(3))) bf16x8*)(kp+4096); kf[5]=*(const __attribute__((address_space(3))) bf16x8*)(kp+4608);
  kf[6]=*(const __attribute__((address_space(3))) bf16x8*)(kp+6144); kf[7]=*(const __attribute__((address_space(3))) bf16x8*)(kp+6656);
}
__device__ __forceinline__ void kload2(bf16x8*kf,lds_cptr kp,int j){ kf[2*j]=*(const __attribute__((address_space(3))) bf16x8*)(kp+j*2048); kf[2*j+1]=*(const __attribute__((address_space(3))) bf16x8*)(kp+j*2048+512); }
__device__ __forceinline__ s16x4 vtr(lds_cptr p){ return __builtin_bit_cast(s16x4,__builtin_amdgcn_ds_read_tr16_b64_v4i16((__attribute__((address_space(3))) v4i16_t*)p)); }
__device__ __forceinline__ float rowmax(const f32x16&p0,const f32x16&p1){
  float a=max3f(p0[0],p0[1],p1[0]),b=max3f(p0[2],p0[3],p1[1]);a=max3f(a,p1[2],p1[3]);
  #pragma unroll
  for(int r=4;r<16;r+=4){a=max3f(a,p0[r],p0[r+1]);b=max3f(b,p0[r+2],p0[r+3]);a=max3f(a,p1[r],p1[r+1]);b=max3f(b,p1[r+2],p1[r+3]);}
  const float m=max2f(a,b);
  auto rr=__builtin_amdgcn_permlane32_swap(__float_as_uint(m),__float_as_uint(m),false,false);
  return max2f(__uint_as_float(rr[0]),__uint_as_float(rr[1]));
}
__device__ __forceinline__ void pv(f32x16*o,int vb,bf16x8 pa0,bf16x8 pa1,bf16x8 pa2,bf16x8 pa3){
  #pragma unroll
  for(int d0=0;d0<2;++d0){s16x4 lo[4],hi[4];
    #pragma unroll
    for(int ks=0;ks<4;++ks){
      asm volatile("ds_read_b64_tr_b16 %0,%1 offset:%c2":"=&v"(lo[ks]):"v"(vb),"i"(d0*4096+ks*1024):"memory");
      asm volatile("ds_read_b64_tr_b16 %0,%1 offset:%c2":"=&v"(hi[ks]):"v"(vb),"i"(d0*4096+ks*1024+512):"memory");}
    asm volatile("s_waitcnt lgkmcnt(0)":::"memory");SBAR();
    #define PK(k) (bf16x8){lo[k][0],lo[k][1],lo[k][2],lo[k][3],hi[k][0],hi[k][1],hi[k][2],hi[k][3]}
    o[d0]=__builtin_amdgcn_mfma_f32_32x32x16_bf16(pa0,PK(0),o[d0],0,0,0);
    o[d0]=__builtin_amdgcn_mfma_f32_32x32x16_bf16(pa1,PK(1),o[d0],0,0,0);
    o[d0]=__builtin_amdgcn_mfma_f32_32x32x16_bf16(pa2,PK(2),o[d0],0,0,0);
    o[d0]=__builtin_amdgcn_mfma_f32_32x32x16_bf16(pa3,PK(3),o[d0],0,0,0);
    #undef PK
  }
}


typedef unsigned u32x2 __attribute__((ext_vector_type(2)));
__device__ __forceinline__ void split3(float v,unsigned&h16,unsigned&m16,unsigned&l16){
  const unsigned uh=__float_as_uint(v)&0xffff0000u; const float r1=v-__uint_as_float(uh);
  const unsigned um=__float_as_uint(r1)&0xffff0000u; const float r2=r1-__uint_as_float(um);
  const unsigned ul=__float_as_uint(r2); h16=uh>>16; m16=um>>16; l16=(ul+0x7fffu+((ul>>16)&1u))>>16;
}
__device__ __forceinline__ bf16x8 make_qx(float qc){ unsigned h,m,l; split3(qc,h,m,l); const u32x4 w={0x3f803f80u,0x3f80u|(h<<16),m|(l<<16),0u}; return __builtin_bit_cast(bf16x8,w); }
__device__ __forceinline__ void dmask(f32x16&p0,f32x16&p1,int jb,int wid,int r32,int hi,float slope2){
  asm volatile("":"+v"(r32),"+v"(hi));
  const int dj=wid>>1, qrel=32*(wid&1)+r32; const float slope2x2=2.f*slope2;
  if(jb>dj){
    #pragma unroll
    for(int r=0;r<16;++r){p0[r]=-INFINITY;p1[r]=-INFINITY;}
  } else if(jb==dj){
    #pragma unroll
    for(int r=0;r<16;++r){const int kv=4*hi+(r&3)+8*(r>>2); if(kv>qrel)p0[r]-=slope2x2*(float)(kv-qrel); if(kv+32>qrel)p1[r]-=slope2x2*(float)(kv+32-qrel);}
  }
}

template<int MODE> __device__ __forceinline__ int attn_jmin(int qb,float bound,const float*__restrict__ cumf,float slope2,int lane){
  const int NTt=4*qb+4, q0=256*qb; bool negl=false;
  if(lane<NTt-4){ const float bias=(MODE==0)?((cumf[q0]-cumf[64*lane+63])*1.4426950408889634f):(-slope2*(float)(q0-(64*lane+63))); negl=(bound+bias)<-160.f; }
  const unsigned long long m=__ballot(negl); const int n=(m==~0ull)?64:(__ffsll((long long)~m)-1);
  return n&~1;
}
template<int MODE,int THRL> __device__ __forceinline__ void attn_pass(int qb,int jmin,const bf16*Qh,const bf16*__restrict__ Kh0,const bf16*__restrict__ Vh0,const float*__restrict__ cumf,float slope2,char*shm,f32x16(&o)[2]){
  const bf16*__restrict__ Kh=Kh0+(long)jmin*KVBLK*DM; const bf16*__restrict__ Vh=Vh0+(long)jmin*KVBLK*DM;
  int tid_l=threadIdx.x; asm volatile("":"+v"(tid_l));
  const int tid=tid_l,lane=tid&63,r32=lane&31,hi=lane>>5; const int wid=__builtin_amdgcn_readfirstlane(tid>>6);
  const int q0=qb*QB;
  const bf16*Qw=Qh+(long)(q0+wid*QBLK)*DM;
  const unsigned lds0=(unsigned)(uintptr_t)shm;
  float*wsf=(float*)(shm+LDS_WS)+wid*64;
  const int NT=(q0+QB)/KVBLK-jmin;
  const lds_cptr shm3=(lds_cptr)shm;
  const __attribute__((address_space(3))) u32x2*featr=(const __attribute__((address_space(3))) u32x2*)(shm3+LDS_FEAT)+lane;
  #define AXF0(f) __builtin_bit_cast(bf16x8,(u32x4){hi?0u:(f).x,hi?0u:(f).y,hi?0u:0x3f803f80u,0u})
  #define AXF1(f) __builtin_bit_cast(bf16x8,(u32x4){hi?(f).x:0u,hi?(f).y:0u,hi?0x3f803f80u:0u,0u})
  const bf16*ksrc=Kh+(long)lane*DM+wid*8;
  const bf16*vsrc=Vh+(long)(16*(wid&3)+(lane>>2))*DM+(wid>>2)*32+(lane&3)*8;
  const unsigned kdst=lds0+LDS_K+wid*1024, vdst=lds0+LDS_V+wid*1024;
  #define DMA_K(t,slot) glds16(ksrc+(long)(t)*KVBLK*DM,(unsigned)__builtin_amdgcn_readfirstlane(kdst+(slot)))
  #define DMA_V(t,slot) glds16(vsrc+(long)(t)*KVBLK*DM,(unsigned)__builtin_amdgcn_readfirstlane(vdst+(slot)))
  const int vb0=(int)(lds0+LDS_V)+((lane>>4)&1)*32+(lane&3)*8+(4*hi+((lane&15)>>2))*64;
  const char*Kbase=shm+LDS_K; bf16x8 kf[8];
  const lds_cptr kp0=shm3+LDS_K+hi*1024+r32*16; const lds_cptr vp0=shm3+LDS_V+((lane>>4)&1)*32+(lane&3)*8+(4*hi+((lane&15)>>2))*64;
  const float qc=(MODE==0)?(cumf[q0+wid*QBLK+r32]*1.4426950408889634f):(-slope2*(float)(q0+wid*QBLK+r32));
  DMA_K(0,0);DMA_V(0,0);DMA_K(1,SLOTB);
  bf16x8 qr[4];
  #pragma unroll
  for(int d0=0;d0<4;++d0)qr[d0]=*reinterpret_cast<const bf16x8*>(&Qw[(long)r32*DM+d0*16+hi*8]);
  { __attribute__((address_space(3))) u32x2*feat=(__attribute__((address_space(3))) u32x2*)(shm+LDS_FEAT);
    if(MODE==0){ float cv[8];
      #pragma unroll
      for(int i=0;i<8;++i){ const int s=tid+NW*64*i; cv[i]=(s<64*NT)?cumf[s+64*jmin]:0.f; }
      #pragma unroll
      for(int i=0;i<8;++i){ const int s=tid+NW*64*i; if(s<64*NT){ unsigned h,m,l; split3(-cv[i]*1.4426950408889634f,h,m,l); u32x2 w; w.x=h|(m<<16); w.y=l|0x3f800000u; feat[s]=w; } } }
    else for(int s=tid;s<64*NT;s+=NW*64){ const int sg=s+64*jmin; const float kx=slope2*(float)sg; unsigned h,m,l; split3(kx,h,m,l); u32x2 w; w.x=h|(m<<16); w.y=l|0x3f800000u; feat[s]=w; } }
  float qcm=qc,l_reg=0.f;o[0]=f32x16{};o[1]=f32x16{};
  bf16x8 qx=make_qx(qcm);
  const int qrel=wid*QBLK+r32;
  #define CMASK(P0,P1,t) do{int jb_=(t)-(NT-4); if(jb_>=0){ if(MODE==0)cmask(P0,P1,jb_,qrel,hi); else dmask(P0,P1,jb_,wid,r32,hi,slope2);} }while(0)
  bool resc=false;
  #define RESC() do{ if(resc){ asm volatile("s_waitcnt lgkmcnt(0)":::"memory"); \
      _Pragma("unroll") for(int d_=0;d_<2;++d_) _Pragma("unroll") for(int r=0;r<16;++r)o[d_][r]*=wsf[crow(r,hi)]; } }while(0)
  f32x16 pA0,pA1,pB0,pB1;
  int sl_prev=0,sl_cur=0,sl_next=SLOTB;
  #define ROT() do{sl_prev=sl_cur;sl_cur=sl_next;sl_next=(sl_next==(NSLOT-1)*SLOTB)?0:sl_next+SLOTB;}while(0)
  DMA_K(2,2*SLOTB);
  WAIT_BAR(3);
  u32x2 fx=featr[0];
  qkt(pA0,pA1,Kbase,qr,AXF0(fx),AXF1(fx),qx,r32,hi);asm volatile("s_nop 15\n\ts_nop 7":"+v"(pA0),"+v"(pA1));CMASK(pA0,pA1,0);
  { const float rm=rowmax(pA0,pA1); const float dl=(rm>(float)THRL)?rm:0.f; qcm-=dl;
    _Pragma("unroll") for(int r=0;r<16;++r){pA0[r]=fsub_s(pA0[r],dl);pA1[r]=fsub_s(pA1[r],dl);}
    qx=make_qx(qcm);
    _Pragma("unroll") for(int r=0;r<16;++r)pA0[r]=__builtin_amdgcn_exp2f(pA0[r]); }
  _Pragma("unroll") for(int r=0;r<16;++r)pA1[r]=__builtin_amdgcn_exp2f(pA1[r]);
  fx=featr[64];
  WAIT_BAR(0);
  DMA_K(3,0);DMA_V(1,SLOTB);
  ROT();
  kload8(kf,kp0+sl_cur);
  WAIT_BAR(2);
  s16x4 vlo[8],vhi[8]; u32x4 pw0,pw1,pw2,pw3;
  #define PKW(P,B) cvtpk_s(P[B],P[B+1])
  #define PAF(k) __builtin_bit_cast(bf16x8,pw##k)
  #define VFR(i) (bf16x8){vlo[i][0],vlo[i][1],vlo[i][2],vlo[i][3],vhi[i][0],vhi[i][1],vhi[i][2],vhi[i][3]}
  #define PIN(x) asm volatile("":"+v"(x))
  #define MX3(a,b,c) __builtin_fmaxf(__builtin_fmaxf((a),(b)),(c))
  #define GAPA(MF,A0,A1,A2,A3,W0,W1,PW) do{ MF; sacc+=A0; sacc+=A1; sacc+=A2; sacc+=A3; PIN(sacc); W0; W1; PIN(PW); SBAR(); }while(0)
  #define EX(v) __builtin_amdgcn_exp2f(v)
  #define GAPB(MF,X,B) do{ MF; X[B]=EX(X[B]); X[B+1]=EX(X[B+1]); X[B+2]=EX(X[B+2]); X[B+3]=EX(X[B+3]); PIN(X); SBAR(); }while(0)
  #define VRD(i) do{ vlo[i]=vtr(vp_+(((i)>>2)*4096+((i)&3)*1024)); vhi[i]=vtr(vp_+(((i)>>2)*4096+((i)&3)*1024+512)); }while(0)
  #define KRD(G,j) do{ if(G){ kload2(kf,kp0+sl_next,j); SBAR(); } }while(0)
  #define STEP(C0,C1,P0,P1,t,GK,GV,GL) do{ SBAR(); \
    const lds_cptr vp_=vp0+sl_prev; \
    { const bf16x8 ax0_=AXF0(fx), ax1_=AXF1(fx); const f32x16 z_=f32x16{}; \
      C0=__builtin_amdgcn_mfma_f32_32x32x16_bf16(ax0_,qx,z_,0,0,0); C1=__builtin_amdgcn_mfma_f32_32x32x16_bf16(ax1_,qx,z_,0,0,0); SBAR(); } \
    VRD(0); SBAR(); float sacc=(P0[0]+P0[1]); \
    GAPA(C0=__builtin_amdgcn_mfma_f32_32x32x16_bf16(kf[0],qr[0],C0,0,0,0), P0[2],P0[3],P0[4],P0[5],     pw0[0]=PKW(P0,0), pw0[1]=PKW(P0,2), pw0); \
    VRD(4); SBAR(); GAPA(C1=__builtin_amdgcn_mfma_f32_32x32x16_bf16(kf[1],qr[0],C1,0,0,0), P0[6],P0[7],P0[8],P0[9],     pw0[2]=PKW(P0,4), pw0[3]=PKW(P0,6), pw0); \
    VRD(1); SBAR(); GAPA(C0=__builtin_amdgcn_mfma_f32_32x32x16_bf16(kf[2],qr[1],C0,0,0,0),   P0[10],P0[11],P0[12],P0[13], pw1[0]=PKW(P0,8), pw1[1]=PKW(P0,10), pw1); \
    VRD(5); SBAR(); GAPA(C1=__builtin_amdgcn_mfma_f32_32x32x16_bf16(kf[3],qr[1],C1,0,0,0),   P0[14],P0[15],P1[0],P1[1],   pw1[2]=PKW(P0,12),pw1[3]=PKW(P0,14), pw1); \
    VRD(2); SBAR(); GAPA(C0=__builtin_amdgcn_mfma_f32_32x32x16_bf16(kf[4],qr[2],C0,0,0,0),   P1[2],P1[3],P1[4],P1[5],     pw2[0]=PKW(P1,0), pw2[1]=PKW(P1,2), pw2); \
    VRD(6); SBAR(); GAPA(C1=__builtin_amdgcn_mfma_f32_32x32x16_bf16(kf[5],qr[2],C1,0,0,0),   P1[6],P1[7],P1[8],P1[9],     pw2[2]=PKW(P1,4), pw2[3]=PKW(P1,6), pw2); \
    VRD(3); SBAR(); GAPA(C0=__builtin_amdgcn_mfma_f32_32x32x16_bf16(kf[6],qr[3],C0,0,0,0),   P1[10],P1[11],P1[12],P1[13], pw3[0]=PKW(P1,8), pw3[1]=PKW(P1,10), pw3); \
    VRD(7); SBAR(); GAPA(C1=__builtin_amdgcn_mfma_f32_32x32x16_bf16(kf[7],qr[3],C1,0,0,0),   P1[14],P1[15],0.f,0.f,       pw3[2]=PKW(P1,12),pw3[3]=PKW(P1,14), pw3); \
    l_reg+=sacc; \
    if(GK){DMA_K((t)+3,sl_cur);} if(GV){DMA_V((t)+1,sl_next);} \
    CMASK(C0,C1,t); \
    { float a=MX3(C0[0],C0[1],C1[0]),b=MX3(C0[2],C0[3],C1[1]); a=MX3(a,C1[2],C1[3]); \
      _Pragma("unroll") for(int r=4;r<16;r+=4){a=MX3(a,C0[r],C0[r+1]);b=MX3(b,C0[r+2],C0[r+3]);a=MX3(a,C1[r],C1[r+1]);b=MX3(b,C1[r+2],C1[r+3]);} \
      float rm=__builtin_fmaxf(a,b); { auto rr=__builtin_amdgcn_permlane32_swap(__float_as_uint(rm),__float_as_uint(rm),false,false); rm=__builtin_fmaxf(__uint_as_float(rr[0]),__uint_as_float(rr[1])); } \
      resc=false; \
      if(__builtin_expect(__any(rm>(float)THRL),0)){ const float dl=__builtin_fmaxf(rm,0.f); qcm-=dl; \
        _Pragma("unroll") for(int r=0;r<16;++r){C0[r]-=dl;C1[r]-=dl;} \
        qx=make_qx(qcm); \
        const float f=__builtin_amdgcn_exp2f(-dl); l_reg*=f; if(hi==0)wsf[r32]=f; resc=true; } } \
    SBAR(); \
    GAPB(o[0]=__builtin_amdgcn_mfma_f32_32x32x16_bf16(PAF(0),VFR(0),o[0],0,0,0), C0,0); \
    GAPB(o[1]=__builtin_amdgcn_mfma_f32_32x32x16_bf16(PAF(0),VFR(4),o[1],0,0,0), C0,4); \
    KRD(GL,0); GAPB(o[0]=__builtin_amdgcn_mfma_f32_32x32x16_bf16(PAF(1),VFR(1),o[0],0,0,0), C0,8); \
    KRD(GL,1); GAPB(o[1]=__builtin_amdgcn_mfma_f32_32x32x16_bf16(PAF(1),VFR(5),o[1],0,0,0), C0,12); \
    KRD(GL,2); GAPB(o[0]=__builtin_amdgcn_mfma_f32_32x32x16_bf16(PAF(2),VFR(2),o[0],0,0,0), C1,0); \
    KRD(GL,3); GAPB(o[1]=__builtin_amdgcn_mfma_f32_32x32x16_bf16(PAF(2),VFR(6),o[1],0,0,0), C1,4); \
    if(GL){ fx=featr[64*((t)+1)]; SBAR(); } \
    GAPB(o[0]=__builtin_amdgcn_mfma_f32_32x32x16_bf16(PAF(3),VFR(3),o[0],0,0,0), C1,8); \
    GAPB(o[1]=__builtin_amdgcn_mfma_f32_32x32x16_bf16(PAF(3),VFR(7),o[1],0,0,0), C1,12); \
    }while(0)
  int t=1;
  #undef CMASK
  #define CMASK(P0,P1,t) do{}while(0)
  for(;t+5<NT;t+=2){
    STEP(pB0,pB1,pA0,pA1,t,true,true,true);     WAIT_BAR(2); RESC(); ROT();
    STEP(pA0,pA1,pB0,pB1,t+1,true,true,true);   WAIT_BAR(2); RESC(); ROT();
  }
  #undef CMASK
  #define CMASK(P0,P1,t) do{int jb_=(t)-(NT-4); if(jb_>=0){ if(MODE==0)cmask(P0,P1,jb_,qrel,hi); else dmask(P0,P1,jb_,wid,r32,hi,slope2);} }while(0)
  #define ENDW(tt) do{ if((tt)+3<NT){WAIT_BAR(2);} else if((tt)+2<NT){WAIT_BAR(1);} else {WAIT_BAR(0);} }while(0)
  for(;t+1<NT;t+=2){
    STEP(pB0,pB1,pA0,pA1,t,(t+3<NT),(t+1<NT),(t+1<NT));       ENDW(t);   RESC(); ROT();
    STEP(pA0,pA1,pB0,pB1,t+1,(t+4<NT),(t+2<NT),(t+2<NT));     ENDW(t+1); RESC(); ROT();
  }
  STEP(pB0,pB1,pA0,pA1,NT-1,false,false,false); RESC();
  { float sacc=pB0[0]+pB0[1]; _Pragma("unroll") for(int r=2;r<16;++r)sacc+=pB0[r]; _Pragma("unroll") for(int r=0;r<16;++r)sacc+=pB1[r]; l_reg+=sacc;
    pw0=(u32x4){PKW(pB0,0),PKW(pB0,2),PKW(pB0,4),PKW(pB0,6)};pw1=(u32x4){PKW(pB0,8),PKW(pB0,10),PKW(pB0,12),PKW(pB0,14)};pw2=(u32x4){PKW(pB1,0),PKW(pB1,2),PKW(pB1,4),PKW(pB1,6)};pw3=(u32x4){PKW(pB1,8),PKW(pB1,10),PKW(pB1,12),PKW(pB1,14)};
    SBAR(); pv(o,vb0+sl_cur,PAF(0),PAF(1),PAF(2),PAF(3)); }
  #undef PKW
  #undef PAF
  #undef VFR
  #undef PIN
  #undef MX3
  #undef GAPA
  #undef GAPB
  #undef EX
  #undef VRD
  #undef KRD
  #undef STEP
  #undef ENDW
  {auto rr=__builtin_amdgcn_permlane32_swap(__float_as_uint(l_reg),__float_as_uint(l_reg),false,false);l_reg=__uint_as_float(rr[0])+__uint_as_float(rr[1]);}
  if(hi==0)wsf[32+r32]=l_reg;asm volatile("s_waitcnt lgkmcnt(0)":::"memory");
  #pragma unroll
  for(int r=0;r<16;++r){const float rli=__builtin_amdgcn_rcpf(wsf[32+crow(r,hi)]); o[0][r]*=rli; o[1][r]*=rli;}
  asm volatile("s_waitcnt lgkmcnt(0)\n\ts_barrier":::"memory");
  #undef DMA_K
  #undef DMA_V
  #undef CMASK
  #undef RESC
  #undef ROT
  #undef AXF0
  #undef AXF1
}
constexpr int D2_K=0, D2_V=4*8192, D2_VS=16384, D2_WS=D2_V+3*D2_VS, D2_FEAT=D2_WS+NW*64*4, D2_BYTES=D2_FEAT+SEQ*8;
template<int THRL> __device__ __forceinline__ void attn_pass_dv128(int qb,int jmin,const bf16*Qh,const bf16*__restrict__ Kh0,const bf16*__restrict__ Vh0,float slope2,char*shm,f32x16(&o)[4]){
  constexpr int MODE=1; const float*cumf=nullptr;
  const bf16*__restrict__ Kh=Kh0+(long)jmin*KVBLK*DM; const bf16*__restrict__ Vh=Vh0+(long)jmin*KVBLK*DM;
  int tid_l=threadIdx.x; asm volatile("":"+v"(tid_l));
  const int tid=tid_l,lane=tid&63,r32=lane&31,hi=lane>>5; const int wid=__builtin_amdgcn_readfirstlane(tid>>6);
  const int q0=qb*QB;
  const bf16*Qw=Qh+(long)(q0+wid*QBLK)*DM;
  const unsigned lds0=(unsigned)(uintptr_t)shm;
  float*wsf=(float*)(shm+D2_WS)+wid*64;
  const int NT=(q0+QB)/KVBLK-jmin;
  const lds_cptr shm3=(lds_cptr)shm;
  const __attribute__((address_space(3))) u32x2*featr=(const __attribute__((address_space(3))) u32x2*)(shm3+D2_FEAT)+lane;
  #define AXF0(f) __builtin_bit_cast(bf16x8,(u32x4){hi?0u:(f).x,hi?0u:(f).y,hi?0u:0x3f803f80u,0u})
  #define AXF1(f) __builtin_bit_cast(bf16x8,(u32x4){hi?(f).x:0u,hi?(f).y:0u,hi?0x3f803f80u:0u,0u})
  const bf16*ksrc=Kh+(long)lane*DM+wid*8;
  const bf16*vsrc=Vh+(long)(16*(wid&3)+(lane>>2))*DM+(wid>>2)*32+(lane&3)*8;
  const unsigned kdst=lds0+D2_K+wid*1024, vdst=lds0+D2_V+wid*1024;
  #define DMA_K(t,slot) glds16(ksrc+(long)(t)*KVBLK*DM,(unsigned)__builtin_amdgcn_readfirstlane(kdst+(slot)))
  #define DMA_V(t,slot) do{ glds16(vsrc+(long)(t)*KVBLK*DM,(unsigned)__builtin_amdgcn_readfirstlane(vdst+(slot))); glds16(vsrc+(long)(t)*KVBLK*DM+64,(unsigned)__builtin_amdgcn_readfirstlane(vdst+(slot)+8192)); }while(0)
  const int vb0=(int)(lds0+D2_V)+((lane>>4)&1)*32+(lane&3)*8+(4*hi+((lane&15)>>2))*64;
  const char*Kbase=shm+D2_K;
  const lds_cptr kp0=shm3+D2_K+hi*1024+r32*16; const lds_cptr vp0=shm3+D2_V+((lane>>4)&1)*32+(lane&3)*8+(4*hi+((lane&15)>>2))*64;
  const float qc=(MODE==0)?(cumf[q0+wid*QBLK+r32]*1.4426950408889634f):(-slope2*(float)(q0+wid*QBLK+r32));
  DMA_K(0,0);DMA_V(0,0);DMA_K(1,8192);
  bf16x8 qr[4];
  #pragma unroll
  for(int d0=0;d0<4;++d0)qr[d0]=*reinterpret_cast<const bf16x8*>(&Qw[(long)r32*DM+d0*16+hi*8]);
  { __attribute__((address_space(3))) u32x2*feat=(__attribute__((address_space(3))) u32x2*)(shm+D2_FEAT);
    for(int s=tid;s<64*NT;s+=NW*64){ const int sg=s+64*jmin; const float kx=(MODE==0)?(-cumf[sg]*1.4426950408889634f):(slope2*(float)sg); unsigned h,m,l; split3(kx,h,m,l); u32x2 w; w.x=h|(m<<16); w.y=l|0x3f800000u; feat[s]=w; } }
  float qcm=qc,l_reg=0.f;o[0]=f32x16{};o[1]=f32x16{};o[2]=f32x16{};o[3]=f32x16{};
  bf16x8 qx=make_qx(qcm);
  const int qrel=wid*QBLK+r32;
  #define CMASK(P0,P1,t) do{int jb_=(t)-(NT-4); if(jb_>=0){ if(MODE==0)cmask(P0,P1,jb_,qrel,hi); else dmask(P0,P1,jb_,wid,r32,hi,slope2);} }while(0)
  bool resc=false;
  #define RESC() do{ if(resc){ asm volatile("s_waitcnt lgkmcnt(0)":::"memory"); \
      _Pragma("unroll") for(int d_=0;d_<4;++d_) _Pragma("unroll") for(int r=0;r<16;++r)o[d_][r]*=wsf[crow(r,hi)]; } }while(0)
  f32x16 pA0,pA1,pB0,pB1;
  int sl_prev=0,sl_cur=0,sl_next=D2_VS;
  #define ROT() do{sl_prev=sl_cur;sl_cur=sl_next;sl_next=(sl_next==2*D2_VS)?0:sl_next+D2_VS;}while(0)
  #define KSL(t) (((t)&3)*8192)
  DMA_K(2,2*8192);
  WAIT_BAR(4);
  u32x2 fx=featr[0];
  qkt(pA0,pA1,Kbase,qr,AXF0(fx),AXF1(fx),qx,r32,hi);asm volatile("s_nop 15\n\ts_nop 7":"+v"(pA0),"+v"(pA1));CMASK(pA0,pA1,0);
  { const float rm=rowmax(pA0,pA1); const float dl=(rm>(float)THRL)?rm:0.f; qcm-=dl;
    _Pragma("unroll") for(int r=0;r<16;++r){pA0[r]=fsub_s(pA0[r],dl);pA1[r]=fsub_s(pA1[r],dl);}
    qx=make_qx(qcm);
    _Pragma("unroll") for(int r=0;r<16;++r)pA0[r]=__builtin_amdgcn_exp2f(pA0[r]); }
  _Pragma("unroll") for(int r=0;r<16;++r)pA1[r]=__builtin_amdgcn_exp2f(pA1[r]);
  fx=featr[64];
  WAIT_BAR(0);
  DMA_K(3,3*8192);DMA_V(1,D2_VS);
  ROT();
  s16x4 vlo[8],vhi[8]; u32x4 pw0,pw1,pw2,pw3;
  #define PKW(P,B) cvtpk_s(P[B],P[B+1])
  #define PAF(k) __builtin_bit_cast(bf16x8,pw##k)
  #define VFR(i) (bf16x8){vlo[i][0],vlo[i][1],vlo[i][2],vlo[i][3],vhi[i][0],vhi[i][1],vhi[i][2],vhi[i][3]}
  #define PIN(x) asm volatile("":"+v"(x))
  #define MX3(a,b,c) __builtin_fmaxf(__builtin_fmaxf((a),(b)),(c))
  #define GAPA(MF,A0,A1,A2,A3,W0,W1,PW) do{ MF; sacc+=A0; sacc+=A1; sacc+=A2; sacc+=A3; PIN(sacc); W0; W1; PIN(PW); SBAR(); }while(0)
  #define EX(v) __builtin_amdgcn_exp2f(v)
  #define GAPB(MF,X,B) do{ MF; X[B]=EX(X[B]); X[B+1]=EX(X[B+1]); X[B+2]=EX(X[B+2]); X[B+3]=EX(X[B+3]); PIN(X); SBAR(); }while(0)
  #define GAPB2(MF,X,B) do{ MF; X[B]=EX(X[B]); X[B+1]=EX(X[B+1]); PIN(X); SBAR(); }while(0)
  #define VRD(i) do{ vlo[i]=vtr(vp_+(((i)>>2)*4096+((i)&3)*1024)); vhi[i]=vtr(vp_+(((i)>>2)*4096+((i)&3)*1024+512)); }while(0)
  #define VRC(i) do{ vlo[i]=vtr(vp_+8192+(((i)>>2)*4096+((i)&3)*1024)); vhi[i]=vtr(vp_+8192+(((i)>>2)*4096+((i)&3)*1024+512)); }while(0)
  #define KF(j) do{ kA[(j)&1]=*(const __attribute__((address_space(3))) bf16x8*)(kq_+(j)*2048); kB[(j)&1]=*(const __attribute__((address_space(3))) bf16x8*)(kq_+(j)*2048+512); }while(0)
  #define STEP(C0,C1,P0,P1,t,GK,GV,GL) do{ SBAR(); \
    const lds_cptr vp_=vp0+sl_prev; const lds_cptr kq_=kp0+KSL(t); bf16x8 kA[2],kB[2]; \
    KF(0); SBAR(); \
    { const bf16x8 ax0_=AXF0(fx), ax1_=AXF1(fx); const f32x16 z_=f32x16{}; \
      C0=__builtin_amdgcn_mfma_f32_32x32x16_bf16(ax0_,qx,z_,0,0,0); C1=__builtin_amdgcn_mfma_f32_32x32x16_bf16(ax1_,qx,z_,0,0,0); SBAR(); } \
    KF(1); VRD(0); SBAR(); float sacc=(P0[0]+P0[1]); \
    GAPA(C0=__builtin_amdgcn_mfma_f32_32x32x16_bf16(kA[0],qr[0],C0,0,0,0), P0[2],P0[3],P0[4],P0[5],     pw0[0]=PKW(P0,0), pw0[1]=PKW(P0,2), pw0); \
    VRD(4); SBAR(); GAPA(C1=__builtin_amdgcn_mfma_f32_32x32x16_bf16(kB[0],qr[0],C1,0,0,0), P0[6],P0[7],P0[8],P0[9],     pw0[2]=PKW(P0,4), pw0[3]=PKW(P0,6), pw0); \
    KF(2); VRD(1); SBAR(); GAPA(C0=__builtin_amdgcn_mfma_f32_32x32x16_bf16(kA[1],qr[1],C0,0,0,0),   P0[10],P0[11],P0[12],P0[13], pw1[0]=PKW(P0,8), pw1[1]=PKW(P0,10), pw1); \
    VRD(5); SBAR(); GAPA(C1=__builtin_amdgcn_mfma_f32_32x32x16_bf16(kB[1],qr[1],C1,0,0,0),   P0[14],P0[15],P1[0],P1[1],   pw1[2]=PKW(P0,12),pw1[3]=PKW(P0,14), pw1); \
    KF(3); VRD(2); SBAR(); GAPA(C0=__builtin_amdgcn_mfma_f32_32x32x16_bf16(kA[0],qr[2],C0,0,0,0),   P1[2],P1[3],P1[4],P1[5],     pw2[0]=PKW(P1,0), pw2[1]=PKW(P1,2), pw2); \
    VRD(6); SBAR(); GAPA(C1=__builtin_amdgcn_mfma_f32_32x32x16_bf16(kB[0],qr[2],C1,0,0,0),   P1[6],P1[7],P1[8],P1[9],     pw2[2]=PKW(P1,4), pw2[3]=PKW(P1,6), pw2); \
    VRD(3); SBAR(); GAPA(C0=__builtin_amdgcn_mfma_f32_32x32x16_bf16(kA[1],qr[3],C0,0,0,0),   P1[10],P1[11],P1[12],P1[13], pw3[0]=PKW(P1,8), pw3[1]=PKW(P1,10), pw3); \
    VRD(7); SBAR(); GAPA(C1=__builtin_amdgcn_mfma_f32_32x32x16_bf16(kB[1],qr[3],C1,0,0,0),   P1[14],P1[15],0.f,0.f,       pw3[2]=PKW(P1,12),pw3[3]=PKW(P1,14), pw3); \
    l_reg+=sacc; \
    if(GK){DMA_K((t)+3,KSL((t)+3));} if(GV){DMA_V((t)+1,sl_next);} \
    CMASK(C0,C1,t); \
    { float a=MX3(C0[0],C0[1],C1[0]),b=MX3(C0[2],C0[3],C1[1]); a=MX3(a,C1[2],C1[3]); \
      _Pragma("unroll") for(int r=4;r<16;r+=4){a=MX3(a,C0[r],C0[r+1]);b=MX3(b,C0[r+2],C0[r+3]);a=MX3(a,C1[r],C1[r+1]);b=MX3(b,C1[r+2],C1[r+3]);} \
      float rm=__builtin_fmaxf(a,b); { auto rr=__builtin_amdgcn_permlane32_swap(__float_as_uint(rm),__float_as_uint(rm),false,false); rm=__builtin_fmaxf(__uint_as_float(rr[0]),__uint_as_float(rr[1])); } \
      resc=false; \
      if(__builtin_expect(__any(rm>(float)THRL),0)){ const float dl=__builtin_fmaxf(rm,0.f); qcm-=dl; \
        _Pragma("unroll") for(int r=0;r<16;++r){C0[r]-=dl;C1[r]-=dl;} \
        qx=make_qx(qcm); \
        const float f=__builtin_amdgcn_exp2f(-dl); l_reg*=f; if(hi==0)wsf[r32]=f; resc=true; } } \
    SBAR(); \
    GAPB2(o[0]=__builtin_amdgcn_mfma_f32_32x32x16_bf16(PAF(0),VFR(0),o[0],0,0,0), C0,0); \
    GAPB2(o[1]=__builtin_amdgcn_mfma_f32_32x32x16_bf16(PAF(0),VFR(4),o[1],0,0,0), C0,2); \
    GAPB2(o[0]=__builtin_amdgcn_mfma_f32_32x32x16_bf16(PAF(1),VFR(1),o[0],0,0,0), C0,4); \
    GAPB2(o[1]=__builtin_amdgcn_mfma_f32_32x32x16_bf16(PAF(1),VFR(5),o[1],0,0,0), C0,6); \
    GAPB2(o[0]=__builtin_amdgcn_mfma_f32_32x32x16_bf16(PAF(2),VFR(2),o[0],0,0,0), C0,8); \
    GAPB2(o[1]=__builtin_amdgcn_mfma_f32_32x32x16_bf16(PAF(2),VFR(6),o[1],0,0,0), C0,10); \
    if(GL){ fx=featr[64*((t)+1)]; SBAR(); } \
    GAPB2(o[0]=__builtin_amdgcn_mfma_f32_32x32x16_bf16(PAF(3),VFR(3),o[0],0,0,0), C0,12); \
    GAPB2(o[1]=__builtin_amdgcn_mfma_f32_32x32x16_bf16(PAF(3),VFR(7),o[1],0,0,0), C0,14); \
      \
    VRC(0); VRC(4); VRC(1); VRC(5); SBAR(); \
    VRC(2); VRC(6); GAPB2(o[2]=__builtin_amdgcn_mfma_f32_32x32x16_bf16(PAF(0),VFR(0),o[2],0,0,0), C1,0); \
    VRC(3); VRC(7); GAPB2(o[3]=__builtin_amdgcn_mfma_f32_32x32x16_bf16(PAF(0),VFR(4),o[3],0,0,0), C1,2); \
    GAPB2(o[2]=__builtin_amdgcn_mfma_f32_32x32x16_bf16(PAF(1),VFR(1),o[2],0,0,0), C1,4); \
    GAPB2(o[3]=__builtin_amdgcn_mfma_f32_32x32x16_bf16(PAF(1),VFR(5),o[3],0,0,0), C1,6); \
    GAPB2(o[2]=__builtin_amdgcn_mfma_f32_32x32x16_bf16(PAF(2),VFR(2),o[2],0,0,0), C1,8); \
    GAPB2(o[3]=__builtin_amdgcn_mfma_f32_32x32x16_bf16(PAF(2),VFR(6),o[3],0,0,0), C1,10); \
    GAPB2(o[2]=__builtin_amdgcn_mfma_f32_32x32x16_bf16(PAF(3),VFR(3),o[2],0,0,0), C1,12); \
    GAPB2(o[3]=__builtin_amdgcn_mfma_f32_32x32x16_bf16(PAF(3),VFR(7),o[3],0,0,0), C1,14); \
    }while(0)
  int t=1;
  #undef CMASK
  #define CMASK(P0,P1,t) do{}while(0)
  for(;t+5<NT;t+=2){
    STEP(pB0,pB1,pA0,pA1,t,true,true,true);     WAIT_BAR(3); RESC(); ROT();
    STEP(pA0,pA1,pB0,pB1,t+1,true,true,true);   WAIT_BAR(3); RESC(); ROT();
  }
  #undef CMASK
  #define CMASK(P0,P1,t) do{int jb_=(t)-(NT-4); if(jb_>=0){ if(MODE==0)cmask(P0,P1,jb_,qrel,hi); else dmask(P0,P1,jb_,wid,r32,hi,slope2);} }while(0)
  #define ENDW(tt) do{ if((tt)+3<NT){WAIT_BAR(3);} else if((tt)+2<NT){WAIT_BAR(2);} else {WAIT_BAR(0);} }while(0)
  for(;t+1<NT;t+=2){
    STEP(pB0,pB1,pA0,pA1,t,(t+3<NT),(t+1<NT),(t+1<NT));       ENDW(t);   RESC(); ROT();
    STEP(pA0,pA1,pB0,pB1,t+1,(t+4<NT),(t+2<NT),(t+2<NT));     ENDW(t+1); RESC(); ROT();
  }
  STEP(pB0,pB1,pA0,pA1,NT-1,false,false,false); RESC();
  { float sacc=pB0[0]+pB0[1]; _Pragma("unroll") for(int r=2;r<16;++r)sacc+=pB0[r]; _Pragma("unroll") for(int r=0;r<16;++r)sacc+=pB1[r]; l_reg+=sacc;
    pw0=(u32x4){PKW(pB0,0),PKW(pB0,2),PKW(pB0,4),PKW(pB0,6)};pw1=(u32x4){PKW(pB0,8),PKW(pB0,10),PKW(pB0,12),PKW(pB0,14)};pw2=(u32x4){PKW(pB1,0),PKW(pB1,2),PKW(pB1,4),PKW(pB1,6)};pw3=(u32x4){PKW(pB1,8),PKW(pB1,10),PKW(pB1,12),PKW(pB1,14)};
    SBAR(); pv(o,vb0+sl_cur,PAF(0),PAF(1),PAF(2),PAF(3)); pv(o+2,vb0+sl_cur+8192,PAF(0),PAF(1),PAF(2),PAF(3)); }
  #undef PKW
  #undef PAF
  #undef VFR
  #undef PIN
  #undef MX3
  #undef GAPA
  #undef GAPB
  #undef GAPB2
  #undef EX
  #undef VRD
  #undef KF
  #undef VRC
  #undef STEP
  #undef ENDW
  {auto rr=__builtin_amdgcn_permlane32_swap(__float_as_uint(l_reg),__float_as_uint(l_reg),false,false);l_reg=__uint_as_float(rr[0])+__uint_as_float(rr[1]);}
  if(hi==0)wsf[32+r32]=l_reg;asm volatile("s_waitcnt lgkmcnt(0)":::"memory");
  #pragma unroll
  for(int r=0;r<16;++r){const float rli=__builtin_amdgcn_rcpf(wsf[32+crow(r,hi)]); o[0][r]*=rli; o[1][r]*=rli; o[2][r]*=rli; o[3][r]*=rli;}
  asm volatile("s_waitcnt lgkmcnt(0)\n\ts_barrier":::"memory");
  #undef DMA_K
  #undef DMA_V
  #undef CMASK
  #undef RESC
  #undef ROT
  #undef KSL
  #undef AXF0
  #undef AXF1
}
__device__ __forceinline__ void store_tile_bf16_at(const f32x16*o,bf16*dst,int pitch,char*shm,int stage,int wid,int lane){
  const int r32=lane&31,hi=lane>>5;
  bf16*stg=(bf16*)(shm+stage)+wid*2048;
  #pragma unroll
  for(int r=0;r<16;++r){const int orow=crow(r,hi);
    #pragma unroll
    for(int d0=0;d0<2;++d0)stg[orow*64+d0*32+r32]=__float2bfloat16(o[d0][r]);}
  asm volatile("s_waitcnt lgkmcnt(0)":::"memory");
  #pragma unroll
  for(int i=0;i<4;++i){const int row=i*8+(lane>>3),ch=lane&7; const u32x4 v=*(const u32x4*)(stg+row*64+ch*8); *(u32x4*)(dst+(long)row*pitch+ch*8)=v;}
  asm volatile("s_waitcnt lgkmcnt(0)":::"memory");
}
__device__ __forceinline__ void store_tile_bf16(const f32x16(&o)[2],bf16*dst,int pitch,char*shm,int wid,int lane){
  const int r32=lane&31,hi=lane>>5;
  bf16*stg=(bf16*)(shm+LDS_OST)+wid*2048;
  #pragma unroll
  for(int r=0;r<16;++r){const int orow=crow(r,hi);
    #pragma unroll
    for(int d0=0;d0<2;++d0)stg[orow*64+d0*32+r32]=__float2bfloat16(o[d0][r]);}
  asm volatile("s_waitcnt lgkmcnt(0)":::"memory");
  #pragma unroll
  for(int i=0;i<4;++i){const int row=i*8+(lane>>3),ch=lane&7; const u32x4 v=*(const u32x4*)(stg+row*64+ch*8); *(u32x4*)(dst+(long)row*pitch+ch*8)=v;}
  asm volatile("s_waitcnt lgkmcnt(0)":::"memory");
}
constexpr int ATTN_LDS_BYTES=LDS_BYTES;
#undef SBAR
#undef WAIT_BAR
}

namespace cg = cooperative_groups;
constexpr int BATCH = 16, SEQ = 4096, D = 1024, NTOK = BATCH * SEQ;
constexpr int FH = 8, DH = 4, HD = 64;
constexpr int NPROJ = 3072, IN_COLS = 3080;
constexpr int PH = 8, NKEY = 128, TOPK = 16, PQ = 2048, NEXP = 16384;
constexpr float RMS_EPS = 1e-6f, LOG2E = 1.4426950408889634f, C2 = 0.125f * LOG2E;
constexpr float LAMBDA_INIT = 0.2f;
constexpr int COL_QA = 0, COL_KA = 512, COL_VA = 1024, COL_QB = 1536, COL_KB = 2048, COL_VB = 2560;
constexpr int NWAVES = 8, NTHR = 512;

typedef unsigned short bf16_t;
typedef float f32x4v __attribute__((ext_vector_type(4)));
#define LAS __attribute__((address_space(3)))

constexpr size_t MiB = 1u << 20;
constexpr size_t WS_CTL = 0;
constexpr size_t WS_WIN = 2 * MiB;
constexpr size_t WS_WOUT = 8 * MiB;
constexpr size_t WS_WQ = 10 * MiB;
constexpr size_t WS_LOGF = 16 * MiB;
constexpr size_t WS_CUM = 18 * MiB;
constexpr size_t WS_XN = 96 * MiB;
constexpr size_t WS_PROJ = 224 * MiB;
constexpr size_t WS_Y = 224 * MiB;
constexpr size_t WS_QP = 352 * MiB;
constexpr size_t WS_MIXED = 608 * MiB;
constexpr size_t WS_END = 736 * MiB;
constexpr int LDS_BYTES = 147456;

__device__ __forceinline__ unsigned f2bf(float f) { unsigned u = __builtin_bit_cast(unsigned, f); return (u + 0x7fffu + ((u >> 16) & 1u)) >> 16; }
__device__ __forceinline__ unsigned pk2(float lo, float hi) { return f2bf(lo) | (f2bf(hi) << 16); }
__device__ __forceinline__ float bflo(unsigned w) { return __builtin_bit_cast(float, w << 16); }
__device__ __forceinline__ float bfhi(unsigned w) { return __builtin_bit_cast(float, w & 0xffff0000u); }
__device__ __forceinline__ float wave_sum(float v) {
#pragma unroll
    for (int o = 1; o < 64; o <<= 1) v += __shfl_xor(v, o);
    return v;
}

struct Ctx { int tid, lane, wave, vcu, G, gw, NGW; LAS unsigned char* lds; unsigned char* lds_gen; };

__device__ __forceinline__ void p0_transpose_item(const float* W, int ldw, int K, int ncols, bf16_t* WT, int row_off, float scale, const float* ksc, LAS float* scr, int item, int lane) {
    const int nblk = ncols / 32, kb = item / nblk, nb = item % nblk, k0 = 64 * kb, n0 = 32 * nb;
#pragma unroll 8
    for (int i = 0; i < 32; ++i) { const int kk = 2 * i + (lane >> 5); scr[kk * 33 + (lane & 31)] = W[(size_t)(k0 + kk) * ldw + n0 + (lane & 31)] * (ksc ? scale * ksc[k0 + kk] : scale); }
    asm volatile("s_waitcnt lgkmcnt(0)" ::: "memory");
    const int c = lane & 7;
#pragma unroll
    for (int j = 0; j < 4; ++j) { const int n = (lane >> 3) + 8 * j; const LAS float* s = scr + (8 * c) * 33 + n;
        uint4 o; o.x = pk2(s[0 * 33], s[1 * 33]); o.y = pk2(s[2 * 33], s[3 * 33]); o.z = pk2(s[4 * 33], s[5 * 33]); o.w = pk2(s[6 * 33], s[7 * 33]);
        *(uint4*)(WT + (size_t)(row_off + n0 + n) * K + k0 + 8 * c) = o; }
    asm volatile("s_waitcnt lgkmcnt(0)" ::: "memory");
}
__device__ __forceinline__ void p0_weights(const Ctx& c, const float* w_in, const float* w_out, const float* w_q, const float* g2, bf16_t* WIN, bf16_t* WOUT, bf16_t* WQ) {
    LAS float* scr = (LAS float*)(c.lds + c.wave * 16384);
    constexpr int KB = D / 64;
    constexpr int I0 = KB * (512 / 32), I1 = KB * (1024 / 32), I2 = I0, I3 = I1, I4 = KB * (D / 32), I5 = KB * (PQ / 32);
    constexpr int NIT = I0 + I1 + I2 + I3 + I4 + I5;
    for (int it = c.gw; it < NIT; it += c.NGW) {
        int r = it;
        if (r < I0) { p0_transpose_item(w_in + 0, IN_COLS, D, 512, WIN, 0, C2, nullptr, scr, r, c.lane); continue; } r -= I0;
        if (r < I1) { p0_transpose_item(w_in + 512, IN_COLS, D, 1024, WIN, 512, 1.f, nullptr, scr, r, c.lane); continue; } r -= I1;
        if (r < I2) { p0_transpose_item(w_in + 1544, IN_COLS, D, 512, WIN, 1536, C2, nullptr, scr, r, c.lane); continue; } r -= I2;
        if (r < I3) { p0_transpose_item(w_in + 2056, IN_COLS, D, 1024, WIN, 2048, 1.f, nullptr, scr, r, c.lane); continue; } r -= I3;
        if (r < I4) { p0_transpose_item(w_out, D, D, D, WOUT, 0, 1.f, nullptr, scr, r, c.lane); continue; } r -= I4;
        p0_transpose_item(w_q, PQ, D, PQ, WQ, 0, 1.f, g2, scr, r, c.lane);
    }
}

__device__ __forceinline__ void rms1_gates_wave(int row0, int step, int lane, const float* __restrict__ x, const float* __restrict__ g1, const float* __restrict__ w_in, const float* __restrict__ b_f,
                                                bf16_t* __restrict__ XN, float* __restrict__ LOGF) {
    f32x4v wg[16][2], gn[4];
#pragma unroll
    for (int j = 0; j < 4; ++j) { gn[j] = ((const f32x4v*)g1)[lane + 64 * j];
#pragma unroll
        for (int e = 0; e < 4; ++e) { const f32x4v* wr = (const f32x4v*)(w_in + (size_t)(4 * lane + 256 * j + e) * IN_COLS + 1536); wg[4 * j + e][0] = wr[0]; wg[4 * j + e][1] = wr[1]; } }
    const float bfl = b_f[lane >> 3];
    f32x4v va[4], vb[4];
    { const f32x4v* xr = (const f32x4v*)(x + (size_t)row0 * D) + lane;
#pragma unroll
      for (int j = 0; j < 4; ++j) va[j] = xr[64 * j];
      const int r1 = (row0 + step < NTOK) ? row0 + step : row0; const f32x4v* xs = (const f32x4v*)(x + (size_t)r1 * D) + lane;
#pragma unroll
      for (int j = 0; j < 4; ++j) vb[j] = xs[64 * j]; }
    const bool b5 = (lane & 32) != 0, b4 = (lane & 16) != 0, b3 = (lane & 8) != 0;
#define RMS1_ROW(BUF, row_) do { const int rr = (row_); \
        f32x4v v[4]; float ss = 0.f; \
        _Pragma("unroll") for (int j = 0; j < 4; ++j) { v[j] = BUF[j]; ss += (v[j].x * v[j].x + v[j].y * v[j].y) + (v[j].z * v[j].z + v[j].w * v[j].w); } \
        { const int rn = (rr + 2 * step < NTOK) ? rr + 2 * step : rr; const f32x4v* xr = (const f32x4v*)(x + (size_t)rn * D) + lane; \
          _Pragma("unroll") for (int j = 0; j < 4; ++j) BUF[j] = xr[64 * j]; } \
        ss = wave_sum(ss); \
        const float rstd = rsqrtf(ss * (1.f / D) + RMS_EPS); \
        f32x4v ga = {0.f, 0.f, 0.f, 0.f}, gb = {0.f, 0.f, 0.f, 0.f}; \
        unsigned long long* o8 = (unsigned long long*)(XN + (size_t)rr * D) + lane; \
        _Pragma("unroll") for (int j = 0; j < 4; ++j) { \
            v[j] = v[j] * rstd * gn[j]; \
            o8[64 * j] = (unsigned long long)pk2(v[j].x, v[j].y) | ((unsigned long long)pk2(v[j].z, v[j].w) << 32); \
            _Pragma("unroll") for (int e = 0; e < 4; ++e) { ga += v[j][e] * wg[4 * j + e][0]; gb += v[j][e] * wg[4 * j + e][1]; } \
        } \
          \
        float h0, h1, h2, h3; \
        { const float s0 = b5 ? ga.x : gb.x, s1 = b5 ? ga.y : gb.y, s2 = b5 ? ga.z : gb.z, s3 = b5 ? ga.w : gb.w; \
          h0 = (b5 ? gb.x : ga.x) + __shfl_xor(s0, 32); h1 = (b5 ? gb.y : ga.y) + __shfl_xor(s1, 32); h2 = (b5 ? gb.z : ga.z) + __shfl_xor(s2, 32); h3 = (b5 ? gb.w : ga.w) + __shfl_xor(s3, 32); } \
        float k0, k1; \
        { const float s0 = b4 ? h0 : h2, s1 = b4 ? h1 : h3; k0 = (b4 ? h2 : h0) + __shfl_xor(s0, 16); k1 = (b4 ? h3 : h1) + __shfl_xor(s1, 16); } \
        float gv; { const float s0 = b3 ? k0 : k1; gv = (b3 ? k1 : k0) + __shfl_xor(s0, 8); } \
        gv += __shfl_xor(gv, 4); gv += __shfl_xor(gv, 2); gv += __shfl_xor(gv, 1); \
        if ((lane & 7) == 0) { \
            const float z = gv + bfl; \
            const float ls = fminf(z, 0.f) - log1pf(expf(-fabsf(z))); \
            const int b = rr / SEQ, t = rr % SEQ; \
            LOGF[((size_t)b * FH + (lane >> 3)) * SEQ + t] = ls; \
        } } while (0)
#pragma unroll 1
    for (int row = row0; row < NTOK; row += 2 * step) {
        RMS1_ROW(va, row);
        if (row + step < NTOK) RMS1_ROW(vb, row + step);
    }
#undef RMS1_ROW
}

__device__ __forceinline__ void cumsum_seq(int bh, int lane, const float* __restrict__ LOGF, float* __restrict__ CUM) {
    const float* src = LOGF + (size_t)bh * SEQ + lane * 64; float* dst = CUM + (size_t)bh * SEQ + lane * 64;
    float loc[64]; float run = 0.f;
#pragma unroll
    for (int i = 0; i < 64; ++i) { run += src[i]; loc[i] = run; }
    float incl = run;
#pragma unroll
    for (int o = 1; o < 64; o <<= 1) { const float t = __shfl_up(incl, o); if (lane >= o) incl += t; }
    const float excl = incl - run;
#pragma unroll
    for (int i = 0; i < 64; ++i) dst[i] = loc[i] + excl;
}

namespace pg8 {
struct EpiBf16RowScale {
    static constexpr bool PERM = true, AFTER_DRAIN = false;
    bf16_t* O; int ldc; const unsigned long long* ss; float inv_n, eps;
    __device__ __forceinline__ void operator()(const f32x4 (&acc)[2][2][4][2], const Unit& u, int wr, int wc, int fr, int fq) const {
        const int row0 = u.pm * BM + wr * 64 + fr, col0 = u.pn * BM + wc * 32 + 8 * fq;
#pragma unroll
        for (int ai = 0; ai < 2; ++ai)
#pragma unroll
            for (int m = 0; m < 4; ++m) { const int row = row0 + ai * HALF + m * 16; const float sc = rsqrtf((float)ss[row] * (inv_n * 5.9604644775390625e-8f) + eps); bf16_t* rowp = O + (size_t)row * ldc + col0;
#pragma unroll
                for (int bj = 0; bj < 2; ++bj) { const f32x4 v0 = acc[ai][bj][m][0] * sc, v1 = acc[ai][bj][m][1] * sc;
                    u32x4 w; w.x = cvt_pk_bf16(v0[0], v0[1]); w.y = cvt_pk_bf16(v0[2], v0[3]); w.z = cvt_pk_bf16(v1[0], v1[1]); w.w = cvt_pk_bf16(v1[2], v1[3]);
                    *(u32x4*)(rowp + bj * HALF) = w; } }
    }
};
struct EpiBf16Norm {
    static constexpr bool PERM = true, AFTER_DRAIN = false;
    bf16_t* O; int ldc; unsigned* NRM;
    __device__ __forceinline__ void operator()(const f32x4 (&acc)[2][2][4][2], const Unit& u, int wr, int wc, int fr, int fq) const {
        const int row0 = u.pm * BM + wr * 64 + fr, col0 = u.pn * BM + wc * 32 + 8 * fq;
        const int pn = u.pn; const bool isq = (pn < 2) || (pn == 6) || (pn == 7), isk = (pn == 2) || (pn == 3) || (pn == 8) || (pn == 9);
        float mx0 = 0.f, mx1 = 0.f;
#pragma unroll
        for (int ai = 0; ai < 2; ++ai)
#pragma unroll
            for (int m = 0; m < 4; ++m) { bf16_t* rowp = O + (size_t)(row0 + ai * HALF + m * 16) * ldc + col0;
#pragma unroll
                for (int bj = 0; bj < 2; ++bj) { const f32x4 v0 = acc[ai][bj][m][0], v1 = acc[ai][bj][m][1];
                    u32x4 w; w.x = cvt_pk_bf16(v0[0], v0[1]); w.y = cvt_pk_bf16(v0[2], v0[3]); w.z = cvt_pk_bf16(v1[0], v1[1]); w.w = cvt_pk_bf16(v1[2], v1[3]);
                    *(u32x4*)(rowp + bj * HALF) = w;
                    if (isq || isk) { float ss = ((v0[0] * v0[0] + v0[1] * v0[1]) + (v0[2] * v0[2] + v0[3] * v0[3])) + ((v1[0] * v1[0] + v1[1] * v1[1]) + (v1[2] * v1[2] + v1[3] * v1[3]));
                        ss += __shfl_xor(ss, 16); ss += __shfl_xor(ss, 32);
                        if (bj == 0) mx0 = fmaxf(mx0, ss); else mx1 = fmaxf(mx1, ss); } } }
        if (isq || isk) {
#pragma unroll
            for (int off = 1; off < 16; off <<= 1) { mx0 = fmaxf(mx0, __shfl_xor(mx0, off)); mx1 = fmaxf(mx1, __shfl_xor(mx1, off)); }
            if (fr == 0 && fq == 0) {
                const int b = u.pm >> 4, qb = u.pm & 15, half = wc & 1;
                const int base = isq ? (pn < 2 ? pn * 4 : 8 + (pn - 6) * 4) : (pn < 4 ? (pn - 2) * 4 : 8 + (pn - 8) * 4);
#pragma unroll
                for (int bj = 0; bj < 2; ++bj) { const int vq = base + 2 * bj + (wc >> 1); const float mv = (bj == 0 ? mx0 : mx1) * 1.02f;
                    const int idx = isq ? (512 + (((b * 16 + qb) * 16 + vq) << 1) + half) : ((((b * 16) + vq) << 1) + half);
                    atomicMax(NRM + idx, __float_as_uint(mv)); }
            }
        }
    }
};
struct EpiResidual {
    static constexpr bool PERM = false, AFTER_DRAIN = false;
    const float* __restrict__ X; bf16_t* __restrict__ HB; unsigned long long* __restrict__ SS; int ldc;
    __device__ __forceinline__ void operator()(const f32x4 (&acc)[2][2][4][2], const Unit& u, int wr, int wc, int fr, int fq) const {
        typedef unsigned u32x2e __attribute__((ext_vector_type(2)));
        const int col0 = u.pn * BM + wc * 32 + 4 * fq;
#pragma unroll
        for (int ai = 0; ai < 2; ++ai) {
            f32x4 pre[4][2][2];
#pragma unroll
            for (int m = 0; m < 4; ++m) { const size_t off = (size_t)(u.pm * BM + ai * HALF + wr * 64 + m * 16 + fr) * ldc + col0;
#pragma unroll
                for (int bj = 0; bj < 2; ++bj)
#pragma unroll
                    for (int n = 0; n < 2; ++n) pre[m][bj][n] = *(const f32x4*)(X + off + bj * HALF + n * 16); }
#pragma unroll
            for (int m = 0; m < 4; ++m) { const int row = u.pm * BM + ai * HALF + wr * 64 + m * 16 + fr; const size_t off = (size_t)row * ldc + col0; float part = 0.f;
#pragma unroll
                for (int bj = 0; bj < 2; ++bj)
#pragma unroll
                    for (int n = 0; n < 2; ++n) { const f32x4 v = acc[ai][bj][m][n] + pre[m][bj][n];
                        part += (v[0] * v[0] + v[1] * v[1]) + (v[2] * v[2] + v[3] * v[3]);
                        u32x2e w; w.x = cvt_pk_bf16(v[0], v[1]); w.y = cvt_pk_bf16(v[2], v[3]); *(u32x2e*)(HB + off + bj * HALF + n * 16) = w; }
                part += __shfl_xor(part, 16); part += __shfl_xor(part, 32);
                if (fq == 0) atomicAdd(SS + row, (unsigned long long)(part * 16777216.f)); }
        }
    }
};
}
constexpr size_t WS_SS = 20 * MiB + 65536;
constexpr size_t WS_PO = 224 * MiB;
constexpr int LDS_LAM = 131072;
constexpr size_t WS_NRM = 20 * MiB;
#define NRM_K(b, vq) (((b) * 16 + (vq)) * 2)
#define NRM_Q(b, qb, vq) (512 + (((b) * 16 + (qb)) * 16 + (vq)) * 2)
constexpr int NRM_WORDS = 512 + 8192;
__device__ __forceinline__ void norms_wave(int t0, int lane, const bf16_t* __restrict__ PROJ, float* __restrict__ NRM) {
    const int slot = lane >> 1, half = lane & 1, vq = slot & 15;
    const int col = (slot < 16 ? (vq < 8 ? COL_QA + vq * 64 : COL_QB + (vq - 8) * 64) : (vq < 8 ? COL_KA + vq * 64 : COL_KB + (vq - 8) * 64)) + half * 32;
    float mx = 0.f;
    for (int i = 0; i < 32; ++i) {
        const uint4* p = (const uint4*)(PROJ + (size_t)(t0 + i) * NPROJ + col); float ss = 0.f;
#pragma unroll
        for (int j = 0; j < 4; ++j) { const uint4 w = p[j]; const float a0 = bflo(w.x), a1 = bfhi(w.x), a2 = bflo(w.y), a3 = bfhi(w.y), a4 = bflo(w.z), a5 = bfhi(w.z), a6 = bflo(w.w), a7 = bfhi(w.w);
            ss += (a0 * a0 + a1 * a1) + (a2 * a2 + a3 * a3) + (a4 * a4 + a5 * a5) + (a6 * a6 + a7 * a7); }
        ss += __shfl_xor(ss, 1);
        mx = fmaxf(mx, ss);
    }
    if (half == 0) { const int b = t0 / SEQ, qb = (t0 % SEQ) / 256;
        atomicMax((unsigned*)NRM + (slot < 16 ? NRM_Q(b, qb, vq) : NRM_K(b, vq)), __float_as_uint(mx * 1.02f)); }
}
constexpr size_t WS_DSCR = 32 * MiB;
__device__ __forceinline__ void fox_unit(const Ctx& c, int b, int h, int qb, const bf16_t* PROJ, const float* CUM, const float* NRM, bf16_t* MIXED) {
    using attn_body::bf16; using attn_body::f32x16; using attn_body::attn_pass; using attn_body::store_tile_bf16;
    const bf16* P = (const bf16*)PROJ + (size_t)b * SEQ * NPROJ;
    f32x16 o[2];
    const float* cumf = CUM + ((size_t)b * FH + h) * SEQ;
    const float bound = sqrtf((NRM[NRM_Q(b, qb, h)] + NRM[NRM_Q(b, qb, h) + 1]) * (NRM[NRM_K(b, h)] + NRM[NRM_K(b, h) + 1]));
    const int jmin = attn_body::attn_jmin<0>(qb, bound, cumf, 0.f, threadIdx.x & 63);
    attn_pass<0, 8>(qb, jmin, P + COL_QA + h * 64, P + COL_KA + h * 64, P + COL_VA + h * 64, cumf, 0.f, (char*)c.lds_gen, o);
    int tid_l = threadIdx.x; asm volatile("" : "+v"(tid_l));
    const int lane = tid_l & 63, wave = __builtin_amdgcn_readfirstlane(tid_l >> 6);
    store_tile_bf16(o, (bf16*)MIXED + ((size_t)b * SEQ + qb * 256 + wave * 32) * D + h * 64, D, (char*)c.lds_gen, wave, lane);
}
__device__ __forceinline__ void diff_unit(const Ctx& c, int b, int h, int qb, const bf16_t* PROJ, const float* NRM, const float* subg, bf16_t* MIXED, unsigned char* ws) {
    using attn_body::bf16; using attn_body::f32x16; using attn_body::attn_pass_dv128; using attn_body::store_tile_bf16_at;
    f32x16 o[4];
#pragma unroll 1
    for (int m = 0; m < 2; ++m) {
        { const bf16* P = (const bf16*)PROJ + (size_t)b * SEQ * NPROJ; const float slope2 = exp2f(-2.f * (float)(h + 1)) * LOG2E;
          const float bound = sqrtf((NRM[NRM_Q(b, qb, 8 + 2 * h + m)] + NRM[NRM_Q(b, qb, 8 + 2 * h + m) + 1]) * (NRM[NRM_K(b, 8 + 2 * h + m)] + NRM[NRM_K(b, 8 + 2 * h + m) + 1]));
          const int jmin = attn_body::attn_jmin<1>(qb, bound, nullptr, slope2, threadIdx.x & 63);
          attn_pass_dv128<8>(qb, jmin, P + COL_QB + h * 128 + m * 64, P + COL_KB + h * 128 + m * 64, P + COL_VB + h * 128, slope2, (char*)c.lds_gen, o); }
        int tid_l = threadIdx.x; asm volatile("" : "+v"(tid_l));
        const int lane = tid_l & 63, wave = __builtin_amdgcn_readfirstlane(tid_l >> 6);
        f32x4v* stash = (f32x4v*)(ws + WS_DSCR + ((size_t)blockIdx.x * NWAVES + wave) * 16384) + lane;
        if (m == 0) {
#pragma unroll
            for (int i = 0; i < 16; ++i) { const int d0 = i >> 2, r = (i & 3) * 4; stash[i * 64] = (f32x4v){o[d0][r], o[d0][r + 1], o[d0][r + 2], o[d0][r + 3]}; }
        } else {
            const float lam = ((const LAS float*)(c.lds + LDS_LAM))[0];
            asm volatile("s_waitcnt vmcnt(0)" ::: "memory");
#pragma unroll
            for (int i = 0; i < 16; ++i) { const int d0 = i >> 2, r = (i & 3) * 4; const f32x4v a = stash[i * 64];
                o[d0][r] = a.x - lam * o[d0][r]; o[d0][r + 1] = a.y - lam * o[d0][r + 1]; o[d0][r + 2] = a.z - lam * o[d0][r + 2]; o[d0][r + 3] = a.w - lam * o[d0][r + 3]; }
            const int r32 = lane & 31;
            const float g0 = subg[r32], g1 = subg[32 + r32], g2 = subg[64 + r32], g3 = subg[96 + r32];
#pragma unroll
            for (int r = 0; r < 16; ++r) {
                float ss = (o[0][r] * o[0][r] + o[1][r] * o[1][r]) + (o[2][r] * o[2][r] + o[3][r] * o[3][r]);
#pragma unroll
                for (int off = 1; off < 32; off <<= 1) ss += __shfl_xor(ss, off);
                const float rn = rsqrtf(ss * (1.f / 128.f) + RMS_EPS) * (1.f - LAMBDA_INIT);
                o[0][r] *= rn * g0; o[1][r] *= rn * g1; o[2][r] *= rn * g2; o[3][r] *= rn * g3;
            }
            bf16* dst = (bf16*)MIXED + ((size_t)b * SEQ + qb * 256 + wave * 32) * D + 512 + h * 128;
            store_tile_bf16_at(o, dst, D, (char*)c.lds_gen, attn_body::D2_K, wave, lane);
            store_tile_bf16_at(o + 2, dst + 64, D, (char*)c.lds_gen, attn_body::D2_K, wave, lane);
        }
    }
}

__device__ __forceinline__ void resid_rms2_row(int row, int lane, const float* __restrict__ x, const bf16_t* __restrict__ Y, const float* __restrict__ g2, bf16_t* __restrict__ HN) {
    const f32x4v* xr = (const f32x4v*)(x + (size_t)row * D) + lane;
    const uint2* yr = (const uint2*)(Y + (size_t)row * D) + lane;
    f32x4v v[4]; float ss = 0.f;
#pragma unroll
    for (int j = 0; j < 4; ++j) { const uint2 y = yr[64 * j]; v[j] = xr[64 * j]; v[j].x += bflo(y.x); v[j].y += bfhi(y.x); v[j].z += bflo(y.y); v[j].w += bfhi(y.y);
        ss += (v[j].x * v[j].x + v[j].y * v[j].y) + (v[j].z * v[j].z + v[j].w * v[j].w); }
    ss = wave_sum(ss);
    const float rstd = rsqrtf(ss * (1.f / D) + RMS_EPS);
    unsigned long long* o8 = (unsigned long long*)(HN + (size_t)row * D) + lane;
#pragma unroll
    for (int j = 0; j < 4; ++j) { const f32x4v g = ((const f32x4v*)g2)[lane + 64 * j]; const f32x4v w = v[j] * rstd * g;
        o8[64 * j] = (unsigned long long)pk2(w.x, w.y) | ((unsigned long long)pk2(w.z, w.w) << 32); }
}


constexpr size_t WS_UF8 = 736 * MiB;
constexpr size_t WS_VF8 = 752 * MiB;
constexpr size_t WS_SCU = 768 * MiB;
constexpr size_t WS_SCV = 768 * MiB + 65536;
constexpr size_t WS_SUA = 672 * MiB;
constexpr size_t WS_EIDX = 608 * MiB;
constexpr size_t WS_GATE = 640 * MiB;
constexpr size_t WS_END2 = 800 * MiB;
typedef __bf16 bf16x2v __attribute__((ext_vector_type(2)));
typedef unsigned rt_u32x4 __attribute__((ext_vector_type(4)));
typedef short rt_bf16x8 __attribute__((ext_vector_type(8)));
typedef float rt_f32x16 __attribute__((ext_vector_type(16)));

typedef float rt_f32x2 __attribute__((ext_vector_type(2)));
__device__ __forceinline__ void p0_table_row(int lane, const float* __restrict__ src, const float* __restrict__ colgain, unsigned char* __restrict__ dst_base, int row, float* __restrict__ sc) {
    const f32x4v* sr = (const f32x4v*)src + 4 * lane; f32x4v v[4]; float am = 0.f;
#pragma unroll
    for (int j = 0; j < 4; ++j) { v[j] = sr[j]; if (colgain) v[j] = v[j] * ((const f32x4v*)colgain)[4 * lane + j]; am = fmaxf(am, fmaxf(fmaxf(fabsf(v[j].x), fabsf(v[j].y)), fmaxf(fabsf(v[j].z), fabsf(v[j].w)))); }
#pragma unroll
    for (int o = 1; o < 64; o <<= 1) am = fmaxf(am, __shfl_xor(am, o));
    const float q = am > 0.f ? 448.f / am : 1.f;
    unsigned w[4];
#pragma unroll
    for (int j = 0; j < 4; ++j) { int p = __builtin_amdgcn_cvt_pk_fp8_f32(v[j].x * q, v[j].y * q, 0, false); p = __builtin_amdgcn_cvt_pk_fp8_f32(v[j].z * q, v[j].w * q, p, true); w[j] = (unsigned)p; }
    *(uint4*)(dst_base + (size_t)(lane >> 3) * ((size_t)NEXP * 128) + (size_t)row * 128 + (lane & 7) * 16) = (uint4){w[0], w[1], w[2], w[3]};
    if (lane == 0) *sc = am > 0.f ? am * (1.f / 448.f) : 1.f;
}
__device__ __forceinline__ void p0_tables(const Ctx& c, const float* __restrict__ U, const float* __restrict__ V, const float* __restrict__ g2, unsigned char* __restrict__ UF, unsigned char* __restrict__ VF, float* __restrict__ SCU, float* __restrict__ SCV) {
    for (int r = c.gw; r < 2 * NEXP; r += c.NGW) {
        if (r < NEXP) p0_table_row(c.lane, U + (size_t)r * D, g2, UF, r, SCU + r);
        else p0_table_row(c.lane, V + (size_t)(r - NEXP) * D, nullptr, VF, r - NEXP, SCV + (r - NEXP));
    }
}

__device__ __forceinline__ void ce_desc(unsigned& a, unsigned& b) { const unsigned mx = a > b ? a : b, mn = a > b ? b : a; a = mx; b = mn; }
template <int N> __device__ __forceinline__ void bitonic_sort_desc(unsigned (&v)[N]) {
#pragma unroll
    for (int k = 2; k <= N; k <<= 1) {
#pragma unroll
        for (int j = k >> 1; j > 0; j >>= 1) {
#pragma unroll
            for (int i = 0; i < N; ++i) { const int l = i ^ j; if (l > i) { if ((i & k) == 0) ce_desc(v[i], v[l]); else ce_desc(v[l], v[i]); } }
        }
    }
}
__device__ __forceinline__ void sort16_desc(unsigned (&v)[16]) { ce_desc(v[0], v[1]); ce_desc(v[2], v[3]); ce_desc(v[0], v[2]); ce_desc(v[1], v[3]); ce_desc(v[1], v[2]); ce_desc(v[4], v[5]); ce_desc(v[6], v[7]); ce_desc(v[4], v[6]); ce_desc(v[5], v[7]); ce_desc(v[5], v[6]); ce_desc(v[0], v[4]); ce_desc(v[2], v[6]); ce_desc(v[2], v[4]); ce_desc(v[1], v[5]); ce_desc(v[3], v[7]); ce_desc(v[3], v[5]); ce_desc(v[1], v[2]); ce_desc(v[3], v[4]); ce_desc(v[5], v[6]); ce_desc(v[8], v[9]); ce_desc(v[10], v[11]); ce_desc(v[8], v[10]); ce_desc(v[9], v[11]); ce_desc(v[9], v[10]); ce_desc(v[12], v[13]); ce_desc(v[14], v[15]); ce_desc(v[12], v[14]); ce_desc(v[13], v[15]); ce_desc(v[13], v[14]); ce_desc(v[8], v[12]); ce_desc(v[10], v[14]); ce_desc(v[10], v[12]); ce_desc(v[9], v[13]); ce_desc(v[11], v[15]); ce_desc(v[11], v[13]); ce_desc(v[9], v[10]); ce_desc(v[11], v[12]); ce_desc(v[13], v[14]); ce_desc(v[0], v[8]); ce_desc(v[4], v[12]); ce_desc(v[4], v[8]); ce_desc(v[2], v[10]); ce_desc(v[6], v[14]); ce_desc(v[6], v[10]); ce_desc(v[2], v[4]); ce_desc(v[6], v[8]); ce_desc(v[10], v[12]); ce_desc(v[1], v[9]); ce_desc(v[5], v[13]); ce_desc(v[5], v[9]); ce_desc(v[3], v[11]); ce_desc(v[7], v[15]); ce_desc(v[7], v[11]); ce_desc(v[3], v[5]); ce_desc(v[7], v[9]); ce_desc(v[11], v[13]); ce_desc(v[1], v[2]); ce_desc(v[3], v[4]); ce_desc(v[5], v[6]); ce_desc(v[7], v[8]); ce_desc(v[9], v[10]); ce_desc(v[11], v[12]); ce_desc(v[13], v[14]); }
__device__ __forceinline__ void merge_top16(unsigned (&a)[16], const unsigned (&b)[16]) {
#pragma unroll
    for (int i = 0; i < 16; ++i) a[i] = a[i] > b[15 - i] ? a[i] : b[15 - i];
#pragma unroll
    for (int j = 8; j > 0; j >>= 1) {
#pragma unroll
        for (int i = 0; i < 16; ++i) { const int l = i ^ j; if (l > i) ce_desc(a[i], a[l]); }
    }
}
__device__ __forceinline__ unsigned f2key(float f) { const unsigned b = __float_as_uint(f); return b ^ (((int)b >> 31) | 0x80000000u); }
__device__ __forceinline__ float key2f(unsigned k) { return __uint_as_float((k & 0x80000000u) ? (k ^ 0x80000000u) : ~k); }

__device__ __forceinline__ void top16_of_scores(const rt_f32x16 (&acc)[4], int hi, unsigned (&t)[16]) {
    unsigned g[16];
#pragma unroll
    for (int kb = 0; kb < 4; ++kb) {
        unsigned hi4 = (unsigned)(4 * hi); asm volatile("" : "+v"(hi4));
#pragma unroll
        for (int r = 0; r < 16; ++r) g[r] = ((f2key(acc[kb][r]) & ~127u) | hi4) | (unsigned)(32 * kb + (r & 3) + 8 * (r >> 2));
        sort16_desc(g);
        if (kb == 0) {
#pragma unroll
            for (int i = 0; i < 16; ++i) t[i] = g[i];
        } else merge_top16(t, g);
    }
    unsigned lo[16], up[16];
#pragma unroll
    for (int i = 0; i < 16; ++i) { auto rr = __builtin_amdgcn_permlane32_swap(t[i], t[i], false, false); lo[i] = rr[0]; up[i] = rr[1]; }
    merge_top16(lo, up);
#pragma unroll
    for (int i = 0; i < 16; ++i) t[i] = lo[i];
}

__host__ __device__ constexpr int cand_slot(int a, int b) { int n = 0; for (int i = 0; i < 16; ++i) for (int j = 0; j < 16; ++j) { if (i == a && j == b) return n; if ((i + 1) * (j + 1) <= 16) ++n; } return n; }
static_assert(cand_slot(15, 0) == 49, "50 candidates");
__host__ __device__ constexpr int cand_a(int slot) { int n = 0; for (int i = 0; i < 16; ++i) for (int j = 0; j < 16; ++j) if ((i + 1) * (j + 1) <= 16) { if (n == slot) return i; ++n; } return 0; }
__host__ __device__ constexpr int cand_b(int slot) { int n = 0; for (int i = 0; i < 16; ++i) for (int j = 0; j < 16; ++j) if ((i + 1) * (j + 1) <= 16) { if (n == slot) return j; ++n; } return 0; }
static_assert(cand_a(49) == 15 && cand_b(49) == 0 && cand_a(0) == 0 && cand_b(1) == 1, "candidate slot inverse");
constexpr int RT_SK_BYTES = 65536, RT_LUT_OFF = 65536;
__device__ __forceinline__ void route_stage_subkeys(const Ctx& c, const float* __restrict__ subk, int h) {
    f32x4v a[8], b[8];
#pragma unroll
    for (int i = 0; i < 8; ++i) { const int q = c.tid + i * NTHR; const int p = q >> 11, key = (q >> 4) & 127, ch = q & 15;
        const float* src = subk + (((size_t)h * 2 + p) * NKEY + key) * 128 + ch * 8; a[i] = ((const f32x4v*)src)[0]; b[i] = ((const f32x4v*)src)[1]; }
#pragma unroll
    for (int i = 0; i < 8; ++i) { const int q = c.tid + i * NTHR; const int p = q >> 11, key = (q >> 4) & 127, ch = q & 15;
        rt_u32x4 o; o.x = pk2(a[i].x, a[i].y); o.y = pk2(a[i].z, a[i].w); o.z = pk2(b[i].x, b[i].y); o.w = pk2(b[i].z, b[i].w);
        *(LAS rt_u32x4*)(c.lds + p * 32768 + key * 256 + ((ch ^ (key & 15)) << 4)) = o; }
}
__device__ __forceinline__ void route_tile(const Ctx& c, int tile, int h, const bf16_t* __restrict__ QP, const float* __restrict__ SCU, const float* __restrict__ SCV, int* __restrict__ EIDX, float* __restrict__ GATE, float* __restrict__ SUA) {
    int lane = c.lane; asm volatile("" : "+v"(lane));
    const int r32 = lane & 31, hi = lane >> 5;
    const int tok = tile * 32 + r32;
    unsigned s1[16], s2[16];
#pragma unroll
    for (int p = 0; p < 2; ++p) {
        rt_bf16x8 qf[8];
        { const uint4* qp = (const uint4*)(QP + (size_t)tok * PQ + h * 256 + p * 128) + hi;
#pragma unroll
          for (int kc = 0; kc < 8; ++kc) qf[kc] = __builtin_bit_cast(rt_bf16x8, qp[2 * kc]); }
        rt_f32x16 acc[4];
#pragma unroll
        for (int kb = 0; kb < 4; ++kb) {
            const int key = 32 * kb + r32;
            const LAS unsigned char* rowp = c.lds + p * 32768 + key * 256;
            acc[kb] = rt_f32x16{};
#pragma unroll
            for (int kc = 0; kc < 8; ++kc) {
                const rt_bf16x8 af = *(const LAS rt_bf16x8*)(rowp + (((2 * kc + hi) ^ (key & 15)) << 4));
                acc[kb] = __builtin_amdgcn_mfma_f32_32x32x16_bf16(af, qf[kc], acc[kb], 0, 0, 0);
            }
        }
        if (p == 0) top16_of_scores(acc, hi, s1); else top16_of_scores(acc, hi, s2);
    }
    unsigned top[16];
    {
        float f1[16], f2[16];
#pragma unroll
        for (int i = 0; i < 16; ++i) { f1[i] = key2f(s1[i]); f2[i] = key2f(s2[i]); }
        unsigned ga[16], gb[16];
#pragma unroll
        for (int j = 0; j < 32; ++j) {
            unsigned key = 0u;
            if (j < 25) { constexpr int dummy = 0; (void)dummy;
                const int a0 = cand_a(2 * j), b0 = cand_b(2 * j), a1 = cand_a(2 * j + 1), b1 = cand_b(2 * j + 1);
                const float fa = hi ? f1[a1] : f1[a0], fb = hi ? f2[b1] : f2[b0];
                const unsigned pos = hi ? (unsigned)(255 - (a1 * 16 + b1)) : (unsigned)(255 - (a0 * 16 + b0));
                key = (f2key(fa + fb) & ~255u) | pos; }
            if (j < 16) ga[j] = key; else gb[j - 16] = key;
        }
        sort16_desc(ga); sort16_desc(gb); merge_top16(ga, gb);
        unsigned lo[16], up[16];
#pragma unroll
        for (int i = 0; i < 16; ++i) { auto rr = __builtin_amdgcn_permlane32_swap(ga[i], ga[i], false, false); lo[i] = rr[0]; up[i] = rr[1]; }
        merge_top16(lo, up);
#pragma unroll
        for (int i = 0; i < 16; ++i) top[i] = lo[i];
    }
    LAS unsigned char* lut = c.lds + RT_LUT_OFF + c.wave * 2048 + lane * 32;
    { unsigned w[8];
#pragma unroll
      for (int i = 0; i < 4; ++i) { w[i] = (s1[4 * i] & 127u) | ((s1[4 * i + 1] & 127u) << 8) | ((s1[4 * i + 2] & 127u) << 16) | ((s1[4 * i + 3] & 127u) << 24);
                                    w[4 + i] = (s2[4 * i] & 127u) | ((s2[4 * i + 1] & 127u) << 8) | ((s2[4 * i + 2] & 127u) << 16) | ((s2[4 * i + 3] & 127u) << 24); }
      *(LAS rt_u32x4*)(lut) = (rt_u32x4){w[0], w[1], w[2], w[3]}; *(LAS rt_u32x4*)(lut + 16) = (rt_u32x4){w[4], w[5], w[6], w[7]}; }
    asm volatile("s_waitcnt lgkmcnt(0)" ::: "memory");
    float sc[16], sum = 0.f; const float mx = key2f(top[0] & ~255u);
#pragma unroll
    for (int i = 0; i < 16; ++i) { sc[i] = __expf(key2f(top[i] & ~255u) - mx); sum += sc[i]; }
    const float rs = 1.f / sum;
    int eo[8]; float go[8], so[8];
#pragma unroll
    for (int i = 0; i < 8; ++i) {
        const unsigned k = hi ? top[8 + i] : top[i]; const unsigned pos = 255u - (k & 255u);
        const unsigned ia = lut[pos >> 4], ib = lut[16 + (pos & 15u)];
        eo[i] = (int)(ia * NKEY + ib); go[i] = (hi ? sc[8 + i] : sc[i]) * rs;
    }
#pragma unroll
    for (int i = 0; i < 8; ++i) { so[i] = SCU[eo[i]]; go[i] *= SCV[eo[i]]; }
    asm volatile("s_waitcnt lgkmcnt(0)" ::: "memory");
    int* ep = EIDX + (size_t)tok * 128 + h * 16 + hi * 8; float* gp = GATE + (size_t)tok * 128 + h * 16 + hi * 8;
    *(int4*)ep = (int4){eo[0], eo[1], eo[2], eo[3]}; *(int4*)(ep + 4) = (int4){eo[4], eo[5], eo[6], eo[7]};
    *(f32x4v*)gp = (f32x4v){go[0], go[1], go[2], go[3]}; *(f32x4v*)(gp + 4) = (f32x4v){go[4], go[5], go[6], go[7]};
    float* sp = SUA + (size_t)tok * 128 + h * 16 + hi * 8;
    *(f32x4v*)sp = (f32x4v){so[0], so[1], so[2], so[3]}; *(f32x4v*)(sp + 4) = (f32x4v){so[4], so[5], so[6], so[7]};
}

constexpr size_t WS_PART = 352 * MiB;
__device__ __forceinline__ float dpp_f(float v, const int ctrl_sel) {
    const int x = __builtin_bit_cast(int, v);
    const int r = ctrl_sel == 0 ? __builtin_amdgcn_update_dpp(x, x, 0xB1, 0xf, 0xf, false) : ctrl_sel == 1 ? __builtin_amdgcn_update_dpp(x, x, 0x4E, 0xf, 0xf, false) : __builtin_amdgcn_update_dpp(x, x, 0x141, 0xf, 0xf, false);
    return __builtin_bit_cast(float, r);
}
#define FP8X16(W_, F_) do { const uint4 q_ = (W_); const rt_f32x2 t0_ = __builtin_amdgcn_cvt_pk_f32_fp8((int)q_.x, false), t1_ = __builtin_amdgcn_cvt_pk_f32_fp8((int)q_.x, true), t2_ = __builtin_amdgcn_cvt_pk_f32_fp8((int)q_.y, false), t3_ = __builtin_amdgcn_cvt_pk_f32_fp8((int)q_.y, true); \
    const rt_f32x2 t4_ = __builtin_amdgcn_cvt_pk_f32_fp8((int)q_.z, false), t5_ = __builtin_amdgcn_cvt_pk_f32_fp8((int)q_.z, true), t6_ = __builtin_amdgcn_cvt_pk_f32_fp8((int)q_.w, false), t7_ = __builtin_amdgcn_cvt_pk_f32_fp8((int)q_.w, true); \
    F_[0] = t0_.x; F_[1] = t0_.y; F_[2] = t1_.x; F_[3] = t1_.y; F_[4] = t2_.x; F_[5] = t2_.y; F_[6] = t3_.x; F_[7] = t3_.y; F_[8] = t4_.x; F_[9] = t4_.y; F_[10] = t5_.x; F_[11] = t5_.y; F_[12] = t6_.x; F_[13] = t6_.y; F_[14] = t7_.x; F_[15] = t7_.y; } while (0)
typedef int rt_i32x4 __attribute__((ext_vector_type(4)));
#define U_DOT(Wq, XW, D_) do { const uint4 q_ = (Wq); float d_ = 0.f; \
    d_ = __builtin_amdgcn_fdot2_f32_bf16(__builtin_amdgcn_cvt_scalef32_pk_bf16_fp8(q_.x, 1.0f, false), __builtin_bit_cast(bf16x2v, XW[0]), d_, false); \
    d_ = __builtin_amdgcn_fdot2_f32_bf16(__builtin_amdgcn_cvt_scalef32_pk_bf16_fp8(q_.x, 1.0f, true),  __builtin_bit_cast(bf16x2v, XW[1]), d_, false); \
    d_ = __builtin_amdgcn_fdot2_f32_bf16(__builtin_amdgcn_cvt_scalef32_pk_bf16_fp8(q_.y, 1.0f, false), __builtin_bit_cast(bf16x2v, XW[2]), d_, false); \
    d_ = __builtin_amdgcn_fdot2_f32_bf16(__builtin_amdgcn_cvt_scalef32_pk_bf16_fp8(q_.y, 1.0f, true),  __builtin_bit_cast(bf16x2v, XW[3]), d_, false); \
    d_ = __builtin_amdgcn_fdot2_f32_bf16(__builtin_amdgcn_cvt_scalef32_pk_bf16_fp8(q_.z, 1.0f, false), __builtin_bit_cast(bf16x2v, XW[4]), d_, false); \
    d_ = __builtin_amdgcn_fdot2_f32_bf16(__builtin_amdgcn_cvt_scalef32_pk_bf16_fp8(q_.z, 1.0f, true),  __builtin_bit_cast(bf16x2v, XW[5]), d_, false); \
    d_ = __builtin_amdgcn_fdot2_f32_bf16(__builtin_amdgcn_cvt_scalef32_pk_bf16_fp8(q_.w, 1.0f, false), __builtin_bit_cast(bf16x2v, XW[6]), d_, false); \
    d_ = __builtin_amdgcn_fdot2_f32_bf16(__builtin_amdgcn_cvt_scalef32_pk_bf16_fp8(q_.w, 1.0f, true),  __builtin_bit_cast(bf16x2v, XW[7]), d_, false); \
    D_ = d_; } while (0)
__device__ __forceinline__ void peer_u_wave(int tok0, int step, int k, int lane, const bf16_t* __restrict__ HN, const int* __restrict__ EIDX, const unsigned char* __restrict__ UF, unsigned* __restrict__ PARTB) {
    asm volatile("" : "+v"(lane));
    const int g = lane >> 3, c = lane & 7;
    const unsigned uoff = (unsigned)(k * (NEXP * 128) + 16 * c);
    const int last = tok0 + ((NTOK - 1 - tok0) / step) * step;
#define U_IDS(DST, tok_, half_) do { const int tt_ = (tok_) <= last ? (tok_) : last; const rt_i32x4* e_ = (const rt_i32x4*)(EIDX + (size_t)tt_ * 128 + 16 * g + 8 * (half_)); const rt_i32x4 a_ = e_[0], b_ = e_[1]; \
        DST[0] = a_.x; DST[1] = a_.y; DST[2] = a_.z; DST[3] = a_.w; DST[4] = b_.x; DST[5] = b_.y; DST[6] = b_.z; DST[7] = b_.w; } while (0)
#define U_GATHER(W, IDS) do { _Pragma("unroll") for (int i_ = 0; i_ < 8; ++i_) W[i_] = *(const uint4*)(UF + ((unsigned)IDS[i_] * 128u + uoff)); } while (0)
#define U_X(XW, tok_) do { const int tt_ = (tok_) <= last ? (tok_) : last; const uint4* h_ = (const uint4*)(HN + (size_t)tt_ * D + 128 * k + 16 * c); const uint4 a_ = h_[0], b_ = h_[1]; \
        XW[0] = a_.x; XW[1] = a_.y; XW[2] = a_.z; XW[3] = a_.w; XW[4] = b_.x; XW[5] = b_.y; XW[6] = b_.z; XW[7] = b_.w; } while (0)
#define U_COMPUTE(W, XW, R_) do { float d8_[8]; _Pragma("unroll") for (int i_ = 0; i_ < 8; ++i_) U_DOT(W[i_], XW, d8_[i_]); \
        float d4_[4], d2_[2]; \
        _Pragma("unroll") for (int j_ = 0; j_ < 4; ++j_) { const float keep_ = b2_ ? d8_[j_ + 4] : d8_[j_], send_ = b2_ ? d8_[j_] : d8_[j_ + 4]; d4_[j_] = keep_ + dpp_f(send_, 2); } \
        _Pragma("unroll") for (int j_ = 0; j_ < 2; ++j_) { const float keep_ = b0_ ? d4_[j_ + 2] : d4_[j_], send_ = b0_ ? d4_[j_] : d4_[j_ + 2]; d2_[j_] = keep_ + dpp_f(send_, 0); } \
        const float keep_ = b1_ ? d2_[1] : d2_[0], send_ = b1_ ? d2_[0] : d2_[1]; \
        R_ = keep_ + dpp_f(send_, 1); } while (0)
    const bool b0_ = (lane & 1) != 0, b1_ = (lane & 2) != 0, b2_ = (lane & 4) != 0; const int isel = 4 * (int)b2_ + 2 * (int)b0_ + (int)b1_;
    int idsA[8], idsB[8]; uint4 WA[8], WB[8]; unsigned xc[8], xn[8];
    U_IDS(idsA, tok0, 0); U_IDS(idsB, tok0, 1);
    U_GATHER(WA, idsA); U_X(xc, tok0); U_IDS(idsA, tok0 + step, 0);
#pragma unroll 1
    for (int tok = tok0; tok < NTOK; tok += step) {
        U_GATHER(WB, idsB); U_IDS(idsB, tok + step, 1);
        float r0_, r1_;
        U_COMPUTE(WA, xc, r0_);
        U_GATHER(WA, idsA); U_X(xn, tok + step); U_IDS(idsA, tok + 2 * step, 0);
        U_COMPUTE(WB, xc, r1_);
        PARTB[(size_t)tok * 512 + k * 64 + lane] = pk2(r0_, r1_);
#pragma unroll
        for (int j = 0; j < 8; ++j) xc[j] = xn[j];
    }
#undef U_IDS
#undef U_GATHER
#undef U_X
#undef U_COMPUTE
}
__device__ __forceinline__ void peer_hid_token(int tok, int lane, const float* __restrict__ PART, const float* __restrict__ SUA, const unsigned long long* __restrict__ SS, float* __restrict__ GATE_HID) {
    const float* pp = PART + (size_t)tok * 1024 + lane; float a = 0.f, b = 0.f;
#pragma unroll
    for (int k = 0; k < 8; ++k) { a += pp[128 * k]; b += pp[128 * k + 64]; }
    const float rstd = rsqrtf((float)SS[tok] * (5.9604644775390625e-8f / D) + RMS_EPS);
    a *= SUA[(size_t)tok * 128 + lane] * rstd; b *= SUA[(size_t)tok * 128 + 64 + lane] * rstd;
    float* gp = GATE_HID + (size_t)tok * 128 + lane;
    gp[0] = 0.5f * a * (1.f + erff(a * 0.70710678118654752f)) * gp[0];
    gp[64] = 0.5f * b * (1.f + erff(b * 0.70710678118654752f)) * gp[64];
}
__device__ __forceinline__ void peer_hid_token2(int t0, int t1, int lane, const unsigned* __restrict__ PARTB, const float* __restrict__ SUA, const unsigned long long* __restrict__ SS, float* __restrict__ GATE_HID) {
    const unsigned* p0 = PARTB + (size_t)t0 * 512 + lane; const unsigned* p1 = PARTB + (size_t)t1 * 512 + lane;
    unsigned w0[8], w1[8];
#pragma unroll
    for (int k = 0; k < 8; ++k) { w0[k] = p0[64 * k]; w1[k] = p1[64 * k]; }
    const int s0 = 16 * (lane >> 3) + 4 * ((lane >> 2) & 1) + 2 * (lane & 1) + ((lane >> 1) & 1);
    float* g0 = GATE_HID + (size_t)t0 * 128 + s0; float* g1 = GATE_HID + (size_t)t1 * 128 + s0;
    const float ga0 = g0[0], gb0 = g0[8], ga1 = g1[0], gb1 = g1[8];
    const float sa0 = SUA[(size_t)t0 * 128 + s0], sb0 = SUA[(size_t)t0 * 128 + s0 + 8], sa1 = SUA[(size_t)t1 * 128 + s0], sb1 = SUA[(size_t)t1 * 128 + s0 + 8];
    const float r0 = rsqrtf((float)SS[t0] * (5.9604644775390625e-8f / D) + RMS_EPS), r1 = rsqrtf((float)SS[t1] * (5.9604644775390625e-8f / D) + RMS_EPS);
    float a0 = 0.f, b0 = 0.f, a1 = 0.f, b1 = 0.f;
#pragma unroll
    for (int k = 0; k < 8; ++k) { a0 += bflo(w0[k]); b0 += bfhi(w0[k]); a1 += bflo(w1[k]); b1 += bfhi(w1[k]); }
    a0 *= sa0 * r0; b0 *= sb0 * r0; a1 *= sa1 * r1; b1 *= sb1 * r1;
    const float h00 = 0.5f * a0 * (1.f + erff(a0 * 0.70710678118654752f)) * ga0, h01 = 0.5f * b0 * (1.f + erff(b0 * 0.70710678118654752f)) * gb0;
    const float h10 = 0.5f * a1 * (1.f + erff(a1 * 0.70710678118654752f)) * ga1, h11 = 0.5f * b1 * (1.f + erff(b1 * 0.70710678118654752f)) * gb1;
    g0[0] = h00; g0[8] = h01; g1[0] = h10; g1[8] = h11;
}
__device__ __forceinline__ void peer_v_wave(int tok0, int step, int k, int lane, const int* __restrict__ EIDX, const float* __restrict__ HID, const unsigned char* __restrict__ VF, bf16_t* __restrict__ PO) {
    asm volatile("" : "+v"(lane));
    const int g = lane >> 3, c = lane & 7;
    const unsigned voff = (unsigned)(k * (NEXP * 128) + 16 * c);
    const int dim = 128 * k + 16 * c + ((lane >> 5) & 1) * 8 + ((lane >> 4) & 1) * 4 + ((lane >> 3) & 1) * 2;
    const int last = tok0 + ((NTOK - 1 - tok0) / step) * step;
#define V_IDS(DST, tok_, half_) do { const int tt_ = (tok_) <= last ? (tok_) : last; const rt_i32x4* e_ = (const rt_i32x4*)(EIDX + (size_t)tt_ * 128 + 16 * g + 8 * (half_)); const rt_i32x4 a_ = e_[0], b_ = e_[1]; \
        DST[0] = a_.x; DST[1] = a_.y; DST[2] = a_.z; DST[3] = a_.w; DST[4] = b_.x; DST[5] = b_.y; DST[6] = b_.z; DST[7] = b_.w; } while (0)
#define V_HID(DST, tok_, half_) do { const int tt_ = (tok_) <= last ? (tok_) : last; const f32x4v* e_ = (const f32x4v*)(HID + (size_t)tt_ * 128 + 16 * g + 8 * (half_)); const f32x4v a_ = e_[0], b_ = e_[1]; \
        DST[0] = a_.x; DST[1] = a_.y; DST[2] = a_.z; DST[3] = a_.w; DST[4] = b_.x; DST[5] = b_.y; DST[6] = b_.z; DST[7] = b_.w; } while (0)
#define V_GATHER(W, IDS) do { _Pragma("unroll") for (int i_ = 0; i_ < 8; ++i_) W[i_] = *(const uint4*)(VF + ((unsigned)IDS[i_] * 128u + voff)); } while (0)
#define V_FMA2(j_, word_, hi_) acc2[j_] = __builtin_amdgcn_cvt_pk_f32_fp8((int)(word_), hi_) * hh_ + acc2[j_]
#define V_COMPUTE(W, HL) do { _Pragma("unroll") for (int i_ = 0; i_ < 8; ++i_) { const uint4 q_ = W[i_]; const rt_f32x2 hh_ = {HL[i_], HL[i_]}; \
        V_FMA2(0, q_.x, false); V_FMA2(1, q_.x, true); V_FMA2(2, q_.y, false); V_FMA2(3, q_.y, true); V_FMA2(4, q_.z, false); V_FMA2(5, q_.z, true); V_FMA2(6, q_.w, false); V_FMA2(7, q_.w, true); \
        asm volatile("" : "+v"(acc2[0]), "+v"(acc2[1]), "+v"(acc2[2]), "+v"(acc2[3]), "+v"(acc2[4]), "+v"(acc2[5]), "+v"(acc2[6]), "+v"(acc2[7]));   \
        __builtin_amdgcn_sched_barrier(0); } } while (0)
    int idsA[8], idsB[8]; uint4 WA[8], WB[8]; float hA[8], hB[8];
    V_IDS(idsA, tok0, 0); V_IDS(idsB, tok0, 1);
    V_GATHER(WA, idsA); V_HID(hA, tok0, 0); V_IDS(idsA, tok0 + step, 0);
#pragma unroll 1
    for (int tok = tok0; tok < NTOK; tok += step) {
        V_GATHER(WB, idsB); V_HID(hB, tok, 1); V_IDS(idsB, tok + step, 1);
        rt_f32x2 acc2[8];
#pragma unroll
        for (int j = 0; j < 8; ++j) acc2[j] = (rt_f32x2){0.f, 0.f};
        V_COMPUTE(WA, hA);
        V_GATHER(WA, idsA); V_HID(hA, tok + step, 0); V_IDS(idsA, tok + 2 * step, 0);
        V_COMPUTE(WB, hB);
        float acc[16];
#pragma unroll
        for (int j = 0; j < 8; ++j) { acc[2 * j] = acc2[j].x; acc[2 * j + 1] = acc2[j].y; }
        float a8[8], a4[4], a2[2];
#pragma unroll
        for (int j = 0; j < 8; ++j) { auto rr = __builtin_amdgcn_permlane32_swap(__float_as_uint(acc[j]), __float_as_uint(acc[j + 8]), false, false); a8[j] = __uint_as_float(rr[0]) + __uint_as_float(rr[1]); }
#pragma unroll
        for (int j = 0; j < 4; ++j) { auto rr = __builtin_amdgcn_permlane16_swap(__float_as_uint(a8[j]), __float_as_uint(a8[j + 4]), false, false); a4[j] = __uint_as_float(rr[0]) + __uint_as_float(rr[1]); }
#pragma unroll
        for (int j = 0; j < 2; ++j) { const bool up = (lane & 8) != 0; const float keep = up ? a4[j + 2] : a4[j], send = up ? a4[j] : a4[j + 2];
            a2[j] = keep + __builtin_bit_cast(float, __builtin_amdgcn_update_dpp(0, __builtin_bit_cast(int, send), 0x128, 0xf, 0xf, false)); }
        *(unsigned*)(PO + (size_t)tok * D + dim) = pk2(a2[0], a2[1]);
    }
#undef V_IDS
#undef V_HID
#undef V_GATHER
#undef V_COMPUTE
#undef V_FMA2
}
__device__ __forceinline__ void final_norm_row(int row, int lane, const bf16_t* __restrict__ HB, const bf16_t* __restrict__ PO, const float* __restrict__ fg, float* __restrict__ out) {
    const uint2* hr = (const uint2*)(HB + (size_t)row * D) + lane; const uint2* pr = (const uint2*)(PO + (size_t)row * D) + lane;
    f32x4v* orow = (f32x4v*)(out + (size_t)row * D) + lane; f32x4v v[4]; float ss = 0.f;
#pragma unroll
    for (int j = 0; j < 4; ++j) { const uint2 y = hr[64 * j], p = pr[64 * j];
        v[j].x = bflo(y.x) + bflo(p.x); v[j].y = bfhi(y.x) + bfhi(p.x); v[j].z = bflo(y.y) + bflo(p.y); v[j].w = bfhi(y.y) + bfhi(p.y);
        ss += (v[j].x * v[j].x + v[j].y * v[j].y) + (v[j].z * v[j].z + v[j].w * v[j].w); }
    ss = wave_sum(ss);
    const float rstd = rsqrtf(ss * (1.f / D) + RMS_EPS);
#pragma unroll
    for (int j = 0; j < 4; ++j) orow[64 * j] = v[j] * rstd * ((const f32x4v*)fg)[lane + 64 * j];
}

struct Args { const float* in[16]; float* out; unsigned char* ws; };
#define XB_TMO      128
#define XB_XCNT(j)  (256  + 64 * (j))
#define XB_XSUB(j)  (1280 + 64 * (j))
#define XB_XGEN(j)  (2304 + 64 * (j))
#define XB_TOP      3328
#define XB_TOPGEN   3392
#define XCD_BAR_WORDS 3456
#define XB_SPIN_CAP (1u << 18)

__device__ __forceinline__ unsigned xb_ld(unsigned* p)              { return __hip_atomic_load(p, __ATOMIC_RELAXED, __HIP_MEMORY_SCOPE_AGENT); }
__device__ __forceinline__ unsigned xb_add(unsigned* p, unsigned v) { return __hip_atomic_fetch_add(p, v, __ATOMIC_RELAXED, __HIP_MEMORY_SCOPE_AGENT); }
__device__ __forceinline__ unsigned xb_xcc_id() { return (unsigned)__builtin_amdgcn_s_getreg((3 << 11) | 20) & 0xFu; }
#define XB_SPIN(cond, bar) do { unsigned _sp = 0; while (cond) { __builtin_amdgcn_s_sleep(1); \
    if ((++_sp & 255u) == 0u) { if (xb_ld(&(bar)[XB_TMO])) break; if (_sp > XB_SPIN_CAP) { atomicAdd(&(bar)[XB_TMO], 1u); break; } } } } while (0)

struct XcdBarrier {
    unsigned* bar; unsigned x;
    volatile LAS unsigned* st;
};

__device__ __forceinline__ XcdBarrier xcd_barrier_post(unsigned* bar, volatile LAS unsigned* st) {
    XcdBarrier b; b.bar = bar; b.x = xb_xcc_id(); b.st = st;
    if (threadIdx.x == 0) (void)xb_add(&bar[XB_XCNT(b.x)], 1u);
    return b;
}
__device__ __forceinline__ void xcd_barrier_complete(unsigned* bar, unsigned x, unsigned& nloc, unsigned& nx) {
    const unsigned G = gridDim.x * gridDim.y * gridDim.z;
    unsigned sum, cnt, mine, sp = 0u;
    for (;;) {
        sum = 0u; cnt = 0u; mine = 0u;
#pragma unroll
        for (unsigned j = 0; j < 16; ++j) { const unsigned c = xb_ld(&bar[XB_XCNT(j)]); sum += c; cnt += (c > 0u) ? 1u : 0u; mine = (j == x) ? c : mine; }
        if (sum == G) break;
        __builtin_amdgcn_s_sleep(1);
        if ((++sp & 255u) == 0u) { if (xb_ld(&bar[XB_TMO])) break; if (sp > XB_SPIN_CAP) { atomicAdd(&bar[XB_TMO], 1u); break; } }
    }
    nloc = mine > 0u ? mine : 1u; nx = cnt > 0u ? cnt : 1u;
}

__device__ __forceinline__ void xcd_barrier(const XcdBarrier& b) {
    asm volatile("s_waitcnt vmcnt(0)" ::: "memory");
    __syncthreads();
    if (threadIdx.x == 0) {
        unsigned* bar = b.bar;
        __builtin_amdgcn_s_waitcnt(0);
        unsigned nloc = b.st[0], nx = b.st[1];
        if (nloc == 0u) { xcd_barrier_complete(bar, b.x, nloc, nx); b.st[0] = nloc; b.st[1] = nx; }
        const unsigned old = xb_add(&bar[XB_XSUB(b.x)], 1u);
        const unsigned gen = old / nloc;
        if (old + 1u == (gen + 1u) * nloc) {
            __builtin_amdgcn_fence(__ATOMIC_RELEASE, "agent");
            asm volatile("s_waitcnt vmcnt(0)" ::: "memory");
            const unsigned og = xb_add(&bar[XB_TOP], 1u);
            const unsigned tg = og / nx;
            if (og + 1u == (tg + 1u) * nx) xb_add(&bar[XB_TOPGEN], 1u);
            else XB_SPIN(xb_ld(&bar[XB_TOPGEN]) == tg, bar);
            __builtin_amdgcn_fence(__ATOMIC_ACQUIRE, "agent");
            xb_add(&bar[XB_XGEN(b.x)], 1u);
            asm volatile("s_waitcnt vmcnt(0)" ::: "memory");
        } else {
            XB_SPIN(xb_ld(&bar[XB_XGEN(b.x)]) == gen, bar);
            __builtin_amdgcn_fence(__ATOMIC_ACQUIRE, "agent");
            asm volatile("s_waitcnt vmcnt(0)" ::: "memory");
        }
    }
    __syncthreads();
}

constexpr int CW_QUEUE = 1024, LDS_QW = 131072 + 128;
constexpr int CW_BAR = 4096;
constexpr int LDS_BARST = 131072 + 64;
#define CAS __attribute__((address_space(4)))
#define PHASE_PROLOGUE() \
    const CAS Args* ap = (const CAS Args*)__builtin_amdgcn_kernarg_segment_ptr(); asm volatile("" : "+s"(ap)); \
    Ctx c; { int t_ = threadIdx.x; asm volatile("" : "+v"(t_)); c.tid = t_; } c.lane = c.tid & 63; c.wave = __builtin_amdgcn_readfirstlane(c.tid >> 6); c.G = gridDim.x; \
    { const int bx = blockIdx.x; c.vcu = (c.G % 8 == 0) ? (bx % 8) * (c.G / 8) + bx / 8 : bx; } \
    c.gw = c.vcu * NWAVES + c.wave; c.NGW = c.G * NWAVES; c.lds = (LAS unsigned char*)lds_raw; c.lds_gen = lds_raw; \
    unsigned char* ws = ap->ws; (void)ws
#define IN(k) (ap->in[k])
#define GRID_BAR() do { XcdBarrier b_; b_.bar = (unsigned*)(((const CAS Args*)__builtin_amdgcn_kernarg_segment_ptr())->ws + WS_CTL) + CW_BAR; b_.x = xb_xcc_id(); b_.st = (volatile LAS unsigned*)((LAS unsigned char*)lds_raw + LDS_BARST); xcd_barrier(b_); } while (0)
#ifndef PROBE_PHASE
#define PROBE_PHASE -1
#endif
#define STAMP(k) do { if (PROBE_PHASE >= 0 && blockIdx.x == 0 && threadIdx.x == 0) ((unsigned long long*)(((const CAS Args*)__builtin_amdgcn_kernarg_segment_ptr())->ws + WS_CTL))[k] = __builtin_amdgcn_s_memrealtime(); } while (0)
__global__ void __launch_bounds__(NTHR, 2) fwd_megakernel(Args a_unused) {
    extern __shared__ __attribute__((aligned(16))) unsigned char lds_raw[];
    { volatile LAS unsigned* st_ = (volatile LAS unsigned*)((LAS unsigned char*)lds_raw + LDS_BARST); if (threadIdx.x == 0) { st_[0] = 0u; st_[1] = 0u; } }
    STAMP(0);
    if (blockIdx.x == 0) { unsigned* ctl_ = (unsigned*)(((const CAS Args*)__builtin_amdgcn_kernarg_segment_ptr())->ws + WS_CTL);
        for (int i = 64 + (int)threadIdx.x; i < 16384; i += NTHR) ctl_[i] = 0u; }
    { PHASE_PROLOGUE();
      p0_weights(c, IN(2), IN(9), IN(11), IN(10), (bf16_t*)(ws + WS_WIN), (bf16_t*)(ws + WS_WOUT), (bf16_t*)(ws + WS_WQ));
      rms1_gates_wave(c.gw, c.NGW, c.lane, IN(0), IN(1), IN(2), IN(3), (bf16_t*)(ws + WS_XN), (float*)(ws + WS_LOGF)); }
    { PHASE_PROLOGUE();
      for (int i = c.vcu * NTHR + c.tid; i < NRM_WORDS; i += c.G * NTHR) ((float*)(ws + WS_NRM))[i] = 0.f;
      for (int i = c.vcu * NTHR + c.tid; i < NTOK; i += c.G * NTHR) ((unsigned long long*)(ws + WS_SS))[i] = 0ull; }
    cg::this_grid().sync();
    (void)xcd_barrier_post((unsigned*)(((const CAS Args*)__builtin_amdgcn_kernarg_segment_ptr())->ws + WS_CTL) + CW_BAR, (volatile LAS unsigned*)((LAS unsigned char*)lds_raw + LDS_BARST));
    STAMP(1);
    { PHASE_PROLOGUE();
      if (c.gw < BATCH * FH) cumsum_seq(c.gw, c.lane, (const float*)(ws + WS_LOGF), (float*)(ws + WS_CUM));
      __syncthreads(); }
    { PHASE_PROLOGUE();
      pg8::Gemm g{(const bf16_t*)(ws + WS_XN), (const bf16_t*)(ws + WS_WIN), NTOK, NPROJ, D}; pg8::StaticOrder S; S.init(NTOK, NPROJ, c.G, (int)blockIdx.x);
      pg8::EpiBf16Norm E{(bf16_t*)(ws + WS_PROJ), NPROJ, (unsigned*)(ws + WS_NRM)};
      pg8::gemm_phase<pg8::EpiBf16Norm, pg8::StaticOrder, true, true>(c.lds, g, S, E); }
    GRID_BAR(); STAMP(2);
    STAMP(3);
    { PHASE_PROLOGUE();
      const float lam = expf(wave_sum(IN(4)[c.lane] * IN(5)[c.lane])) - expf(wave_sum(IN(6)[c.lane] * IN(7)[c.lane])) + LAMBDA_INIT;
      if (c.tid == 0) ((LAS float*)(c.lds + LDS_LAM))[0] = lam;
      __syncthreads(); }
    { PHASE_PROLOGUE();
      const int xg = (int)blockIdx.x & 7;
      unsigned* qctr = (unsigned*)(ws + WS_CTL) + CW_QUEUE + 64 * xg;
      for (;;) {
          __syncthreads();
          if (c.tid == 0) ((LAS unsigned*)(c.lds + LDS_QW))[0] = atomicAdd(qctr, 1u);
          __syncthreads();
          const int u = __builtin_amdgcn_readfirstlane((int)((LAS unsigned*)(c.lds + LDS_QW))[0]);
          if (u >= 2 * 16 * (DH + FH)) break;
          if (u < 2 * 16 * DH) { const int bl = u >> 4; diff_unit(c, xg + 8 * (bl >> 2), bl & 3, 15 - (u & 15), (const bf16_t*)(ws + WS_PROJ), (const float*)(ws + WS_NRM), IN(8), (bf16_t*)(ws + WS_MIXED), ws); }
          else { const int v = u - 2 * 16 * DH, bl = v >> 4; fox_unit(c, xg + 8 * (bl >> 3), bl & 7, 15 - (v & 15), (const bf16_t*)(ws + WS_PROJ), (const float*)(ws + WS_CUM), (const float*)(ws + WS_NRM), (bf16_t*)(ws + WS_MIXED)); }
      } }
    { PHASE_PROLOGUE();
      unsigned* tctr = (unsigned*)(ws + WS_CTL) + CW_QUEUE + 64 * 8;
      for (;;) {
          __syncthreads();
          if (c.tid == 0) ((LAS unsigned*)(c.lds + LDS_QW))[0] = atomicAdd(tctr, 1u);
          __syncthreads();
          const int u = __builtin_amdgcn_readfirstlane((int)((LAS unsigned*)(c.lds + LDS_QW))[0]);
          if (u >= 2 * NEXP / 64) break;
#pragma unroll 1
          for (int i = 0; i < 8; ++i) { const int r = u * 64 + c.wave * 8 + i;
              if (r < NEXP) p0_table_row(c.lane, IN(13) + (size_t)r * D, IN(10), ws + WS_UF8, r, (float*)(ws + WS_SCU) + r);
              else p0_table_row(c.lane, IN(14) + (size_t)(r - NEXP) * D, nullptr, ws + WS_VF8, r - NEXP, (float*)(ws + WS_SCV) + (r - NEXP)); }
      } }
    GRID_BAR(); STAMP(4);
    { PHASE_PROLOGUE();
      pg8::Gemm g{(const bf16_t*)(ws + WS_MIXED), (const bf16_t*)(ws + WS_WOUT), NTOK, D, D}; pg8::StaticOrder S; S.init(NTOK, D, c.G, (int)blockIdx.x);
      pg8::EpiResidual E{IN(0), (bf16_t*)(ws + WS_XN), (unsigned long long*)(ws + WS_SS), D};
      pg8::gemm_phase<pg8::EpiResidual, pg8::StaticOrder, true, true>(c.lds, g, S, E); }
    GRID_BAR(); STAMP(5); STAMP(6);
    { PHASE_PROLOGUE();
      pg8::Gemm g{(const bf16_t*)(ws + WS_XN), (const bf16_t*)(ws + WS_WQ), NTOK, PQ, D}; pg8::StaticOrder S; S.init(NTOK, PQ, c.G, (int)blockIdx.x);
      pg8::EpiBf16RowScale E{(bf16_t*)(ws + WS_QP), PQ, (const unsigned long long*)(ws + WS_SS), 1.f / D, RMS_EPS};
      pg8::gemm_phase<pg8::EpiBf16RowScale, pg8::StaticOrder, true, true>(c.lds, g, S, E); }
    GRID_BAR(); STAMP(7);
    { PHASE_PROLOGUE();
      for (int blk = c.vcu; blk < NTOK / 256; blk += c.G) {
          for (int h = 0; h < PH; ++h) {
              __syncthreads();
              route_stage_subkeys(c, IN(12), h);
              __syncthreads();
              route_tile(c, blk * 8 + c.wave, h, (const bf16_t*)(ws + WS_QP), (const float*)(ws + WS_SCU), (const float*)(ws + WS_SCV), (int*)(ws + WS_EIDX), (float*)(ws + WS_GATE), (float*)(ws + WS_SUA));
          }
      } }
    GRID_BAR(); STAMP(8);
    asm volatile(".rept 6\n s_nop 0\n .endr" ::: "memory");
    { PHASE_PROLOGUE();
      const int k = (int)blockIdx.x & 7, nw = (c.G >> 3) * NWAVES, wx = ((int)blockIdx.x >> 3) * NWAVES + c.wave;
      peer_u_wave(wx, nw, k, c.lane, (const bf16_t*)(ws + WS_XN), (const int*)(ws + WS_EIDX), ws + WS_UF8, (unsigned*)(ws + WS_PART)); }
    GRID_BAR(); STAMP(9);
    { PHASE_PROLOGUE();
      for (int tok = c.gw; tok < NTOK; tok += 2 * c.NGW) peer_hid_token2(tok, (tok + c.NGW < NTOK) ? tok + c.NGW : tok, c.lane, (const unsigned*)(ws + WS_PART), (const float*)(ws + WS_SUA), (const unsigned long long*)(ws + WS_SS), (float*)(ws + WS_GATE)); }
    GRID_BAR(); STAMP(10);
    asm volatile(".rept 4\n s_nop 0\n .endr" ::: "memory");
    { PHASE_PROLOGUE();
      const int k = (int)blockIdx.x & 7, nw = (c.G >> 3) * NWAVES, wx = ((int)blockIdx.x >> 3) * NWAVES + c.wave;
      peer_v_wave(wx, nw, k, c.lane, (const int*)(ws + WS_EIDX), (const float*)(ws + WS_GATE), ws + WS_VF8, (bf16_t*)(ws + WS_PO)); }
    GRID_BAR(); STAMP(11);
    { PHASE_PROLOGUE();
      for (int row = c.gw; row < NTOK; row += c.NGW) final_norm_row(row, c.lane, (const bf16_t*)(ws + WS_XN), (const bf16_t*)(ws + WS_PO), IN(15), ap->out);
      STAMP(12);
      if (PROBE_PHASE >= 0 && blockIdx.x == 0 && threadIdx.x == 0) { asm volatile("s_waitcnt vmcnt(0)" ::: "memory"); const unsigned long long* ts = (const unsigned long long*)(ws + WS_CTL);
          ap->out[0] += (float)(PROBE_PHASE == 100 ? ts[12] - ts[0] : ts[PROBE_PHASE + 1] - ts[PROBE_PHASE]) * 1e-4f; } }
}

extern "C" void kernel_launch(void* const* d_in, const int* in_sizes, int n_in, void* d_out, int out_size, void* d_ws, size_t ws_size, hipStream_t stream) {
    static int grid = 0;
    if (grid == 0) {
        if (n_in != 16 || in_sizes[0] != NTOK * D || out_size != NTOK * D || ws_size < WS_END2) { fprintf(stderr, "kernel_launch: unexpected shapes (n_in %d in0 %d out %d ws %zu)\n", n_in, in_sizes[0], out_size, ws_size); grid = -1; return; }
        int dev = 0, cus = 0, per_cu = 0;
        if (hipGetDevice(&dev) != hipSuccess || hipDeviceGetAttribute(&cus, hipDeviceAttributeMultiprocessorCount, dev) != hipSuccess) { grid = -1; return; }
        if (hipFuncSetAttribute((const void*)fwd_megakernel, hipFuncAttributeMaxDynamicSharedMemorySize, LDS_BYTES) != hipSuccess) { fprintf(stderr, "hipFuncSetAttribute failed\n"); grid = -1; return; }
        if (hipOccupancyMaxActiveBlocksPerMultiprocessor(&per_cu, (const void*)fwd_megakernel, NTHR, LDS_BYTES) != hipSuccess || per_cu < 1) { fprintf(stderr, "occupancy query failed (%d)\n", per_cu); grid = -1; return; }
        grid = cus;
    }
    if (grid < 0) return;
    Args a{};
    for (int i = 0; i < 16; ++i) a.in[i] = (const float*)d_in[i];
    a.out = (float*)d_out; a.ws = (unsigned char*)d_ws;
    void* args[] = {&a};
    hipError_t e = hipLaunchCooperativeKernel((const void*)fwd_megakernel, dim3(grid), dim3(NTHR), args, LDS_BYTES, stream);
    if (e != hipSuccess) fprintf(stderr, "cooperative launch failed: %s (grid %d)\n", hipGetErrorString(e), grid);
}
```

```cpp
#include <hip/hip_runtime.h>
#include <hip/hip_cooperative_groups.h>
#include <cstdio>
#include <cstdint>
#include <cmath>
namespace pg8 {
#define PG8_LAS __attribute__((address_space(3)))
typedef unsigned short bf16_t;
typedef short bf16x8 __attribute__((ext_vector_type(8)));
typedef float f32x4 __attribute__((ext_vector_type(4)));
typedef unsigned u32x4 __attribute__((ext_vector_type(4)));
constexpr int BM = 256, BK = 64, HALF = 128, HTB = HALF * BK * 2  , STAGE_BYTES = 8 * HTB, NXCD = 8, WGM = 8;

__host__ __device__ __forceinline__ int lds_byte(int r, int c) { const int st = (r >> 4) * 2 + (c >> 5), rr = r & 15, cc = c & 31, ob = rr * 64 + cc * 2; return st * 1024 + (ob ^ (((ob >> 9) & 1) << 5)); }
__host__ __device__ __forceinline__ void stage_rc(int b, int& R, int& C) { const int st = b / 1024, sb = b % 1024, swz = sb ^ (((sb >> 9) & 1) << 5); R = (st >> 1) * 16 + swz / 64; C = (st & 1) * 32 + (swz % 64) / 2; }
__host__ __device__ __forceinline__ int perm32(int rho) { const int n = rho >> 4, i = rho & 15; return 8 * (i >> 2) + 4 * n + (i & 3); }

struct Unit { int pm, pn; };
struct Gemm { const bf16_t* A; const bf16_t* Bt; int M, N, K; };

struct StaticOrder {
    int nM, nN, nwg, G, c;
    __host__ __device__ void init(int M, int N, int G_, int c_) { nM = M / BM; nN = N / BM; nwg = nM * nN; G = G_; c = c_; }
    __host__ __device__ bool next(int i, Unit& u) const {
        const long L = (long)i * G + c; if (L >= nwg) return false;
        int wgid = (int)L; { const int q = nwg / NXCD, r = nwg % NXCD, xcd = wgid % NXCD, off = wgid / NXCD; wgid = (xcd < r ? xcd * (q + 1) : r * (q + 1) + (xcd - r) * q) + off; }
        const int nig = WGM * nN, gid = wgid / nig, fm = gid * WGM, gsz = (nM - fm) < WGM ? (nM - fm) : WGM;
        u.pm = fm + ((wgid % nig) % gsz); u.pn = (wgid % nig) / gsz; return true;
    }
    __device__ __forceinline__ void a_ready(const Unit&) const {}
    __device__ __forceinline__ void done(const Unit&) const {}
};

__device__ __forceinline__ unsigned cvt_pk_bf16(float lo, float hi) { unsigned r; asm volatile("v_cvt_pk_bf16_f32 %0, %1, %2" : "=v"(r) : "v"(lo), "v"(hi)); return r; }
typedef float f32x2 __attribute__((ext_vector_type(2)));
__device__ __forceinline__ f32x2 gelu_pk(f32x2 v) {
    const f32x2 av = __builtin_elementwise_abs(v), d = av * 0.2316418882f + 1.0f;
    f32x2 t; t.x = __builtin_amdgcn_rcpf(d.x); t.y = __builtin_amdgcn_rcpf(d.y);
    f32x2 q = t * 0.5307027145f + (-0.7265760135f); q = q * t + 0.7107068705f; q = q * t + (-0.142248368f); q = q * t + 0.127414796f; q = q * t;
    const f32x2 s = (v * v) * (-0.72134752044f);
    f32x2 e; e.x = __builtin_amdgcn_exp2f(s.x); e.y = __builtin_amdgcn_exp2f(s.y);
    const f32x2 m = v * (q * e), r = v - m;
    f32x2 o; o.x = v.x < 0.f ? m.x : r.x; o.y = v.y < 0.f ? m.y : r.y; return o;
}

template <int ACT  > struct EpiBf16 {
    static constexpr bool PERM = true, AFTER_DRAIN = false; static_assert(ACT == 0 || ACT == 1, "EpiBf16: ACT is 0 (none) or 1 (gelu_pk)");
    bf16_t* O; int ldc; const float* bias; int split_cols; size_t split_stride; float scale0;
    __device__ __forceinline__ void operator()(const f32x4 (&acc)[2][2][4][2], const Unit& u, int wr, int wc, int fr, int fq) const {
        const int row0 = u.pm * BM + wr * 64 + fr; int colt = u.pn * BM; bf16_t* base = O;
        float sc = 1.f; if (split_cols) { const int t = colt / split_cols; base += (size_t)t * split_stride; colt -= t * split_cols; if (t == 0) sc = scale0; }
        const int col0 = colt + wc * 32 + 8 * fq, bcol0 = u.pn * BM + wc * 32 + 8 * fq;
        f32x4 bv[2][2];
#pragma unroll
        for (int bj = 0; bj < 2; ++bj)
#pragma unroll
            for (int n = 0; n < 2; ++n) bv[bj][n] = bias ? *(const f32x4*)(bias + bcol0 + bj * HALF + 4 * n) : (f32x4){0.f, 0.f, 0.f, 0.f};
#pragma unroll
        for (int ai = 0; ai < 2; ++ai)
#pragma unroll
            for (int m = 0; m < 4; ++m) { bf16_t* rowp = base + (size_t)(row0 + ai * HALF + m * 16) * ldc + col0;
#pragma unroll
                for (int bj = 0; bj < 2; ++bj) { f32x4 v0 = acc[ai][bj][m][0] + bv[bj][0], v1 = acc[ai][bj][m][1] + bv[bj][1];
                    if (ACT == 1) { f32x2 a = gelu_pk((f32x2){v0[0], v0[1]}), b = gelu_pk((f32x2){v0[2], v0[3]}), c = gelu_pk((f32x2){v1[0], v1[1]}), d = gelu_pk((f32x2){v1[2], v1[3]});
                        v0 = (f32x4){a.x, a.y, b.x, b.y}; v1 = (f32x4){c.x, c.y, d.x, d.y}; }
                    v0 = v0 * sc; v1 = v1 * sc; u32x4 w; w.x = cvt_pk_bf16(v0[0], v0[1]); w.y = cvt_pk_bf16(v0[2], v0[3]); w.z = cvt_pk_bf16(v1[0], v1[1]); w.w = cvt_pk_bf16(v1[2], v1[3]);
                    *(u32x4*)(rowp + bj * HALF) = w; } }
    }
};
template <class Epi, class Sched, bool ALIGN_EPI = false, bool SP2 = false>
__device__ __forceinline__ void gemm_phase(PG8_LAS unsigned char* lds, const Gemm g, const Sched& S, const Epi& E) {
    int tid_l = threadIdx.x; asm volatile("" : "+v"(tid_l));
    const int tid = tid_l, wid = __builtin_amdgcn_readfirstlane(tid >> 6), lane = tid & 63, wr = wid >> 2, wc = wid & 3, fr = lane & 15, fq = lane >> 4;
    const int K = g.K, nt = K / BK;
    unsigned voffA[2], voffB[2];
#pragma unroll
    for (int i = 0; i < 2; ++i) { int R, C; stage_rc(tid * 16 + i * 8192, R, C); const int Rb = Epi::PERM ? ((R & ~31) + perm32(R & 31)) : R;
        voffA[i] = (unsigned)(R * K + C) * 2u; voffB[i] = (unsigned)(Rb * K + C) * 2u; }
    const size_t kstep = (size_t)(BK * 2);
    const size_t hstep = (size_t)HALF * K * 2;
    const size_t tstep = 2 * hstep;
    const unsigned ldsw = (unsigned)wid * 1024u;
    const int aoff = lds_byte(wr * 64 + fr, fq * 8), boff = lds_byte(wc * 32 + fr, fq * 8);
#define PG8_SA(b, h) (((b) * 2 + (h)) * HTB)
#define PG8_SB(b, h) ((4 + (b) * 2 + (h)) * HTB)
#define PG8_STAGE(bufoff, gbase, voff) do { _Pragma("unroll") for (int _i = 0; _i < 2; ++_i) \
        __builtin_amdgcn_global_load_lds((const unsigned*)((const char*)(gbase) + (voff)[_i]), (PG8_LAS unsigned*)(lds + (bufoff) + ldsw + _i * 8192), 16, 0, 0); } while (0)
#define PG8_LDA(dst, b, h) do { _Pragma("unroll") for (int m = 0; m < 4; ++m) _Pragma("unroll") for (int k = 0; k < 2; ++k) dst[m][k] = *(const PG8_LAS bf16x8*)(lds + PG8_SA(b, h) + aoff + m * 2048 + k * 1024); } while (0)
#define PG8_LDB(dst, b, h) do { _Pragma("unroll") for (int n = 0; n < 2; ++n) _Pragma("unroll") for (int k = 0; k < 2; ++k) dst[n][k] = *(const PG8_LAS bf16x8*)(lds + PG8_SB(b, h) + boff + n * 2048 + k * 1024); } while (0)
#define PG8_MMA(ai, bj, At, Bt) do { __builtin_amdgcn_s_setprio(1); _Pragma("unroll") for (int m = 0; m < 4; ++m) _Pragma("unroll") for (int n = 0; n < 2; ++n) _Pragma("unroll") for (int k = 0; k < 2; ++k) \
        acc[ai][bj][m][n] = __builtin_amdgcn_mfma_f32_16x16x32_bf16(Bt[n][k], At[m][k], acc[ai][bj][m][n], 0, 0, 0); __builtin_amdgcn_s_setprio(0); } while (0)
#define PG8_WAIT_V(n) asm volatile("s_waitcnt vmcnt(" #n ")" ::: "memory")
#define PG8_WAIT_L(n) asm volatile("s_waitcnt lgkmcnt(" #n ")" ::: "memory")
#define PG8_BAR __builtin_amdgcn_s_barrier()
#define PG8_SCHED __builtin_amdgcn_sched_barrier(0)
    Unit cur, nxt; int ui = 0;
    if (!S.next(0, cur)) return;
    f32x4 acc[2][2][4][2];
#pragma unroll
    for (int a = 0; a < 2; ++a)
#pragma unroll
        for (int b = 0; b < 2; ++b)
#pragma unroll
            for (int m = 0; m < 4; ++m)
#pragma unroll
                for (int n = 0; n < 2; ++n) acc[a][b][m][n] = (f32x4){0.f, 0.f, 0.f, 0.f};
    bf16x8 At[4][2], B0[2][2], B1[2][2];
    const char* cA = (const char*)g.A + (size_t)cur.pm * tstep; const char* cB = (const char*)g.Bt + (size_t)cur.pn * tstep;
    S.a_ready(cur);
    if constexpr (SP2) {
        PG8_STAGE(PG8_SB(0, 0), cB, voffB); PG8_STAGE(PG8_SB(0, 1), cB + hstep, voffB); PG8_STAGE(PG8_SA(0, 0), cA, voffA); PG8_STAGE(PG8_SA(0, 1), cA + hstep, voffA);
        if (wr == 1) PG8_BAR;
        PG8_WAIT_V(2); PG8_BAR;
        PG8_STAGE(PG8_SB(1, 0), cB + kstep, voffB); PG8_STAGE(PG8_SA(1, 0), cA + kstep, voffA); PG8_STAGE(PG8_SB(1, 1), cB + hstep + kstep, voffB);
        PG8_WAIT_V(6); PG8_BAR;
    } else {
        PG8_STAGE(PG8_SB(0, 0), cB, voffB); PG8_STAGE(PG8_SA(0, 0), cA, voffA); PG8_STAGE(PG8_SB(0, 1), cB + hstep, voffB); PG8_STAGE(PG8_SA(0, 1), cA + hstep, voffA);
        if (wr == 1) PG8_BAR;
        PG8_WAIT_V(4); PG8_BAR;
        PG8_STAGE(PG8_SB(1, 0), cB + kstep, voffB); PG8_STAGE(PG8_SA(1, 0), cA + kstep, voffA); PG8_STAGE(PG8_SB(1, 1), cB + hstep + kstep, voffB);
        PG8_WAIT_V(6); PG8_BAR;
    }
    for (;;) {
        const bool has_next = S.next(ui + 1, nxt);
        const char* nA = has_next ? (const char*)g.A + (size_t)nxt.pm * tstep : cA; const char* nB = has_next ? (const char*)g.Bt + (size_t)nxt.pn * tstep : cB;
        for (int t = 0; t < nt; t += 2) {
            const bool last = (t == nt - 2);
            const char* a1 = cA + (size_t)(t + 1) * kstep;
            const char* a2 = last ? nA : cA + (size_t)(t + 2) * kstep; const char* b2 = last ? nB : cB + (size_t)(t + 2) * kstep;
            const char* a3 = a2 + kstep; const char* b3 = b2 + kstep;
            if (last && has_next) S.a_ready(nxt);
            if constexpr (SP2) {
            PG8_LDB(B0, 0, 0); PG8_LDB(B1, 0, 1); PG8_SCHED; PG8_LDA(At, 0, 0); PG8_STAGE(PG8_SA(1, 1), a1 + hstep, voffA);
            PG8_WAIT_V(8); PG8_WAIT_L(0); PG8_BAR; PG8_MMA(0, 0, At, B0); PG8_MMA(0, 1, At, B1); PG8_BAR; PG8_SCHED;
            PG8_LDA(At, 0, 1); PG8_STAGE(PG8_SB(0, 0), b2, voffB); PG8_STAGE(PG8_SB(0, 1), b2 + hstep, voffB); PG8_STAGE(PG8_SA(0, 0), a2, voffA);
            PG8_WAIT_V(8); PG8_WAIT_L(0); PG8_BAR; PG8_MMA(1, 0, At, B0); PG8_MMA(1, 1, At, B1); PG8_BAR; PG8_SCHED;
            PG8_LDB(B0, 1, 0); PG8_LDB(B1, 1, 1); PG8_SCHED; PG8_LDA(At, 1, 0); PG8_STAGE(PG8_SA(0, 1), a2 + hstep, voffA);
            PG8_WAIT_V(8); PG8_WAIT_L(0); PG8_BAR; PG8_MMA(0, 0, At, B0); PG8_MMA(0, 1, At, B1); PG8_BAR; PG8_SCHED;
            PG8_LDA(At, 1, 1); PG8_STAGE(PG8_SB(1, 0), b3, voffB); PG8_STAGE(PG8_SB(1, 1), b3 + hstep, voffB); PG8_STAGE(PG8_SA(1, 0), a3, voffA);
            PG8_WAIT_V(8); PG8_WAIT_L(0); PG8_BAR; PG8_MMA(1, 0, At, B0); PG8_MMA(1, 1, At, B1); PG8_BAR; PG8_SCHED;
            } else {
            PG8_LDB(B0, 0, 0); PG8_SCHED; PG8_LDA(At, 0, 0); PG8_STAGE(PG8_SA(1, 1), a1 + hstep, voffA);
            PG8_WAIT_L(8); PG8_BAR; PG8_WAIT_L(0); PG8_MMA(0, 0, At, B0); PG8_BAR; PG8_SCHED;
            PG8_LDB(B1, 0, 1); PG8_STAGE(PG8_SB(0, 0), b2, voffB);
            PG8_BAR; PG8_WAIT_L(0); PG8_MMA(0, 1, At, B1); PG8_BAR;
            PG8_LDA(At, 0, 1); PG8_STAGE(PG8_SA(0, 0), a2, voffA);
            PG8_BAR; PG8_WAIT_L(0); PG8_MMA(1, 0, At, B0); PG8_BAR; PG8_SCHED;
            PG8_STAGE(PG8_SB(0, 1), b2 + hstep, voffB);
            PG8_WAIT_V(6); PG8_BAR; PG8_MMA(1, 1, At, B1); PG8_BAR;
            PG8_LDB(B0, 1, 0); PG8_SCHED; PG8_LDA(At, 1, 0); PG8_STAGE(PG8_SA(0, 1), a2 + hstep, voffA);
            PG8_WAIT_L(8); PG8_BAR; PG8_WAIT_L(0); PG8_MMA(0, 0, At, B0); PG8_BAR; PG8_SCHED;
            PG8_LDB(B1, 1, 1); PG8_STAGE(PG8_SB(1, 0), b3, voffB);
            PG8_BAR; PG8_WAIT_L(0); PG8_MMA(0, 1, At, B1); PG8_BAR;
            PG8_LDA(At, 1, 1); PG8_STAGE(PG8_SA(1, 0), a3, voffA);
            PG8_BAR; PG8_WAIT_L(0); PG8_MMA(1, 0, At, B0); PG8_BAR; PG8_SCHED;
            PG8_STAGE(PG8_SB(1, 1), b3 + hstep, voffB);
            PG8_WAIT_V(6); PG8_BAR; PG8_MMA(1, 1, At, B1); PG8_BAR;
            }
        }
        if constexpr (ALIGN_EPI) { if (wr == 0) PG8_BAR; }
        if constexpr (!Epi::AFTER_DRAIN) { E(acc, cur, wr, wc, fr, fq); S.done(cur); }
        if (!has_next) break;
#pragma unroll
        for (int a = 0; a < 2; ++a)
#pragma unroll
            for (int b = 0; b < 2; ++b)
#pragma unroll
                for (int m = 0; m < 4; ++m)
#pragma unroll
                    for (int n = 0; n < 2; ++n) acc[a][b][m][n] = (f32x4){0.f, 0.f, 0.f, 0.f};
        cur = nxt; cA = nA; cB = nB; ++ui;
        if constexpr (ALIGN_EPI) { if (wr == 1) PG8_BAR; }
    }
    PG8_WAIT_V(0);
    if constexpr (!ALIGN_EPI) { if (wr == 0) PG8_BAR; }
    PG8_BAR;
    if constexpr (Epi::AFTER_DRAIN) { E.fused(acc, cur, wr, wc, fr, fq, lds, wid, lane); S.done(cur); }
#undef PG8_SA
#undef PG8_SB
#undef PG8_STAGE
#undef PG8_LDA
#undef PG8_LDB
#undef PG8_MMA
#undef PG8_WAIT_V
#undef PG8_WAIT_L
#undef PG8_BAR
#undef PG8_SCHED
}
}
#include <hip/hip_bf16.h>
#include <cmath>
namespace attn_body {
using bf16=__hip_bfloat16;
using bf16x8=__attribute__((ext_vector_type(8)))short;
using s16x4=__attribute__((ext_vector_type(4)))short;
using f32x16=__attribute__((ext_vector_type(16)))float;
using u32x4=__attribute__((ext_vector_type(4)))unsigned;
constexpr int SEQ=4096,D=64,DM=3072;
constexpr int NW=8,QBLK=32,QB=QBLK*NW,KVBLK=64,NQB=SEQ/QB;
constexpr int ATTN_UNIT_ROWS=QB;
__device__ __forceinline__ int crow(int r,int hi){return (r&3)+8*(r>>2)+4*hi;}
#define SBAR() __builtin_amdgcn_sched_barrier(0)
__device__ __forceinline__ void cmask(f32x16&p0,f32x16&p1,int jb,int qrel,int hi){
  asm volatile("":"+v"(qrel),"+v"(hi));
  const float NEG=-INFINITY; int kb=64*jb+4*hi;
  #pragma unroll
  for(int r=0;r<16;++r){int kv=kb+(r&3)+8*(r>>2); if(kv>qrel)p0[r]=NEG; if(kv+32>qrel)p1[r]=NEG;}
}

constexpr int NSLOT=3, SLOTB=8192;
constexpr int LDS_K=0, LDS_V=NSLOT*SLOTB, LDS_WS=2*NSLOT*SLOTB, LDS_OST=LDS_WS+NW*64*4, LDS_FEAT=LDS_OST+NW*4096, LDS_BYTES=LDS_FEAT+SEQ*8;
constexpr float C2=0.125f*1.4426950408889634f;
__device__ __forceinline__ void glds16(const void*gsrc,unsigned lds_dst){unsigned keep;
  asm volatile("s_mov_b32 %0, m0\n\ts_mov_b32 m0, %2\n\ts_nop 0\n\tglobal_load_lds_dwordx4 %1, off\n\ts_mov_b32 m0, %0":"=&s"(keep):"v"(gsrc),"s"(lds_dst):"memory");}
__device__ __forceinline__ float max3f(float a,float b,float c){float r;asm("v_max3_f32 %0, %1, %2, %3":"=v"(r):"v"(a),"v"(b),"v"(c));return r;}
__device__ __forceinline__ float max2f(float a,float b){float r;asm("v_max_f32_e32 %0, %1, %2":"=v"(r):"v"(a),"v"(b));return r;}
__device__ __forceinline__ float fadd_s(float a,float b){float r;asm("v_add_f32_e32 %0, %1, %2":"=v"(r):"v"(a),"v"(b));return r;}
__device__ __forceinline__ float fsub_s(float a,float b){float r;asm("v_sub_f32_e32 %0, %1, %2":"=v"(r):"v"(a),"v"(b));return r;}
typedef float f32x2_t __attribute__((ext_vector_type(2))); typedef __bf16 bf16x2_t __attribute__((ext_vector_type(2)));
__device__ __forceinline__ unsigned cvtpk_s(float lo,float hi){f32x2_t v={lo,hi};bf16x2_t b=__builtin_convertvector(v,bf16x2_t);return __builtin_bit_cast(unsigned,b);}
#define WAIT_BAR(N) asm volatile("s_waitcnt vmcnt(" #N ") lgkmcnt(0)\n\ts_barrier":::"memory")

__device__ __forceinline__ void qkt(f32x16&p0,f32x16&p1,const char*Kslot,const bf16x8*qr,bf16x8 ax0,bf16x8 ax1,bf16x8 qx,int r32,int hi){
  const char*kb=Kslot+hi*1024+r32*16;
  const f32x16 z=f32x16{};
  p0=__builtin_amdgcn_mfma_f32_32x32x16_bf16(ax0,qx,z,0,0,0);p1=__builtin_amdgcn_mfma_f32_32x32x16_bf16(ax1,qx,z,0,0,0);
  #pragma unroll
  for(int d0=0;d0<4;++d0){
    const bf16x8 b0=*reinterpret_cast<const bf16x8*>(kb+d0*2048);
    const bf16x8 b1=*reinterpret_cast<const bf16x8*>(kb+d0*2048+512);
    p0=__builtin_amdgcn_mfma_f32_32x32x16_bf16(b0,qr[d0],p0,0,0,0);p1=__builtin_amdgcn_mfma_f32_32x32x16_bf16(b1,qr[d0],p1,0,0,0);}
}
typedef __attribute__((address_space(3))) const char* lds_cptr;
typedef short v4i16_t __attribute__((ext_vector_type(4)));
__device__ __forceinline__ void kload8(bf16x8*kf,lds_cptr kp){
  kf[0]=*(const __attribute__((address_space(3))) bf16x8*)(kp);      kf[1]=*(const __attribute__((address_space(3))) bf16x8*)(kp+512);
  kf[2]=*(const __attribute__((address_space(3))) bf16x8*)(kp+2048); kf[3]=*(const __attribute__((address_space(3))) bf16x8*)(kp+2560);
  kf[4]=*(const __attribute__((address_space(3))) bf16x8*)(kp+4096); kf[5]=*(const __attribute__((address_space(3))) bf16x8*)(kp+4608);
  kf[6]=*(const __attribute__((address_space(3))) bf16x8*)(kp+6144); kf[7]=*(const __attribute__((address_space(3))) bf16x8*)(kp+6656);
}
__device__ __forceinline__ void kload2(bf16x8*kf,lds_cptr kp,int j){ kf[2*j]=*(const __attribute__((address_space(3))) bf16x8*)(kp+j*2048); kf[2*j+1]=*(const __attribute__((address_space(3))) bf16x8*)(kp+j*2048+512); }
__device__ __forceinline__ s16x4 vtr(lds_cptr p){ return __builtin_bit_cast(s16x4,__builtin_amdgcn_ds_read_tr16_b64_v4i16((__attribute__((address_space(3))) v4i16_t*)p)); }
__device__ __forceinline__ float rowmax(const f32x16&p0,const f32x16&p1){
  float a=max3f(p0[0],p0[1],p1[0]),b=max3f(p0[2],p0[3],p1[1]);a=max3f(a,p1[2],p1[3]);
  #pragma unroll
  for(int r=4;r<16;r+=4){a=max3f(a,p0[r],p0[r+1]);b=max3f(b,p0[r+2],p0[r+3]);a=max3f(a,p1[r],p1[r+1]);b=max3f(b,p1[r+2],p1[r+3]);}
  const float m=max2f(a,b);
  auto rr=__builtin_amdgcn_permlane32_swap(__float_as_uint(m),__float_as_uint(m),false,false);
  return max2f(__uint_as_float(rr[0]),__uint_as_float(rr[1]));
}
__device__ __forceinline__ void pv(f32x16*o,int vb,bf16x8 pa0,bf16x8 pa1,bf16x8 pa2,bf16x8 pa3){
  #pragma unroll
  for(int d0=0;d0<2;++d0){s16x4 lo[4],hi[4];
    #pragma unroll
    for(int ks=0;ks<4;++ks){
      asm volatile("ds_read_b64_tr_b16 %0,%1 offset:%c2":"=&v"(lo[ks]):"v"(vb),"i"(d0*4096+ks*1024):"memory");
      asm volatile("ds_read_b64_tr_b16 %0,%1 offset:%c2":"=&v"(hi[ks]):"v"(vb),"i"(d0*4096+ks*1024+512):"memory");}
    asm volatile("s_waitcnt lgkmcnt(0)":::"memory");SBAR();
    #define PK(k) (bf16x8){lo[k][0],lo[k][1],lo[k][2],lo[k][3],hi[k][0],hi[k][1],hi[k][2],hi[k][3]}
    o[d0]=__builtin_amdgcn_mfma_f32_32x32x16_bf16(pa0,PK(0),o[d0],0,0,0);
    o[d0]=__builtin_amdgcn_mfma_f32_32x32x16_bf16(pa1,PK(1),o[d0],0,0,0);
    o[d0]=__builtin_amdgcn_mfma_f32_32x32x16_bf16(pa2,PK(2),o[d0],0,0,0);
    o[d0]=__builtin_amdgcn_mfma_f32_32x32x16_bf16(pa3,PK(3),o[d0],0,0,0);
    #undef PK
  }
}


typedef unsigned u32x2 __attribute__((ext_vector_type(2)));
__device__ __forceinline__ void split3(float v,unsigned&h16,unsigned&m16,unsigned&l16){
  const unsigned uh=__float_as_uint(v)&0xffff0000u; const float r1=v-__uint_as_float(uh);
  const unsigned um=__float_as_uint(r1)&0xffff0000u; const float r2=r1-__uint_as_float(um);
  const unsigned ul=__float_as_uint(r2); h16=uh>>16; m16=um>>16; l16=(ul+0x7fffu+((ul>>16)&1u))>>16;
}
__device__ __forceinline__ bf16x8 make_qx(float qc){ unsigned h,m,l; split3(qc,h,m,l); const u32x4 w={0x3f803f80u,0x3f80u|(h<<16),m|(l<<16),0u}; return __builtin_bit_cast(bf16x8,w); }
__device__ __forceinline__ void dmask(f32x16&p0,f32x16&p1,int jb,int wid,int r32,int hi,float slope2){
  asm volatile("":"+v"(r32),"+v"(hi));
  const int dj=wid>>1, qrel=32*(wid&1)+r32; const float slope2x2=2.f*slope2;
  if(jb>dj){
    #pragma unroll
    for(int r=0;r<16;++r){p0[r]=-INFINITY;p1[r]=-INFINITY;}
  } else if(jb==dj){
    #pragma unroll
    for(int r=0;r<16;++r){const int kv=4*hi+(r&3)+8*(r>>2); if(kv>qrel)p0[r]-=slope2x2*(float)(kv-qrel); if(kv+32>qrel)p1[r]-=slope2x2*(float)(kv+32-qrel);}
  }
}

template<int MODE> __device__ __forceinline__ int attn_jmin(int qb,float bound,const float*__restrict__ cumf,float slope2,int lane){
  const int NTt=4*qb+4, q0=256*qb; bool negl=false;
  if(lane<NTt-4){ const float bias=(MODE==0)?((cumf[q0]-cumf[64*lane+63])*1.4426950408889634f):(-slope2*(float)(q0-(64*lane+63))); negl=(bound+bias)<-160.f; }
  const unsigned long long m=__ballot(negl); const int n=(m==~0ull)?64:(__ffsll((long long)~m)-1);
  return n&~1;
}
template<int MODE,int THRL> __device__ __forceinline__ void attn_pass(int qb,int jmin,const bf16*Qh,const bf16*__restrict__ Kh0,const bf16*__restrict__ Vh0,const float*__restrict__ cumf,float slope2,char*shm,f32x16(&o)[2]){
  const bf16*__restrict__ Kh=Kh0+(long)jmin*KVBLK*DM; const bf16*__restrict__ Vh=Vh0+(long)jmin*KVBLK*DM;
  int tid_l=threadIdx.x; asm volatile("":"+v"(tid_l));
  const int tid=tid_l,lane=tid&63,r32=lane&31,hi=lane>>5; const int wid=__builtin_amdgcn_readfirstlane(tid>>6);
  const int q0=qb*QB;
  const bf16*Qw=Qh+(long)(q0+wid*QBLK)*DM;
  const unsigned lds0=(unsigned)(uintptr_t)shm;
  float*wsf=(float*)(shm+LDS_WS)+wid*64;
  const int NT=(q0+QB)/KVBLK-jmin;
  const lds_cptr shm3=(lds_cptr)shm;
  const __attribute__((address_space(3))) u32x2*featr=(const __attribute__((address_space(3))) u32x2*)(shm3+LDS_FEAT)+lane;
  #define AXF0(f) __builtin_bit_cast(bf16x8,(u32x4){hi?0u:(f).x,hi?0u:(f).y,hi?0u:0x3f803f80u,0u})
  #define AXF1(f) __builtin_bit_cast(bf16x8,(u32x4){hi?(f).x:0u,hi?(f).y:0u,hi?0x3f803f80u:0u,0u})
  const bf16*ksrc=Kh+(long)lane*DM+wid*8;
  const bf16*vsrc=Vh+(long)(16*(wid&3)+(lane>>2))*DM+(wid>>2)*32+(lane&3)*8;
  const unsigned kdst=lds0+LDS_K+wid*1024, vdst=lds0+LDS_V+wid*1024;
  #define DMA_K(t,slot) glds16(ksrc+(long)(t)*KVBLK*DM,(unsigned)__builtin_amdgcn_readfirstlane(kdst+(slot)))
  #define DMA_V(t,slot) glds16(vsrc+(long)(t)*KVBLK*DM,(unsigned)__builtin_amdgcn_readfirstlane(vdst+(slot)))
  const int vb0=(int)(lds0+LDS_V)+((lane>>4)&1)*32+(lane&3)*8+(4*hi+((lane&15)>>2))*64;
  const char*Kbase=shm+LDS_K; bf16x8 kf[8];
  const lds_cptr kp0=shm3+LDS_K+hi*1024+r32*16; const lds_cptr vp0=shm3+LDS_V+((lane>>4)&1)*32+(lane&3)*8+(4*hi+((lane&15)>>2))*64;
  const float qc=(MODE==0)?(cumf[q0+wid*QBLK+r32]*1.4426950408889634f):(-slope2*(float)(q0+wid*QBLK+r32));
  DMA_K(0,0);DMA_V(0,0);DMA_K(1,SLOTB);
  bf16x8 qr[4];
  #pragma unroll
  for(int d0=0;d0<4;++d0)qr[d0]=*reinterpret_cast<const bf16x8*>(&Qw[(long)r32*DM+d0*16+hi*8]);
  { __attribute__((address_space(3))) u32x2*feat=(__attribute__((address_space(3))) u32x2*)(shm+LDS_FEAT);
    if(MODE==0){ float cv[8];
      #pragma unroll
      for(int i=0;i<8;++i){ const int s=tid+NW*64*i; cv[i]=(s<64*NT)?cumf[s+64*jmin]:0.f; }
      #pragma unroll
      for(int i=0;i<8;++i){ const int s=tid+NW*64*i; if(s<64*NT){ unsigned h,m,l; split3(-cv[i]*1.4426950408889634f,h,m,l); u32x2 w; w.x=h|(m<<16); w.y=l|0x3f800000u; feat[s]=w; } } }
    else for(int s=tid;s<64*NT;s+=NW*64){ const int sg=s+64*jmin; const float kx=slope2*(float)sg; unsigned h,m,l; split3(kx,h,m,l); u32x2 w; w.x=h|(m<<16); w.y=l|0x3f800000u; feat[s]=w; } }
  float qcm=qc,l_reg=0.f;o[0]=f32x16{};o[1]=f32x16{};
  bf16x8 qx=make_qx(qcm);
  const int qrel=wid*QBLK+r32;
  #define CMASK(P0,P1,t) do{int jb_=(t)-(NT-4); if(jb_>=0){ if(MODE==0)cmask(P0,P1,jb_,qrel,hi); else dmask(P0,P1,jb_,wid,r32,hi,slope2);} }while(0)
  bool resc=false;
  #define RESC() do{ if(resc){ asm volatile("s_waitcnt lgkmcnt(0)":::"memory"); \
      _Pragma("unroll") for(int d_=0;d_<2;++d_) _Pragma("unroll") for(int r=0;r<16;++r)o[d_][r]*=wsf[crow(r,hi)]; } }while(0)
  f32x16 pA0,pA1,pB0,pB1;
  int sl_prev=0,sl_cur=0,sl_next=SLOTB;
  #define ROT() do{sl_prev=sl_cur;sl_cur=sl_next;sl_next=(sl_next==(NSLOT-1)*SLOTB)?0:sl_next+SLOTB;}while(0)
  DMA_K(2,2*SLOTB);
  WAIT_BAR(3);
  u32x2 fx=featr[0];
  qkt(pA0,pA1,Kbase,qr,AXF0(fx),AXF1(fx),qx,r32,hi);asm volatile("s_nop 15\n\ts_nop 7":"+v"(pA0),"+v"(pA1));CMASK(pA0,pA1,0);
  { const float rm=rowmax(pA0,pA1); const float dl=(rm>(float)THRL)?rm:0.f; qcm-=dl;
    _Pragma("unroll") for(int r=0;r<16;++r){pA0[r]=fsub_s(pA0[r],dl);pA1[r]=fsub_s(pA1[r],dl);}
    qx=make_qx(qcm);
    _Pragma("unroll") for(int r=0;r<16;++r)pA0[r]=__builtin_amdgcn_exp2f(pA0[r]); }
  _Pragma("unroll") for(int r=0;r<16;++r)pA1[r]=__builtin_amdgcn_exp2f(pA1[r]);
  fx=featr[64];
  WAIT_BAR(0);
  DMA_K(3,0);DMA_V(1,SLOTB);
  ROT();
  kload8(kf,kp0+sl_cur);
  WAIT_BAR(2);
  s16x4 vlo[8],vhi[8]; u32x4 pw0,pw1,pw2,pw3;
  #define PKW(P,B) cvtpk_s(P[B],P[B+1])
  #define PAF(k) __builtin_bit_cast(bf16x8,pw##k)
  #define VFR(i) (bf16x8){vlo[i][0],vlo[i][1],vlo[i][2],vlo[i][3],vhi[i][0],vhi[i][1],vhi[i][2],vhi[i][3]}
  #define PIN(x) asm volatile("":"+v"(x))
  #define MX3(a,b,c) __builtin_fmaxf(__builtin_fmaxf((a),(b)),(c))
  #define GAPA(MF,A0,A1,A2,A3,W0,W1,PW) do{ MF; sacc+=A0; sacc+=A1; sacc+=A2; sacc+=A3; PIN(sacc); W0; W1; PIN(PW); SBAR(); }while(0)
  #define EX(v) __builtin_amdgcn_exp2f(v)
  #define GAPB(MF,X,B) do{ MF; X[B]=EX(X[B]); X[B+1]=EX(X[B+1]); X[B+2]=EX(X[B+2]); X[B+3]=EX(X[B+3]); PIN(X); SBAR(); }while(0)
  #define VRD(i) do{ vlo[i]=vtr(vp_+(((i)>>2)*4096+((i)&3)*1024)); vhi[i]=vtr(vp_+(((i)>>2)*4096+((i)&3)*1024+512)); }while(0)
  #define KRD(G,j) do{ if(G){ kload2(kf,kp0+sl_next,j); SBAR(); } }while(0)
  #define STEP(C0,C1,P0,P1,t,GK,GV,GL) do{ SBAR(); \
    const lds_cptr vp_=vp0+sl_prev; \
    { const bf16x8 ax0_=AXF0(fx), ax1_=AXF1(fx); const f32x16 z_=f32x16{}; \
      C0=__builtin_amdgcn_mfma_f32_32x32x16_bf16(ax0_,qx,z_,0,0,0); C1=__builtin_amdgcn_mfma_f32_32x32x16_bf16(ax1_,qx,z_,0,0,0); SBAR(); } \
    VRD(0); SBAR(); float sacc=(P0[0]+P0[1]); \
    GAPA(C0=__builtin_amdgcn_mfma_f32_32x32x16_bf16(kf[0],qr[0],C0,0,0,0), P0[2],P0[3],P0[4],P0[5],     pw0[0]=PKW(P0,0), pw0[1]=PKW(P0,2), pw0); \
    VRD(4); SBAR(); GAPA(C1=__builtin_amdgcn_mfma_f32_32x32x16_bf16(kf[1],qr[0],C1,0,0,0), P0[6],P0[7],P0[8],P0[9],     pw0[2]=PKW(P0,4), pw0[3]=PKW(P0,6), pw0); \
    VRD(1); SBAR(); GAPA(C0=__builtin_amdgcn_mfma_f32_32x32x16_bf16(kf[2],qr[1],C0,0,0,0),   P0[10],P0[11],P0[12],P0[13], pw1[0]=PKW(P0,8), pw1[1]=PKW(P0,10), pw1); \
    VRD(5); SBAR(); GAPA(C1=__builtin_amdgcn_mfma_f32_32x32x16_bf16(kf[3],qr[1],C1,0,0,0),   P0[14],P0[15],P1[0],P1[1],   pw1[2]=PKW(P0,12),pw1[3]=PKW(P0,14), pw1); \
    VRD(2); SBAR(); GAPA(C0=__builtin_amdgcn_mfma_f32_32x32x16_bf16(kf[4],qr[2],C0,0,0,0),   P1[2],P1[3],P1[4],P1[5],     pw2[0]=PKW(P1,0), pw2[1]=PKW(P1,2), pw2); \
    VRD(6); SBAR(); GAPA(C1=__builtin_amdgcn_mfma_f32_32x32x16_bf16(kf[5],qr[2],C1,0,0,0),   P1[6],P1[7],P1[8],P1[9],     pw2[2]=PKW(P1,4), pw2[3]=PKW(P1,6), pw2); \
    VRD(3); SBAR(); GAPA(C0=__builtin_amdgcn_mfma_f32_32x32x16_bf16(kf[6],qr[3],C0,0,0,0),   P1[10],P1[11],P1[12],P1[13], pw3[0]=PKW(P1,8), pw3[1]=PKW(P1,10), pw3); \
    VRD(7); SBAR(); GAPA(C1=__builtin_amdgcn_mfma_f32_32x32x16_bf16(kf[7],qr[3],C1,0,0,0),   P1[14],P1[15],0.f,0.f,       pw3[2]=PKW(P1,12),pw3[3]=PKW(P1,14), pw3); \
    l_reg+=sacc; \
    if(GK){DMA_K((t)+3,sl_cur);} if(GV){DMA_V((t)+1,sl_next);} \
    CMASK(C0,C1,t); \
    { float a=MX3(C0[0],C0[1],C1[0]),b=MX3(C0[2],C0[3],C1[1]); a=MX3(a,C1[2],C1[3]); \
      _Pragma("unroll") for(int r=4;r<16;r+=4){a=MX3(a,C0[r],C0[r+1]);b=MX3(b,C0[r+2],C0[r+3]);a=MX3(a,C1[r],C1[r+1]);b=MX3(b,C1[r+2],C1[r+3]);} \
      float rm=__builtin_fmaxf(a,b); { auto rr=__builtin_amdgcn_permlane32_swap(__float_as_uint(rm),__float_as_uint(rm),false,false); rm=__builtin_fmaxf(__uint_as_float(rr[0]),__uint_as_float(rr[1])); } \
      resc=false; \
      if(__builtin_expect(__any(rm>(float)THRL),0)){ const float dl=__builtin_fmaxf(rm,0.f); qcm-=dl; \
        _Pragma("unroll") for(int r=0;r<16;++r){C0[r]-=dl;C1[r]-=dl;} \
        qx=make_qx(qcm); \
        const float f=__builtin_amdgcn_exp2f(-dl); l_reg*=f; if(hi==0)wsf[r32]=f; resc=true; } } \
    SBAR(); \
    GAPB(o[0]=__builtin_amdgcn_mfma_f32_32x32x16_bf16(PAF(0),VFR(0),o[0],0,0,0), C0,0); \
    GAPB(o[1]=__builtin_amdgcn_mfma_f32_32x32x16_bf16(PAF(0),VFR(4),o[1],0,0,0), C0,4); \
    KRD(GL,0); GAPB(o[0]=__builtin_amdgcn_mfma_f32_32x32x16_bf16(PAF(1),VFR(1),o[0],0,0,0), C0,8); \
    KRD(GL,1); GAPB(o[1]=__builtin_amdgcn_mfma_f32_32x32x16_bf16(PAF(1),VFR(5),o[1],0,0,0), C0,12); \
    KRD(GL,2); GAPB(o[0]=__builtin_amdgcn_mfma_f32_32x32x16_bf16(PAF(2),VFR(2),o[0],0,0,0), C1,0); \
    KRD(GL,3); GAPB(o[1]=__builtin_amdgcn_mfma_f32_32x32x16_bf16(PAF(2),VFR(6),o[1],0,0,0), C1,4); \
    if(GL){ fx=featr[64*((t)+1)]; SBAR(); } \
    GAPB(o[0]=__builtin_amdgcn_mfma_f32_32x32x16_bf16(PAF(3),VFR(3),o[0],0,0,0), C1,8); \
    GAPB(o[1]=__builtin_amdgcn_mfma_f32_32x32x16_bf16(PAF(3),VFR(7),o[1],0,0,0), C1,12); \
    }while(0)
  int t=1;
  #undef CMASK
  #define CMASK(P0,P1,t) do{}while(0)
  for(;t+5<NT;t+=2){
    STEP(pB0,pB1,pA0,pA1,t,true,true,true);     WAIT_BAR(2); RESC(); ROT();
    STEP(pA0,pA1,pB0,pB1,t+1,true,true,true);   WAIT_BAR(2); RESC(); ROT();
  }
  #undef CMASK
  #define CMASK(P0,P1,t) do{int jb_=(t)-(NT-4); if(jb_>=0){ if(MODE==0)cmask(P0,P1,jb_,qrel,hi); else dmask(P0,P1,jb_,wid,r32,hi,slope2);} }while(0)
  #define ENDW(tt) do{ if((tt)+3<NT){WAIT_BAR(2);} else if((tt)+2<NT){WAIT_BAR(1);} else {WAIT_BAR(0);} }while(0)
  for(;t+1<NT;t+=2){
    STEP(pB0,pB1,pA0,pA1,t,(t+3<NT),(t+1<NT),(t+1<NT));       ENDW(t);   RESC(); ROT();
    STEP(pA0,pA1,pB0,pB1,t+1,(t+4<NT),(t+2<NT),(t+2<NT));     ENDW(t+1); RESC(); ROT();
  }
  STEP(pB0,pB1,pA0,pA1,NT-1,false,false,false); RESC();
  { float sacc=pB0[0]+pB0[1]; _Pragma("unroll") for(int r=2;r<16;++r)sacc+=pB0[r]; _Pragma("unroll") for(int r=0;r<16;++r)sacc+=pB1[r]; l_reg+=sacc;
    pw0=(u32x4){PKW(pB0,0),PKW(pB0,2),PKW(pB0,4),PKW(pB0,6)};pw1=(u32x4){PKW(pB0,8),PKW(pB0,10),PKW(pB0,12),PKW(pB0,14)};pw2=(u32x4){PKW(pB1,0),PKW(pB1,2),PKW(pB1,4),PKW(pB1,6)};pw3=(u32x4){PKW(pB1,8),PKW(pB1,10),PKW(pB1,12),PKW(pB1,14)};
    SBAR(); pv(o,vb0+sl_cur,PAF(0),PAF(1),PAF(2),PAF(3)); }
  #undef PKW
  #undef PAF
  #undef VFR
  #undef PIN
  #undef MX3
  #undef GAPA
  #undef GAPB
  #undef EX
  #undef VRD
  #undef KRD
  #undef STEP
  #undef ENDW
  {auto rr=__builtin_amdgcn_permlane32_swap(__float_as_uint(l_reg),__float_as_uint(l_reg),false,false);l_reg=__uint_as_float(rr[0])+__uint_as_float(rr[1]);}
  if(hi==0)wsf[32+r32]=l_reg;asm volatile("s_waitcnt lgkmcnt(0)":::"memory");
  #pragma unroll
  for(int r=0;r<16;++r){const float rli=__builtin_amdgcn_rcpf(wsf[32+crow(r,hi)]); o[0][r]*=rli; o[1][r]*=rli;}
  asm volatile("s_waitcnt lgkmcnt(0)\n\ts_barrier":::"memory");
  #undef DMA_K
  #undef DMA_V
  #undef CMASK
  #undef RESC
  #undef ROT
  #undef AXF0
  #undef AXF1
}
constexpr int D2_K=0, D2_V=4*8192, D2_VS=16384, D2_WS=D2_V+3*D2_VS, D2_FEAT=D2_WS+NW*64*4, D2_BYTES=D2_FEAT+SEQ*8;
template<int THRL> __device__ __forceinline__ void attn_pass_dv128(int qb,int jmin,const bf16*Qh,const bf16*__restrict__ Kh0,const bf16*__restrict__ Vh0,float slope2,char*shm,f32x16(&o)[4]){
  constexpr int MODE=1; const float*cumf=nullptr;
  const bf16*__restrict__ Kh=Kh0+(long)jmin*KVBLK*DM; const bf16*__restrict__ Vh=Vh0+(long)jmin*KVBLK*DM;
  int tid_l=threadIdx.x; asm volatile("":"+v"(tid_l));
  const int tid=tid_l,lane=tid&63,r32=lane&31,hi=lane>>5; const int wid=__builtin_amdgcn_readfirstlane(tid>>6);
  const int q0=qb*QB;
  const bf16*Qw=Qh+(long)(q0+wid*QBLK)*DM;
  const unsigned lds0=(unsigned)(uintptr_t)shm;
  float*wsf=(float*)(shm+D2_WS)+wid*64;
  const int NT=(q0+QB)/KVBLK-jmin;
  const lds_cptr shm3=(lds_cptr)shm;
  const __attribute__((address_space(3))) u32x2*featr=(const __attribute__((address_space(3))) u32x2*)(shm3+D2_FEAT)+lane;
  #define AXF0(f) __builtin_bit_cast(bf16x8,(u32x4){hi?0u:(f).x,hi?0u:(f).y,hi?0u:0x3f803f80u,0u})
  #define AXF1(f) __builtin_bit_cast(bf16x8,(u32x4){hi?(f).x:0u,hi?(f).y:0u,hi?0x3f803f80u:0u,0u})
  const bf16*ksrc=Kh+(long)lane*DM+wid*8;
  const bf16*vsrc=Vh+(long)(16*(wid&3)+(lane>>2))*DM+(wid>>2)*32+(lane&3)*8;
  const unsigned kdst=lds0+D2_K+wid*1024, vdst=lds0+D2_V+wid*1024;
  #define DMA_K(t,slot) glds16(ksrc+(long)(t)*KVBLK*DM,(unsigned)__builtin_amdgcn_readfirstlane(kdst+(slot)))
  #define DMA_V(t,slot) do{ glds16(vsrc+(long)(t)*KVBLK*DM,(unsigned)__builtin_amdgcn_readfirstlane(vdst+(slot))); glds16(vsrc+(long)(t)*KVBLK*DM+64,(unsigned)__builtin_amdgcn_readfirstlane(vdst+(slot)+8192)); }while(0)
  const int vb0=(int)(lds0+D2_V)+((lane>>4)&1)*32+(lane&3)*8+(4*hi+((lane&15)>>2))*64;
  const char*Kbase=shm+D2_K;
  const lds_cptr kp0=shm3+D2_K+hi*1024+r32*16; const lds_cptr vp0=shm3+D2_V+((lane>>4)&1)*32+(lane&3)*8+(4*hi+((lane&15)>>2))*64;
  const float qc=(MODE==0)?(cumf[q0+wid*QBLK+r32]*1.4426950408889634f):(-slope2*(float)(q0+wid*QBLK+r32));
  DMA_K(0,0);DMA_V(0,0);DMA_K(1,8192);
  bf16x8 qr[4];
  #pragma unroll
  for(int d0=0;d0<4;++d0)qr[d0]=*reinterpret_cast<const bf16x8*>(&Qw[(long)r32*DM+d0*16+hi*8]);
  { __attribute__((address_space(3))) u32x2*feat=(__attribute__((address_space(3))) u32x2*)(shm+D2_FEAT);
    for(int s=tid;s<64*NT;s+=NW*64){ const int sg=s+64*jmin; const float kx=(MODE==0)?(-cumf[sg]*1.4426950408889634f):(slope2*(float)sg); unsigned h,m,l; split3(kx,h,m,l); u32x2 w; w.x=h|(m<<16); w.y=l|0x3f800000u; feat[s]=w; } }
  float qcm=qc,l_reg=0.f;o[0]=f32x16{};o[1]=f32x16{};o[2]=f32x16{};o[3]=f32x16{};
  bf16x8 qx=make_qx(qcm);
  const int qrel=wid*QBLK+r32;
  #define CMASK(P0,P1,t) do{int jb_=(t)-(NT-4); if(jb_>=0){ if(MODE==0)cmask(P0,P1,jb_,qrel,hi); else dmask(P0,P1,jb_,wid,r32,hi,slope2);} }while(0)
  bool resc=false;
  #define RESC() do{ if(resc){ asm volatile("s_waitcnt lgkmcnt(0)":::"memory"); \
      _Pragma("unroll") for(int d_=0;d_<4;++d_) _Pragma("unroll") for(int r=0;r<16;++r)o[d_][r]*=wsf[crow(r,hi)]; } }while(0)
  f32x16 pA0,pA1,pB0,pB1;
  int sl_prev=0,sl_cur=0,sl_next=D2_VS;
  #define ROT() do{sl_prev=sl_cur;sl_cur=sl_next;sl_next=(sl_next==2*D2_VS)?0:sl_next+D2_VS;}while(0)
  #define KSL(t) (((t)&3)*8192)
  DMA_K(2,2*8192);
  WAIT_BAR(4);
  u32x2 fx=featr[0];
  qkt(pA0,pA1,Kbase,qr,AXF0(fx),AXF1(fx),qx,r32,hi);asm volatile("s_nop 15\n\ts_nop 7":"+v"(pA0),"+v"(pA1));CMASK(pA0,pA1,0);
  { const float rm=rowmax(pA0,pA1); const float dl=(rm>(float)THRL)?rm:0.f; qcm-=dl;
    _Pragma("unroll") for(int r=0;r<16;++r){pA0[r]=fsub_s(pA0[r],dl);pA1[r]=fsub_s(pA1[r],dl);}
    qx=make_qx(qcm);
    _Pragma("unroll") for(int r=0;r<16;++r)pA0[r]=__builtin_amdgcn_exp2f(pA0[r]); }
  _Pragma("unroll") for(int r=0;r<16;++r)pA1[r]=__builtin_amdgcn_exp2f(pA1[r]);
  fx=featr[64];
  WAIT_BAR(0);
  DMA_K(3,3*8192);DMA_V(1,D2_VS);
  ROT();
  s16x4 vlo[8],vhi[8]; u32x4 pw0,pw1,pw2,pw3;
  #define PKW(P,B) cvtpk_s(P[B],P[B+1])
  #define PAF(k) __builtin_bit_cast(bf16x8,pw##k)
  #define VFR(i) (bf16x8){vlo[i][0],vlo[i][1],vlo[i][2],vlo[i][3],vhi[i][0],vhi[i][1],vhi[i][2],vhi[i][3]}
  #define PIN(x) asm volatile("":"+v"(x))
  #define MX3(a,b,c) __builtin_fmaxf(__builtin_fmaxf((a),(b)),(c))
  #define GAPA(MF,A0,A1,A2,A3,W0,W1,PW) do{ MF; sacc+=A0; sacc+=A1; sacc+=A2; sacc+=A3; PIN(sacc); W0; W1; PIN(PW); SBAR(); }while(0)
  #define EX(v) __builtin_amdgcn_exp2f(v)
  #define GAPB(MF,X,B) do{ MF; X[B]=EX(X[B]); X[B+1]=EX(X[B+1]); X[B+2]=EX(X[B+2]); X[B+3]=EX(X[B+3]); PIN(X); SBAR(); }while(0)
  #define GAPB2(MF,X,B) do{ MF; X[B]=EX(X[B]); X[B+1]=EX(X[B+1]); PIN(X); SBAR(); }while(0)
  #define VRD(i) do{ vlo[i]=vtr(vp_+(((i)>>2)*4096+((i)&3)*1024)); vhi[i]=vtr(vp_+(((i)>>2)*4096+((i)&3)*1024+512)); }while(0)
  #define VRC(i) do{ vlo[i]=vtr(vp_+8192+(((i)>>2)*4096+((i)&3)*1024)); vhi[i]=vtr(vp_+8192+(((i)>>2)*4096+((i)&3)*1024+512)); }while(0)
  #define KF(j) do{ kA[(j)&1]=*(const __attribute__((address_space(3))) bf16x8*)(kq_+(j)*2048); kB[(j)&1]=*(const __attribute__((address_space(3))) bf16x8*)(kq_+(j)*2048+512); }while(0)
  #define STEP(C0,C1,P0,P1,t,GK,GV,GL) do{ SBAR(); \
    const lds_cptr vp_=vp0+sl_prev; const lds_cptr kq_=kp0+KSL(t); bf16x8 kA[2],kB[2]; \
    KF(0); SBAR(); \
    { const bf16x8 ax0_=AXF0(fx), ax1_=AXF1(fx); const f32x16 z_=f32x16{}; \
      C0=__builtin_amdgcn_mfma_f32_32x32x16_bf16(ax0_,qx,z_,0,0,0); C1=__builtin_amdgcn_mfma_f32_32x32x16_bf16(ax1_,qx,z_,0,0,0); SBAR(); } \
    KF(1); VRD(0); SBAR(); float sacc=(P0[0]+P0[1]); \
    GAPA(C0=__builtin_amdgcn_mfma_f32_32x32x16_bf16(kA[0],qr[0],C0,0,0,0), P0[2],P0[3],P0[4],P0[5],     pw0[0]=PKW(P0,0), pw0[1]=PKW(P0,2), pw0); \
    VRD(4); SBAR(); GAPA(C1=__builtin_amdgcn_mfma_f32_32x32x16_bf16(kB[0],qr[0],C1,0,0,0), P0[6],P0[7],P0[8],P0[9],     pw0[2]=PKW(P0,4), pw0[3]=PKW(P0,6), pw0); \
    KF(2); VRD(1); SBAR(); GAPA(C0=__builtin_amdgcn_mfma_f32_32x32x16_bf16(kA[1],qr[1],C0,0,0,0),   P0[10],P0[11],P0[12],P0[13], pw1[0]=PKW(P0,8), pw1[1]=PKW(P0,10), pw1); \
    VRD(5); SBAR(); GAPA(C1=__builtin_amdgcn_mfma_f32_32x32x16_bf16(kB[1],qr[1],C1,0,0,0),   P0[14],P0[15],P1[0],P1[1],   pw1[2]=PKW(P0,12),pw1[3]=PKW(P0,14), pw1); \
    KF(3); VRD(2); SBAR(); GAPA(C0=__builtin_amdgcn_mfma_f32_32x32x16_bf16(kA[0],qr[2],C0,0,0,0),   P1[2],P1[3],P1[4],P1[5],     pw2[0]=PKW(P1,0), pw2[1]=PKW(P1,2), pw2); \
    VRD(6); SBAR(); GAPA(C1=__builtin_amdgcn_mfma_f32_32x32x16_bf16(kB[0],qr[2],C1,0,0,0),   P1[6],P1[7],P1[8],P1[9],     pw2[2]=PKW(P1,4), pw2[3]=PKW(P1,6), pw2); \
    VRD(3); SBAR(); GAPA(C0=__builtin_amdgcn_mfma_f32_32x32x16_bf16(kA[1],qr[3],C0,0,0,0),   P1[10],P1[11],P1[12],P1[13], pw3[0]=PKW(P1,8), pw3[1]=PKW(P1,10), pw3); \
    VRD(7); SBAR(); GAPA(C1=__builtin_amdgcn_mfma_f32_32x32x16_bf16(kB[1],qr[3],C1,0,0,0),   P1[14],P1[15],0.f,0.f,       pw3[2]=PKW(P1,12),pw3[3]=PKW(P1,14), pw3); \
    l_reg+=sacc; \
    if(GK){DMA_K((t)+3,KSL((t)+3));} if(GV){DMA_V((t)+1,sl_next);} \
    CMASK(C0,C1,t); \
    { float a=MX3(C0[0],C0[1],C1[0]),b=MX3(C0[2],C0[3],C1[1]); a=MX3(a,C1[2],C1[3]); \
      _Pragma("unroll") for(int r=4;r<16;r+=4){a=MX3(a,C0[r],C0[r+1]);b=MX3(b,C0[r+2],C0[r+3]);a=MX3(a,C1[r],C1[r+1]);b=MX3(b,C1[r+2],C1[r+3]);} \
      float rm=__builtin_fmaxf(a,b); { auto rr=__builtin_amdgcn_permlane32_swap(__float_as_uint(rm),__float_as_uint(rm),false,false); rm=__builtin_fmaxf(__uint_as_float(rr[0]),__uint_as_float(rr[1])); } \
      resc=false; \
      if(__builtin_expect(__any(rm>(float)THRL),0)){ const float dl=__builtin_fmaxf(rm,0.f); qcm-=dl; \
        _Pragma("unroll") for(int r=0;r<16;++r){C0[r]-=dl;C1[r]-=dl;} \
        qx=make_qx(qcm); \
        const float f=__builtin_amdgcn_exp2f(-dl); l_reg*=f; if(hi==0)wsf[r32]=f; resc=true; } } \
    SBAR(); \
    GAPB2(o[0]=__builtin_amdgcn_mfma_f32_32x32x16_bf16(PAF(0),VFR(0),o[0],0,0,0), C0,0); \
    GAPB2(o[1]=__builtin_amdgcn_mfma_f32_32x32x16_bf16(PAF(0),VFR(4),o[1],0,0,0), C0,2); \
    GAPB2(o[0]=__builtin_amdgcn_mfma_f32_32x32x16_bf16(PAF(1),VFR(1),o[0],0,0,0), C0,4); \
    GAPB2(o[1]=__builtin_amdgcn_mfma_f32_32x32x16_bf16(PAF(1),VFR(5),o[1],0,0,0), C0,6); \
    GAPB2(o[0]=__builtin_amdgcn_mfma_f32_32x32x16_bf16(PAF(2),VFR(2),o[0],0,0,0), C0,8); \
    GAPB2(o[1]=__builtin_amdgcn_mfma_f32_32x32x16_bf16(PAF(2),VFR(6),o[1],0,0,0), C0,10); \
    if(GL){ fx=featr[64*((t)+1)]; SBAR(); } \
    GAPB2(o[0]=__builtin_amdgcn_mfma_f32_32x32x16_bf16(PAF(3),VFR(3),o[0],0,0,0), C0,12); \
    GAPB2(o[1]=__builtin_amdgcn_mfma_f32_32x32x16_bf16(PAF(3),VFR(7),o[1],0,0,0), C0,14); \
      \
    VRC(0); VRC(4); VRC(1); VRC(5); SBAR(); \
    VRC(2); VRC(6); GAPB2(o[2]=__builtin_amdgcn_mfma_f32_32x32x16_bf16(PAF(0),VFR(0),o[2],0,0,0), C1,0); \
    VRC(3); VRC(7); GAPB2(o[3]=__builtin_amdgcn_mfma_f32_32x32x16_bf16(PAF(0),VFR(4),o[3],0,0,0), C1,2); \
    GAPB2(o[2]=__builtin_amdgcn_mfma_f32_32x32x16_bf16(PAF(1),VFR(1),o[2],0,0,0), C1,4); \
    GAPB2(o[3]=__builtin_amdgcn_mfma_f32_32x32x16_bf16(PAF(1),VFR(5),o[3],0,0,0), C1,6); \
    GAPB2(o[2]=__builtin_amdgcn_mfma_f32_32x32x16_bf16(PAF(2),VFR(2),o[2],0,0,0), C1,8); \
    GAPB2(o[3]=__builtin_amdgcn_mfma_f32_32x32x16_bf16(PAF(2),VFR(6),o[3],0,0,0), C1,10); \
    GAPB2(o[2]=__builtin_amdgcn_mfma_f32_32x32x16_bf16(PAF(3),VFR(3),o[2],0,0,0), C1,12); \
    GAPB2(o[3]=__builtin_amdgcn_mfma_f32_32x32x16_bf16(PAF(3),VFR(7),o[3],0,0,0), C1,14); \
    }while(0)
  int t=1;
  #undef CMASK
  #define CMASK(P0,P1,t) do{}while(0)
  for(;t+5<NT;t+=2){
    STEP(pB0,pB1,pA0,pA1,t,true,true,true);     WAIT_BAR(3); RESC(); ROT();
    STEP(pA0,pA1,pB0,pB1,t+1,true,true,true);   WAIT_BAR(3); RESC(); ROT();
  }
  #undef CMASK
  #define CMASK(P0,P1,t) do{int jb_=(t)-(NT-4); if(jb_>=0){ if(MODE==0)cmask(P0,P1,jb_,qrel,hi); else dmask(P0,P1,jb_,wid,r32,hi,slope2);} }while(0)
  #define ENDW(tt) do{ if((tt)+3<NT){WAIT_BAR(3);} else if((tt)+2<NT){WAIT_BAR(2);} else {WAIT_BAR(0);} }while(0)
  for(;t+1<NT;t+=2){
    STEP(pB0,pB1,pA0,pA1,t,(t+3<NT),(t+1<NT),(t+1<NT));       ENDW(t);   RESC(); ROT();
    STEP(pA0,pA1,pB0,pB1,t+1,(t+4<NT),(t+2<NT),(t+2<NT));     ENDW(t+1); RESC(); ROT();
  }
  STEP(pB0,pB1,pA0,pA1,NT-1,false,false,false); RESC();
  { float sacc=pB0[0]+pB0[1]; _Pragma("unroll") for(int r=2;r<16;++r)sacc+=pB0[r]; _Pragma("unroll") for(int r=0;r<16;++r)sacc+=pB1[r]; l_reg+=sacc;
    pw0=(u32x4){PKW(pB0,0),PKW(pB0,2),PKW(pB0,4),PKW(pB0,6)};pw1=(u32x4){PKW(pB0,8),PKW(pB0,10),PKW(pB0,12),PKW(pB0,14)};pw2=(u32x4){PKW(pB1,0),PKW(pB1,2),PKW(pB1,4),PKW(pB1,6)};pw3=(u32x4){PKW(pB1,8),PKW(pB1,10),PKW(pB1,12),PKW(pB1,14)};
    SBAR(); pv(o,vb0+sl_cur,PAF(0),PAF(1),PAF(2),PAF(3)); pv(o+2,vb0+sl_cur+8192,PAF(0),PAF(1),PAF(2),PAF(3)); }
  #undef PKW
  #undef PAF
  #undef VFR
  #undef PIN
  #undef MX3
  #undef GAPA
  #undef GAPB
  #undef GAPB2
  #undef EX
  #undef VRD
  #undef KF
  #undef VRC
  #undef STEP
  #undef ENDW
  {auto rr=__builtin_amdgcn_permlane32_swap(__float_as_uint(l_reg),__float_as_uint(l_reg),false,false);l_reg=__uint_as_float(rr[0])+__uint_as_float(rr[1]);}
  if(hi==0)wsf[32+r32]=l_reg;asm volatile("s_waitcnt lgkmcnt(0)":::"memory");
  #pragma unroll
  for(int r=0;r<16;++r){const float rli=__builtin_amdgcn_rcpf(wsf[32+crow(r,hi)]); o[0][r]*=rli; o[1][r]*=rli; o[2][r]*=rli; o[3][r]*=rli;}
  asm volatile("s_waitcnt lgkmcnt(0)\n\ts_barrier":::"memory");
  #undef DMA_K
  #undef DMA_V
  #undef CMASK
  #undef RESC
  #undef ROT
  #undef KSL
  #undef AXF0
  #undef AXF1
}
__device__ __forceinline__ void store_tile_bf16_at(const f32x16*o,bf16*dst,int pitch,char*shm,int stage,int wid,int lane){
  const int r32=lane&31,hi=lane>>5;
  bf16*stg=(bf16*)(shm+stage)+wid*2048;
  #pragma unroll
  for(int r=0;r<16;++r){const int orow=crow(r,hi);
    #pragma unroll
    for(int d0=0;d0<2;++d0)stg[orow*64+d0*32+r32]=__float2bfloat16(o[d0][r]);}
  asm volatile("s_waitcnt lgkmcnt(0)":::"memory");
  #pragma unroll
  for(int i=0;i<4;++i){const int row=i*8+(lane>>3),ch=lane&7; const u32x4 v=*(const u32x4*)(stg+row*64+ch*8); *(u32x4*)(dst+(long)row*pitch+ch*8)=v;}
  asm volatile("s_waitcnt lgkmcnt(0)":::"memory");
}
__device__ __forceinline__ void store_tile_bf16(const f32x16(&o)[2],bf16*dst,int pitch,char*shm,int wid,int lane){
  const int r32=lane&31,hi=lane>>5;
  bf16*stg=(bf16*)(shm+LDS_OST)+wid*2048;
  #pragma unroll
  for(int r=0;r<16;++r){const int orow=crow(r,hi);
    #pragma unroll
    for(int d0=0;d0<2;++d0)stg[orow*64+d0*32+r32]=__float2bfloat16(o[d0][r]);}
  asm volatile("s_waitcnt lgkmcnt(0)":::"memory");
  #pragma unroll
  for(int i=0;i<4;++i){const int row=i*8+(lane>>3),ch=lane&7; const u32x4 v=*(const u32x4*)(stg+row*64+ch*8); *(u32x4*)(dst+(long)row*pitch+ch*8)=v;}
  asm volatile("s_waitcnt lgkmcnt(0)":::"memory");
}
constexpr int ATTN_LDS_BYTES=LDS_BYTES;
#undef SBAR
#undef WAIT_BAR
}

namespace cg = cooperative_groups;
constexpr int BATCH = 16, SEQ = 4096, D = 1024, NTOK = BATCH * SEQ;
constexpr int FH = 8, DH = 4, HD = 64;
constexpr int NPROJ = 3072, IN_COLS = 3080;
constexpr int PH = 8, NKEY = 128, TOPK = 16, PQ = 2048, NEXP = 16384;
constexpr float RMS_EPS = 1e-6f, LOG2E = 1.4426950408889634f, C2 = 0.125f * LOG2E;
constexpr float LAMBDA_INIT = 0.2f;
constexpr int COL_QA = 0, COL_KA = 512, COL_VA = 1024, COL_QB = 1536, COL_KB = 2048, COL_VB = 2560;
constexpr int NWAVES = 8, NTHR = 512;

typedef unsigned short bf16_t;
typedef float f32x4v __attribute__((ext_vector_type(4)));
#define LAS __attribute__((address_space(3)))

constexpr size_t MiB = 1u << 20;
constexpr size_t WS_CTL = 0;
constexpr size_t WS_WIN = 2 * MiB;
constexpr size_t WS_WOUT = 8 * MiB;
constexpr size_t WS_WQ = 10 * MiB;
constexpr size_t WS_LOGF = 16 * MiB;
constexpr size_t WS_CUM = 18 * MiB;
constexpr size_t WS_XN = 96 * MiB;
constexpr size_t WS_PROJ = 224 * MiB;
constexpr size_t WS_Y = 224 * MiB;
constexpr size_t WS_QP = 352 * MiB;
constexpr size_t WS_MIXED = 608 * MiB;
constexpr size_t WS_END = 736 * MiB;
constexpr int LDS_BYTES = 147456;

__device__ __forceinline__ unsigned f2bf(float f) { unsigned u = __builtin_bit_cast(unsigned, f); return (u + 0x7fffu + ((u >> 16) & 1u)) >> 16; }
__device__ __forceinline__ unsigned pk2(float lo, float hi) { return f2bf(lo) | (f2bf(hi) << 16); }
__device__ __forceinline__ float bflo(unsigned w) { return __builtin_bit_cast(float, w << 16); }
__device__ __forceinline__ float bfhi(unsigned w) { return __builtin_bit_cast(float, w & 0xffff0000u); }
__device__ __forceinline__ float wave_sum(float v) {
#pragma unroll
    for (int o = 1; o < 64; o <<= 1) v += __shfl_xor(v, o);
    return v;
}

struct Ctx { int tid, lane, wave, vcu, G, gw, NGW; LAS unsigned char* lds; unsigned char* lds_gen; };

__device__ __forceinline__ void p0_transpose_item(const float* W, int ldw, int K, int ncols, bf16_t* WT, int row_off, float scale, const float* ksc, LAS float* scr, int item, int lane) {
    const int nblk = ncols / 32, kb = item / nblk, nb = item % nblk, k0 = 64 * kb, n0 = 32 * nb;
#pragma unroll 32
    for (int i = 0; i < 32; ++i) { const int kk = 2 * i + (lane >> 5); scr[kk * 33 + (lane & 31)] = W[(size_t)(k0 + kk) * ldw + n0 + (lane & 31)] * (ksc ? scale * ksc[k0 + kk] : scale); }
    asm volatile("s_waitcnt lgkmcnt(0)" ::: "memory");
    const int c = lane & 7;
#pragma unroll
    for (int j = 0; j < 4; ++j) { const int n = (lane >> 3) + 8 * j; const LAS float* s = scr + (8 * c) * 33 + n;
        uint4 o; o.x = pk2(s[0 * 33], s[1 * 33]); o.y = pk2(s[2 * 33], s[3 * 33]); o.z = pk2(s[4 * 33], s[5 * 33]); o.w = pk2(s[6 * 33], s[7 * 33]);
        *(uint4*)(WT + (size_t)(row_off + n0 + n) * K + k0 + 8 * c) = o; }
    asm volatile("s_waitcnt lgkmcnt(0)" ::: "memory");
}
__device__ __forceinline__ void p0_weights(const Ctx& c, const float* w_in, const float* w_out, const float* w_q, const float* g2, const float* g1, bf16_t* WIN, bf16_t* WOUT, bf16_t* WQ) {
    LAS float* scr = (LAS float*)(c.lds + c.wave * 16384);
    constexpr int KB = D / 64;
    constexpr int I0 = KB * (512 / 32), I1 = KB * (1024 / 32), I2 = I0, I3 = I1, I4 = KB * (D / 32), I5 = KB * (PQ / 32);
    constexpr int NIT = I0 + I1 + I2 + I3 + I4 + I5;
    for (int it = c.gw; it < NIT; it += c.NGW) {
        int r = it;
        if (r < I0) { p0_transpose_item(w_in + 0, IN_COLS, D, 512, WIN, 0, C2, g1, scr, r, c.lane); continue; } r -= I0;
        if (r < I1) { p0_transpose_item(w_in + 512, IN_COLS, D, 1024, WIN, 512, 1.f, g1, scr, r, c.lane); continue; } r -= I1;
        if (r < I2) { p0_transpose_item(w_in + 1544, IN_COLS, D, 512, WIN, 1536, C2, g1, scr, r, c.lane); continue; } r -= I2;
        if (r < I3) { p0_transpose_item(w_in + 2056, IN_COLS, D, 1024, WIN, 2048, 1.f, g1, scr, r, c.lane); continue; } r -= I3;
        if (r < I4) { p0_transpose_item(w_out, D, D, D, WOUT, 0, 1.f, nullptr, scr, r, c.lane); continue; } r -= I4;
        p0_transpose_item(w_q, PQ, D, PQ, WQ, 0, 1.f, g2, scr, r, c.lane);
    }
}

__device__ __forceinline__ void rms1_gates_wave(int row0, int step, int lane, const float* __restrict__ x, const float* __restrict__ g1, const float* __restrict__ w_in, const float* __restrict__ b_f,
                                                bf16_t* __restrict__ XN, float* __restrict__ LOGF, float* __restrict__ RSTD) {
    f32x4v wg[16][2], gn[4];
#pragma unroll
    for (int j = 0; j < 4; ++j) { gn[j] = ((const f32x4v*)g1)[lane + 64 * j];
#pragma unroll
        for (int e = 0; e < 4; ++e) { const f32x4v* wr = (const f32x4v*)(w_in + (size_t)(4 * lane + 256 * j + e) * IN_COLS + 1536); wg[4 * j + e][0] = wr[0]; wg[4 * j + e][1] = wr[1]; } }
    const float bfl = b_f[lane >> 3];
    f32x4v va[4], vb[4];
    { const f32x4v* xr = (const f32x4v*)(x + (size_t)row0 * D) + lane;
#pragma unroll
      for (int j = 0; j < 4; ++j) va[j] = xr[64 * j];
      const int r1 = (row0 + step < NTOK) ? row0 + step : row0; const f32x4v* xs = (const f32x4v*)(x + (size_t)r1 * D) + lane;
#pragma unroll
      for (int j = 0; j < 4; ++j) vb[j] = xs[64 * j]; }
    const bool b5 = (lane & 32) != 0, b4 = (lane & 16) != 0, b3 = (lane & 8) != 0;
#define RMS1_ROW(BUF, row_) do { const int rr = (row_); \
        f32x4v v[4]; float ss = 0.f; \
        _Pragma("unroll") for (int j = 0; j < 4; ++j) { v[j] = BUF[j]; ss += (v[j].x * v[j].x + v[j].y * v[j].y) + (v[j].z * v[j].z + v[j].w * v[j].w); } \
        { const int rn = (rr + 2 * step < NTOK) ? rr + 2 * step : rr; const f32x4v* xr = (const f32x4v*)(x + (size_t)rn * D) + lane; \
          _Pragma("unroll") for (int j = 0; j < 4; ++j) BUF[j] = xr[64 * j]; } \
        ss = wave_sum(ss); \
        const float rstd = rsqrtf(ss * (1.f / D) + RMS_EPS); \
        if (lane == 0) RSTD[rr] = rstd; \
        f32x4v ga = {0.f, 0.f, 0.f, 0.f}, gb = {0.f, 0.f, 0.f, 0.f}; \
        unsigned long long* o8 = (unsigned long long*)(XN + (size_t)rr * D) + lane; \
        _Pragma("unroll") for (int j = 0; j < 4; ++j) { \
            o8[64 * j] = (unsigned long long)pk2(v[j].x, v[j].y) | ((unsigned long long)pk2(v[j].z, v[j].w) << 32);     \
            v[j] = v[j] * rstd * gn[j]; \
            _Pragma("unroll") for (int e = 0; e < 4; ++e) { ga += v[j][e] * wg[4 * j + e][0]; gb += v[j][e] * wg[4 * j + e][1]; } \
        } \
          \
        float h0, h1, h2, h3; \
        { const float s0 = b5 ? ga.x : gb.x, s1 = b5 ? ga.y : gb.y, s2 = b5 ? ga.z : gb.z, s3 = b5 ? ga.w : gb.w; \
          h0 = (b5 ? gb.x : ga.x) + __shfl_xor(s0, 32); h1 = (b5 ? gb.y : ga.y) + __shfl_xor(s1, 32); h2 = (b5 ? gb.z : ga.z) + __shfl_xor(s2, 32); h3 = (b5 ? gb.w : ga.w) + __shfl_xor(s3, 32); } \
        float k0, k1; \
        { const float s0 = b4 ? h0 : h2, s1 = b4 ? h1 : h3; k0 = (b4 ? h2 : h0) + __shfl_xor(s0, 16); k1 = (b4 ? h3 : h1) + __shfl_xor(s1, 16); } \
        float gv; { const float s0 = b3 ? k0 : k1; gv = (b3 ? k1 : k0) + __shfl_xor(s0, 8); } \
        gv += __shfl_xor(gv, 4); gv += __shfl_xor(gv, 2); gv += __shfl_xor(gv, 1); \
        if ((lane & 7) == 0) { \
            const float z = gv + bfl; \
            const float ls = fminf(z, 0.f) - log1pf(expf(-fabsf(z))); \
            const int b = rr / SEQ, t = rr % SEQ; \
            LOGF[((size_t)b * FH + (lane >> 3)) * SEQ + t] = ls; \
        } } while (0)
#pragma unroll 1
    for (int row = row0; row < NTOK; row += 2 * step) {
        RMS1_ROW(va, row);
        if (row + step < NTOK) RMS1_ROW(vb, row + step);
    }
#undef RMS1_ROW
}

__device__ __forceinline__ void cumsum_seq(int bh, int lane, const float* __restrict__ LOGF, float* __restrict__ CUM) {
    const float* src = LOGF + (size_t)bh * SEQ + lane * 64; float* dst = CUM + (size_t)bh * SEQ + lane * 64;
    float loc[64]; float run = 0.f;
#pragma unroll
    for (int i = 0; i < 64; ++i) { run += src[i]; loc[i] = run; }
    float incl = run;
#pragma unroll
    for (int o = 1; o < 64; o <<= 1) { const float t = __shfl_up(incl, o); if (lane >= o) incl += t; }
    const float excl = incl - run;
#pragma unroll
    for (int i = 0; i < 64; ++i) dst[i] = loc[i] + excl;
}

namespace pg8 {
struct EpiBf16RowScale {
    static constexpr bool PERM = true, AFTER_DRAIN = false;
    bf16_t* O; int ldc; const unsigned long long* ss; float inv_n, eps;
    __device__ __forceinline__ void operator()(const f32x4 (&acc)[2][2][4][2], const Unit& u, int wr, int wc, int fr, int fq) const {
        const int row0 = u.pm * BM + wr * 64 + fr, col0 = u.pn * BM + wc * 32 + 8 * fq;
        float scv[2][4];
#pragma unroll
        for (int ai = 0; ai < 2; ++ai)
#pragma unroll
            for (int m = 0; m < 4; ++m) scv[ai][m] = (float)ss[row0 + ai * HALF + m * 16];
#pragma unroll
        for (int ai = 0; ai < 2; ++ai)
#pragma unroll
            for (int m = 0; m < 4; ++m) { const int row = row0 + ai * HALF + m * 16; const float sc = rsqrtf(scv[ai][m] * (inv_n * 5.9604644775390625e-8f) + eps); bf16_t* rowp = O + (size_t)row * ldc + col0;
#pragma unroll
                for (int bj = 0; bj < 2; ++bj) { const f32x4 v0 = acc[ai][bj][m][0] * sc, v1 = acc[ai][bj][m][1] * sc;
                    u32x4 w; w.x = cvt_pk_bf16(v0[0], v0[1]); w.y = cvt_pk_bf16(v0[2], v0[3]); w.z = cvt_pk_bf16(v1[0], v1[1]); w.w = cvt_pk_bf16(v1[2], v1[3]);
                    *(u32x4*)(rowp + bj * HALF) = w; } }
    }
};
struct EpiBf16Norm {
    static constexpr bool PERM = true, AFTER_DRAIN = false;
    bf16_t* O; int ldc; unsigned* NRM; const float* RS;
    __device__ __forceinline__ void operator()(const f32x4 (&acc)[2][2][4][2], const Unit& u, int wr, int wc, int fr, int fq) const {
        const int row0 = u.pm * BM + wr * 64 + fr, col0 = u.pn * BM + wc * 32 + 8 * fq;
        float rs[2][4];
        _Pragma("unroll") for (int ai = 0; ai < 2; ++ai) _Pragma("unroll") for (int m = 0; m < 4; ++m) rs[ai][m] = RS[row0 + ai * HALF + m * 16];
        const int pn = u.pn; const bool isq = (pn < 2) || (pn == 6) || (pn == 7), isk = (pn == 2) || (pn == 3) || (pn == 8) || (pn == 9);
        float mx0 = 0.f, mx1 = 0.f;
#pragma unroll
        for (int ai = 0; ai < 2; ++ai)
#pragma unroll
            for (int m = 0; m < 4; ++m) { bf16_t* rowp = O + (size_t)(row0 + ai * HALF + m * 16) * ldc + col0;
#pragma unroll
                for (int bj = 0; bj < 2; ++bj) { const f32x4 v0 = acc[ai][bj][m][0] * rs[ai][m], v1 = acc[ai][bj][m][1] * rs[ai][m];
                    u32x4 w; w.x = cvt_pk_bf16(v0[0], v0[1]); w.y = cvt_pk_bf16(v0[2], v0[3]); w.z = cvt_pk_bf16(v1[0], v1[1]); w.w = cvt_pk_bf16(v1[2], v1[3]);
                    *(u32x4*)(rowp + bj * HALF) = w;
                    if (isq || isk) { float ss = ((v0[0] * v0[0] + v0[1] * v0[1]) + (v0[2] * v0[2] + v0[3] * v0[3])) + ((v1[0] * v1[0] + v1[1] * v1[1]) + (v1[2] * v1[2] + v1[3] * v1[3]));
                        ss += __shfl_xor(ss, 16); ss += __shfl_xor(ss, 32);
                        if (bj == 0) mx0 = fmaxf(mx0, ss); else mx1 = fmaxf(mx1, ss); } } }
        if (isq || isk) {
#pragma unroll
            for (int off = 1; off < 16; off <<= 1) { mx0 = fmaxf(mx0, __shfl_xor(mx0, off)); mx1 = fmaxf(mx1, __shfl_xor(mx1, off)); }
            if (fr == 0 && fq == 0) {
                const int b = u.pm >> 4, qb = u.pm & 15, half = wc & 1;
                const int base = isq ? (pn < 2 ? pn * 4 : 8 + (pn - 6) * 4) : (pn < 4 ? (pn - 2) * 4 : 8 + (pn - 8) * 4);
#pragma unroll
                for (int bj = 0; bj < 2; ++bj) { const int vq = base + 2 * bj + (wc >> 1); const float mv = (bj == 0 ? mx0 : mx1) * 1.02f;
                    const int idx = isq ? (512 + (((b * 16 + qb) * 16 + vq) << 1) + half) : ((((b * 16) + vq) << 1) + half);
                    atomicMax(NRM + idx, __float_as_uint(mv)); }
            }
        }
    }
};
struct EpiResidual {
    static constexpr bool PERM = true, AFTER_DRAIN = false;
    const bf16_t* X; bf16_t* HB; unsigned long long* __restrict__ SS; int ldc;
    __device__ __forceinline__ void operator()(const f32x4 (&acc)[2][2][4][2], const Unit& u, int wr, int wc, int fr, int fq) const {
        const int col0 = u.pn * BM + wc * 32 + 8 * fq;
#pragma unroll
        for (int ai = 0; ai < 2; ++ai) {
            u32x4 pre[4][2];
#pragma unroll
            for (int m = 0; m < 4; ++m) { const size_t off = (size_t)(u.pm * BM + ai * HALF + wr * 64 + m * 16 + fr) * ldc + col0;
#pragma unroll
                for (int bj = 0; bj < 2; ++bj) pre[m][bj] = *(const u32x4*)(X + off + bj * HALF); }
#pragma unroll
            for (int m = 0; m < 4; ++m) { const int row = u.pm * BM + ai * HALF + wr * 64 + m * 16 + fr; const size_t off = (size_t)row * ldc + col0; float part = 0.f;
#pragma unroll
                for (int bj = 0; bj < 2; ++bj) { const u32x4 px = pre[m][bj];
                    const f32x4 x0 = {__builtin_bit_cast(float, px.x << 16), __builtin_bit_cast(float, px.x & 0xffff0000u), __builtin_bit_cast(float, px.y << 16), __builtin_bit_cast(float, px.y & 0xffff0000u)};
                    const f32x4 x1 = {__builtin_bit_cast(float, px.z << 16), __builtin_bit_cast(float, px.z & 0xffff0000u), __builtin_bit_cast(float, px.w << 16), __builtin_bit_cast(float, px.w & 0xffff0000u)};
                    const f32x4 v0 = acc[ai][bj][m][0] + x0, v1 = acc[ai][bj][m][1] + x1;
                    part += ((v0[0] * v0[0] + v0[1] * v0[1]) + (v0[2] * v0[2] + v0[3] * v0[3])) + ((v1[0] * v1[0] + v1[1] * v1[1]) + (v1[2] * v1[2] + v1[3] * v1[3]));
                    u32x4 w; w.x = cvt_pk_bf16(v0[0], v0[1]); w.y = cvt_pk_bf16(v0[2], v0[3]); w.z = cvt_pk_bf16(v1[0], v1[1]); w.w = cvt_pk_bf16(v1[2], v1[3]);
                    *(u32x4*)(HB + off + bj * HALF) = w; }
                part += __shfl_xor(part, 16); part += __shfl_xor(part, 32);
                if (fq == 0) atomicAdd(SS + row, (unsigned long long)(part * 16777216.f)); }
        }
    }
};
}
constexpr size_t WS_SS = 20 * MiB + 65536;
constexpr size_t WS_PO = 224 * MiB;
constexpr int LDS_LAM = 131072;
constexpr size_t WS_NRM = 20 * MiB;
#define NRM_K(b, vq) (((b) * 16 + (vq)) * 2)
#define NRM_Q(b, qb, vq) (512 + (((b) * 16 + (qb)) * 16 + (vq)) * 2)
constexpr int NRM_WORDS = 512 + 8192;
__device__ __forceinline__ void norms_wave(int t0, int lane, const bf16_t* __restrict__ PROJ, float* __restrict__ NRM) {
    const int slot = lane >> 1, half = lane & 1, vq = slot & 15;
    const int col = (slot < 16 ? (vq < 8 ? COL_QA + vq * 64 : COL_QB + (vq - 8) * 64) : (vq < 8 ? COL_KA + vq * 64 : COL_KB + (vq - 8) * 64)) + half * 32;
    float mx = 0.f;
    for (int i = 0; i < 32; ++i) {
        const uint4* p = (const uint4*)(PROJ + (size_t)(t0 + i) * NPROJ + col); float ss = 0.f;
#pragma unroll
        for (int j = 0; j < 4; ++j) { const uint4 w = p[j]; const float a0 = bflo(w.x), a1 = bfhi(w.x), a2 = bflo(w.y), a3 = bfhi(w.y), a4 = bflo(w.z), a5 = bfhi(w.z), a6 = bflo(w.w), a7 = bfhi(w.w);
            ss += (a0 * a0 + a1 * a1) + (a2 * a2 + a3 * a3) + (a4 * a4 + a5 * a5) + (a6 * a6 + a7 * a7); }
        ss += __shfl_xor(ss, 1);
        mx = fmaxf(mx, ss);
    }
    if (half == 0) { const int b = t0 / SEQ, qb = (t0 % SEQ) / 256;
        atomicMax((unsigned*)NRM + (slot < 16 ? NRM_Q(b, qb, vq) : NRM_K(b, vq)), __float_as_uint(mx * 1.02f)); }
}
constexpr size_t WS_DSCR = 32 * MiB;
__device__ __forceinline__ void fox_unit(const Ctx& c, int b, int h, int qb, const bf16_t* PROJ, const float* CUM, const float* NRM, bf16_t* MIXED, unsigned* qctr, unsigned& nxt) {
    using attn_body::bf16; using attn_body::f32x16; using attn_body::attn_pass; using attn_body::store_tile_bf16;
    const bf16* P = (const bf16*)PROJ + (size_t)b * SEQ * NPROJ;
    f32x16 o[2];
    const float* cumf = CUM + ((size_t)b * FH + h) * SEQ;
    const float bound = sqrtf((NRM[NRM_Q(b, qb, h)] + NRM[NRM_Q(b, qb, h) + 1]) * (NRM[NRM_K(b, h)] + NRM[NRM_K(b, h) + 1]));
    const int jmin = attn_body::attn_jmin<0>(qb, bound, cumf, 0.f, threadIdx.x & 63);
    attn_pass<0, 8>(qb, jmin, P + COL_QA + h * 64, P + COL_KA + h * 64, P + COL_VA + h * 64, cumf, 0.f, (char*)c.lds_gen, o);
    int tid_l = threadIdx.x; asm volatile("" : "+v"(tid_l));
    const int lane = tid_l & 63, wave = __builtin_amdgcn_readfirstlane(tid_l >> 6);
    if (tid_l == 0) nxt = atomicAdd(qctr, 1u);
    store_tile_bf16(o, (bf16*)MIXED + ((size_t)b * SEQ + qb * 256 + wave * 32) * D + h * 64, D, (char*)c.lds_gen, wave, lane);
}
__device__ __forceinline__ void diff_unit(const Ctx& c, int b, int h, int qb, const bf16_t* PROJ, const float* NRM, const float* subg, bf16_t* MIXED, unsigned char* ws, unsigned* qctr, unsigned& nxt) {
    using attn_body::bf16; using attn_body::f32x16; using attn_body::attn_pass_dv128; using attn_body::store_tile_bf16_at;
    f32x16 o[4];
#pragma unroll 1
    for (int m = 0; m < 2; ++m) {
        { const bf16* P = (const bf16*)PROJ + (size_t)b * SEQ * NPROJ; const float slope2 = exp2f(-2.f * (float)(h + 1)) * LOG2E;
          const float bound = sqrtf((NRM[NRM_Q(b, qb, 8 + 2 * h + m)] + NRM[NRM_Q(b, qb, 8 + 2 * h + m) + 1]) * (NRM[NRM_K(b, 8 + 2 * h + m)] + NRM[NRM_K(b, 8 + 2 * h + m) + 1]));
          const int jmin = attn_body::attn_jmin<1>(qb, bound, nullptr, slope2, threadIdx.x & 63);
          attn_pass_dv128<8>(qb, jmin, P + COL_QB + h * 128 + m * 64, P + COL_KB + h * 128 + m * 64, P + COL_VB + h * 128, slope2, (char*)c.lds_gen, o); }
        int tid_l = threadIdx.x; asm volatile("" : "+v"(tid_l));
        const int lane = tid_l & 63, wave = __builtin_amdgcn_readfirstlane(tid_l >> 6);
        f32x4v* stash = (f32x4v*)(ws + WS_DSCR + ((size_t)blockIdx.x * NWAVES + wave) * 16384) + lane;
        if (m == 0) {
#pragma unroll
            for (int i = 0; i < 16; ++i) { const int d0 = i >> 2, r = (i & 3) * 4; stash[i * 64] = (f32x4v){o[d0][r], o[d0][r + 1], o[d0][r + 2], o[d0][r + 3]}; }
        } else {
            const float lam = ((const LAS float*)(c.lds + LDS_LAM))[0];
            asm volatile("s_waitcnt vmcnt(0)" ::: "memory");
            if (tid_l == 0) nxt = atomicAdd(qctr, 1u);
#pragma unroll
            for (int i = 0; i < 16; ++i) { const int d0 = i >> 2, r = (i & 3) * 4; const f32x4v a = stash[i * 64];
                o[d0][r] = a.x - lam * o[d0][r]; o[d0][r + 1] = a.y - lam * o[d0][r + 1]; o[d0][r + 2] = a.z - lam * o[d0][r + 2]; o[d0][r + 3] = a.w - lam * o[d0][r + 3]; }
            const int r32 = lane & 31;
            const float g0 = subg[r32], g1 = subg[32 + r32], g2 = subg[64 + r32], g3 = subg[96 + r32];
#pragma unroll
            for (int r = 0; r < 16; ++r) {
                float ss = (o[0][r] * o[0][r] + o[1][r] * o[1][r]) + (o[2][r] * o[2][r] + o[3][r] * o[3][r]);
#pragma unroll
                for (int off = 1; off < 32; off <<= 1) ss += __shfl_xor(ss, off);
                const float rn = rsqrtf(ss * (1.f / 128.f) + RMS_EPS) * (1.f - LAMBDA_INIT);
                o[0][r] *= rn * g0; o[1][r] *= rn * g1; o[2][r] *= rn * g2; o[3][r] *= rn * g3;
            }
            bf16* dst = (bf16*)MIXED + ((size_t)b * SEQ + qb * 256 + wave * 32) * D + 512 + h * 128;
            store_tile_bf16_at(o, dst, D, (char*)c.lds_gen, attn_body::D2_K, wave, lane);
            store_tile_bf16_at(o + 2, dst + 64, D, (char*)c.lds_gen, attn_body::D2_K, wave, lane);
        }
    }
}

__device__ __forceinline__ void resid_rms2_row(int row, int lane, const float* __restrict__ x, const bf16_t* __restrict__ Y, const float* __restrict__ g2, bf16_t* __restrict__ HN) {
    const f32x4v* xr = (const f32x4v*)(x + (size_t)row * D) + lane;
    const uint2* yr = (const uint2*)(Y + (size_t)row * D) + lane;
    f32x4v v[4]; float ss = 0.f;
#pragma unroll
    for (int j = 0; j < 4; ++j) { const uint2 y = yr[64 * j]; v[j] = xr[64 * j]; v[j].x += bflo(y.x); v[j].y += bfhi(y.x); v[j].z += bflo(y.y); v[j].w += bfhi(y.y);
        ss += (v[j].x * v[j].x + v[j].y * v[j].y) + (v[j].z * v[j].z + v[j].w * v[j].w); }
    ss = wave_sum(ss);
    const float rstd = rsqrtf(ss * (1.f / D) + RMS_EPS);
    unsigned long long* o8 = (unsigned long long*)(HN + (size_t)row * D) + lane;
#pragma unroll
    for (int j = 0; j < 4; ++j) { const f32x4v g = ((const f32x4v*)g2)[lane + 64 * j]; const f32x4v w = v[j] * rstd * g;
        o8[64 * j] = (unsigned long long)pk2(w.x, w.y) | ((unsigned long long)pk2(w.z, w.w) << 32); }
}


constexpr size_t WS_UF8 = 736 * MiB;
constexpr size_t WS_VF8 = 752 * MiB;
constexpr size_t WS_SCU = 768 * MiB;
constexpr size_t WS_SCV = 768 * MiB + 65536;
constexpr size_t WS_SUA = 672 * MiB;
constexpr size_t WS_EIDX = 608 * MiB;
constexpr size_t WS_HIDB = 704 * MiB;
constexpr size_t WS_GATE = 640 * MiB;
constexpr size_t WS_END2 = 800 * MiB;
typedef __bf16 bf16x2v __attribute__((ext_vector_type(2)));
typedef unsigned rt_u32x4 __attribute__((ext_vector_type(4)));
typedef short rt_bf16x8 __attribute__((ext_vector_type(8)));
typedef float rt_f32x16 __attribute__((ext_vector_type(16)));

typedef float rt_f32x2 __attribute__((ext_vector_type(2)));
__device__ __forceinline__ void p0_table_row(int lane, const float* __restrict__ src, const float* __restrict__ colgain, unsigned char* __restrict__ dst_base, int row, float* __restrict__ sc) {
    const f32x4v* sr = (const f32x4v*)src + 4 * lane; f32x4v v[4]; float am = 0.f;
#pragma unroll
    for (int j = 0; j < 4; ++j) { v[j] = sr[j]; if (colgain) v[j] = v[j] * ((const f32x4v*)colgain)[4 * lane + j]; am = fmaxf(am, fmaxf(fmaxf(fabsf(v[j].x), fabsf(v[j].y)), fmaxf(fabsf(v[j].z), fabsf(v[j].w)))); }
#pragma unroll
    for (int o = 1; o < 64; o <<= 1) am = fmaxf(am, __shfl_xor(am, o));
    const float q = am > 0.f ? 448.f / am : 1.f;
    unsigned w[4];
#pragma unroll
    for (int j = 0; j < 4; ++j) { int p = __builtin_amdgcn_cvt_pk_fp8_f32(v[j].x * q, v[j].y * q, 0, false); p = __builtin_amdgcn_cvt_pk_fp8_f32(v[j].z * q, v[j].w * q, p, true); w[j] = (unsigned)p; }
    *(uint4*)(dst_base + (size_t)(lane >> 3) * ((size_t)NEXP * 128) + (size_t)row * 128 + (lane & 7) * 16) = (uint4){w[0], w[1], w[2], w[3]};
    if (lane == 0) *sc = am > 0.f ? am * (1.f / 448.f) : 1.f;
}
__device__ __forceinline__ void p0_table_rows4(int lane, const float* __restrict__ src0, const float* __restrict__ colgain, unsigned char* __restrict__ dst_base, int row0, float* __restrict__ sc0) {
    f32x4v v[4][4];
#pragma unroll
    for (int i = 0; i < 4; ++i) { const f32x4v* sr = (const f32x4v*)(src0 + (size_t)i * D) + 4 * lane;
#pragma unroll
        for (int j = 0; j < 4; ++j) v[i][j] = sr[j]; }
    f32x4v cg[4];
#pragma unroll
    for (int j = 0; j < 4; ++j) cg[j] = colgain ? ((const f32x4v*)colgain)[4 * lane + j] : (f32x4v){1.f, 1.f, 1.f, 1.f};
#pragma unroll
    for (int i = 0; i < 4; ++i) {
        float am = 0.f;
#pragma unroll
        for (int j = 0; j < 4; ++j) { if (colgain) v[i][j] = v[i][j] * cg[j]; am = fmaxf(am, fmaxf(fmaxf(fabsf(v[i][j].x), fabsf(v[i][j].y)), fmaxf(fabsf(v[i][j].z), fabsf(v[i][j].w)))); }
#pragma unroll
        for (int o = 1; o < 64; o <<= 1) am = fmaxf(am, __shfl_xor(am, o));
        const float q = am > 0.f ? 448.f / am : 1.f;
        unsigned w[4];
#pragma unroll
        for (int j = 0; j < 4; ++j) { int p = __builtin_amdgcn_cvt_pk_fp8_f32(v[i][j].x * q, v[i][j].y * q, 0, false); p = __builtin_amdgcn_cvt_pk_fp8_f32(v[i][j].z * q, v[i][j].w * q, p, true); w[j] = (unsigned)p; }
        *(uint4*)(dst_base + (size_t)(lane >> 3) * ((size_t)NEXP * 128) + (size_t)(row0 + i) * 128 + (lane & 7) * 16) = (uint4){w[0], w[1], w[2], w[3]};
        if (lane == 0) sc0[i] = am > 0.f ? am * (1.f / 448.f) : 1.f;
    }
}
__device__ __forceinline__ void p0_tables(const Ctx& c, const float* __restrict__ U, const float* __restrict__ V, const float* __restrict__ g2, unsigned char* __restrict__ UF, unsigned char* __restrict__ VF, float* __restrict__ SCU, float* __restrict__ SCV) {
    for (int r = c.gw; r < 2 * NEXP; r += c.NGW) {
        if (r < NEXP) p0_table_row(c.lane, U + (size_t)r * D, g2, UF, r, SCU + r);
        else p0_table_row(c.lane, V + (size_t)(r - NEXP) * D, nullptr, VF, r - NEXP, SCV + (r - NEXP));
    }
}

__device__ __forceinline__ void ce_desc(unsigned& a, unsigned& b) { const unsigned mx = a > b ? a : b, mn = a > b ? b : a; a = mx; b = mn; }
template <int N> __device__ __forceinline__ void bitonic_sort_desc(unsigned (&v)[N]) {
#pragma unroll
    for (int k = 2; k <= N; k <<= 1) {
#pragma unroll
        for (int j = k >> 1; j > 0; j >>= 1) {
#pragma unroll
            for (int i = 0; i < N; ++i) { const int l = i ^ j; if (l > i) { if ((i & k) == 0) ce_desc(v[i], v[l]); else ce_desc(v[l], v[i]); } }
        }
    }
}
__device__ __forceinline__ void sort16_desc(unsigned (&v)[16]) { ce_desc(v[0], v[1]); ce_desc(v[2], v[3]); ce_desc(v[0], v[2]); ce_desc(v[1], v[3]); ce_desc(v[1], v[2]); ce_desc(v[4], v[5]); ce_desc(v[6], v[7]); ce_desc(v[4], v[6]); ce_desc(v[5], v[7]); ce_desc(v[5], v[6]); ce_desc(v[0], v[4]); ce_desc(v[2], v[6]); ce_desc(v[2], v[4]); ce_desc(v[1], v[5]); ce_desc(v[3], v[7]); ce_desc(v[3], v[5]); ce_desc(v[1], v[2]); ce_desc(v[3], v[4]); ce_desc(v[5], v[6]); ce_desc(v[8], v[9]); ce_desc(v[10], v[11]); ce_desc(v[8], v[10]); ce_desc(v[9], v[11]); ce_desc(v[9], v[10]); ce_desc(v[12], v[13]); ce_desc(v[14], v[15]); ce_desc(v[12], v[14]); ce_desc(v[13], v[15]); ce_desc(v[13], v[14]); ce_desc(v[8], v[12]); ce_desc(v[10], v[14]); ce_desc(v[10], v[12]); ce_desc(v[9], v[13]); ce_desc(v[11], v[15]); ce_desc(v[11], v[13]); ce_desc(v[9], v[10]); ce_desc(v[11], v[12]); ce_desc(v[13], v[14]); ce_desc(v[0], v[8]); ce_desc(v[4], v[12]); ce_desc(v[4], v[8]); ce_desc(v[2], v[10]); ce_desc(v[6], v[14]); ce_desc(v[6], v[10]); ce_desc(v[2], v[4]); ce_desc(v[6], v[8]); ce_desc(v[10], v[12]); ce_desc(v[1], v[9]); ce_desc(v[5], v[13]); ce_desc(v[5], v[9]); ce_desc(v[3], v[11]); ce_desc(v[7], v[15]); ce_desc(v[7], v[11]); ce_desc(v[3], v[5]); ce_desc(v[7], v[9]); ce_desc(v[11], v[13]); ce_desc(v[1], v[2]); ce_desc(v[3], v[4]); ce_desc(v[5], v[6]); ce_desc(v[7], v[8]); ce_desc(v[9], v[10]); ce_desc(v[11], v[12]); ce_desc(v[13], v[14]); }
__device__ __forceinline__ void merge_top16(unsigned (&a)[16], const unsigned (&b)[16]) {
#pragma unroll
    for (int i = 0; i < 16; ++i) a[i] = a[i] > b[15 - i] ? a[i] : b[15 - i];
#pragma unroll
    for (int j = 8; j > 0; j >>= 1) {
#pragma unroll
        for (int i = 0; i < 16; ++i) { const int l = i ^ j; if (l > i) ce_desc(a[i], a[l]); }
    }
}
__device__ __forceinline__ unsigned f2key(float f) { const unsigned b = __float_as_uint(f); return b ^ (((int)b >> 31) | 0x80000000u); }
__device__ __forceinline__ float key2f(unsigned k) { const unsigned s_ = (unsigned)((int)k >> 31); return __uint_as_float(~(k ^ (s_ & 0x7fffffffu))); }

__device__ __forceinline__ void top16_of_scores(const rt_f32x16 (&acc)[4], int hi, unsigned (&t)[16]) {
    unsigned g[16];
#pragma unroll
    for (int kb = 0; kb < 4; ++kb) {
        unsigned hi4 = (unsigned)(4 * hi); asm volatile("" : "+v"(hi4));
#pragma unroll
        for (int r = 0; r < 16; ++r) g[r] = ((f2key(acc[kb][r]) & ~127u) | hi4) | (unsigned)(32 * kb + (r & 3) + 8 * (r >> 2));
        sort16_desc(g);
        if (kb == 0) {
#pragma unroll
            for (int i = 0; i < 16; ++i) t[i] = g[i];
        } else merge_top16(t, g);
    }
    unsigned lo[16], up[16];
#pragma unroll
    for (int i = 0; i < 16; ++i) { auto rr = __builtin_amdgcn_permlane32_swap(t[i], t[i], false, false); lo[i] = rr[0]; up[i] = rr[1]; }
    merge_top16(lo, up);
#pragma unroll
    for (int i = 0; i < 16; ++i) t[i] = lo[i];
}

__host__ __device__ constexpr int cand_slot(int a, int b) { int n = 0; for (int i = 0; i < 16; ++i) for (int j = 0; j < 16; ++j) { if (i == a && j == b) return n; if ((i + 1) * (j + 1) <= 16) ++n; } return n; }
static_assert(cand_slot(15, 0) == 49, "50 candidates");
__host__ __device__ constexpr int cand_a(int slot) { int n = 0; for (int i = 0; i < 16; ++i) for (int j = 0; j < 16; ++j) if ((i + 1) * (j + 1) <= 16) { if (n == slot) return i; ++n; } return 0; }
__host__ __device__ constexpr int cand_b(int slot) { int n = 0; for (int i = 0; i < 16; ++i) for (int j = 0; j < 16; ++j) if ((i + 1) * (j + 1) <= 16) { if (n == slot) return j; ++n; } return 0; }
static_assert(cand_a(49) == 15 && cand_b(49) == 0 && cand_a(0) == 0 && cand_b(1) == 1, "candidate slot inverse");
constexpr int RT_SK_BYTES = 65536, RT_LUT_OFF = 65536;
constexpr size_t WS_RSTD = 22 * MiB;
constexpr size_t WS_SKIMG = 24 * MiB;
__device__ __forceinline__ void p0_subkey_image(const Ctx& c, const float* __restrict__ subk, unsigned char* __restrict__ img) {
    for (int q = c.vcu * NTHR + c.tid; q < PH * 4096; q += c.G * NTHR) {
        const int h = q >> 12, pos = q & 4095, p = pos >> 11, key = (pos >> 4) & 127, ch = (pos & 15) ^ (key & 15);
        const float* src = subk + (((size_t)h * 2 + p) * NKEY + key) * 128 + ch * 8; const f32x4v a = ((const f32x4v*)src)[0], b = ((const f32x4v*)src)[1];
        rt_u32x4 o; o.x = pk2(a.x, a.y); o.y = pk2(a.z, a.w); o.z = pk2(b.x, b.y); o.w = pk2(b.z, b.w);
        *(rt_u32x4*)(img + (size_t)q * 16) = o; }
}
__device__ __forceinline__ void route_dma_subkeys(const Ctx& c, const unsigned char* __restrict__ img_h) {
    int tid_l = threadIdx.x; asm volatile("" : "+v"(tid_l));
    const int lane = tid_l & 63, wv = __builtin_amdgcn_readfirstlane(tid_l >> 6);
#pragma unroll
    for (int i = 0; i < 8; ++i)
        __builtin_amdgcn_global_load_lds((const unsigned*)(img_h + i * 8192 + wv * 1024 + lane * 16), (LAS unsigned*)(c.lds + i * 8192 + wv * 1024), 16, 0, 0);
}
__device__ __forceinline__ void route_tile(const Ctx& c, int tile, int h, const bf16_t* __restrict__ QP, const float* __restrict__ SCU, const float* __restrict__ SCV, unsigned short* __restrict__ EIDX, unsigned* __restrict__ GATE, float* __restrict__ SUA, const unsigned char* __restrict__ img_next) {
    int lane = c.lane; asm volatile("" : "+v"(lane));
    const int r32 = lane & 31, hi = lane >> 5;
    const int tok = tile * 32 + r32;
    unsigned s1[16], s2[16];
    rt_bf16x8 qfa[2][8];
#pragma unroll
    for (int p = 0; p < 2; ++p) { const uint4* qp = (const uint4*)(QP + (size_t)tok * PQ + h * 256 + p * 128) + hi;
#pragma unroll
        for (int kc = 0; kc < 8; ++kc) qfa[p][kc] = __builtin_bit_cast(rt_bf16x8, qp[2 * kc]); }
#pragma unroll
    for (int p = 0; p < 2; ++p) {
        rt_bf16x8 qf[8];
#pragma unroll
        for (int kc = 0; kc < 8; ++kc) qf[kc] = qfa[p][kc];
        rt_f32x16 acc[4];
#pragma unroll
        for (int kb = 0; kb < 4; ++kb) {
            const int key = 32 * kb + r32;
            const LAS unsigned char* rowp = c.lds + p * 32768 + key * 256;
            acc[kb] = rt_f32x16{};
#pragma unroll
            for (int kc = 0; kc < 8; ++kc) {
                const rt_bf16x8 af = *(const LAS rt_bf16x8*)(rowp + (((2 * kc + hi) ^ (key & 15)) << 4));
                acc[kb] = __builtin_amdgcn_mfma_f32_32x32x16_bf16(af, qf[kc], acc[kb], 0, 0, 0);
            }
        }
        if (p == 1) {
            __syncthreads();
            if (img_next) route_dma_subkeys(c, img_next);
        }
        if (p == 0) top16_of_scores(acc, hi, s1); else top16_of_scores(acc, hi, s2);
    }
    unsigned top[16];
    {
        float f1[16], f2[16];
#pragma unroll
        for (int i = 0; i < 16; ++i) { f1[i] = key2f(s1[i]); f2[i] = key2f(s2[i]); }
        unsigned ga[16], gb[16];
#pragma unroll
        for (int j = 0; j < 32; ++j) {
            unsigned key = 0u;
            if (j < 25) { constexpr int dummy = 0; (void)dummy;
                const int a0 = cand_a(2 * j), b0 = cand_b(2 * j), a1 = cand_a(2 * j + 1), b1 = cand_b(2 * j + 1);
                const float fa = hi ? f1[a1] : f1[a0], fb = hi ? f2[b1] : f2[b0];
                const unsigned pos = hi ? (unsigned)(255 - (a1 * 16 + b1)) : (unsigned)(255 - (a0 * 16 + b0));
                key = (f2key(fa + fb) & ~255u) | pos; }
            if (j < 16) ga[j] = key; else gb[j - 16] = key;
        }
        sort16_desc(ga); sort16_desc(gb); merge_top16(ga, gb);
        unsigned lo[16], up[16];
#pragma unroll
        for (int i = 0; i < 16; ++i) { auto rr = __builtin_amdgcn_permlane32_swap(ga[i], ga[i], false, false); lo[i] = rr[0]; up[i] = rr[1]; }
        merge_top16(lo, up);
#pragma unroll
        for (int i = 0; i < 16; ++i) top[i] = lo[i];
    }
    LAS unsigned char* lut = c.lds + RT_LUT_OFF + c.wave * 2048 + lane * 32;
    { unsigned w[8];
#pragma unroll
      for (int i = 0; i < 4; ++i) { w[i] = (s1[4 * i] & 127u) | ((s1[4 * i + 1] & 127u) << 8) | ((s1[4 * i + 2] & 127u) << 16) | ((s1[4 * i + 3] & 127u) << 24);
                                    w[4 + i] = (s2[4 * i] & 127u) | ((s2[4 * i + 1] & 127u) << 8) | ((s2[4 * i + 2] & 127u) << 16) | ((s2[4 * i + 3] & 127u) << 24); }
      *(LAS rt_u32x4*)(lut) = (rt_u32x4){w[0], w[1], w[2], w[3]}; *(LAS rt_u32x4*)(lut + 16) = (rt_u32x4){w[4], w[5], w[6], w[7]}; }
    asm volatile("s_waitcnt lgkmcnt(0)" ::: "memory");
    float sc[16], sum = 0.f; const float mx = key2f(top[0] & ~255u);
#pragma unroll
    for (int i = 0; i < 16; ++i) { sc[i] = __expf(key2f(top[i] & ~255u) - mx); sum += sc[i]; }
    const float rs = 1.f / sum;
    int eo[8]; float go[8], so[8];
#pragma unroll
    for (int i = 0; i < 8; ++i) {
        const unsigned k = hi ? top[8 + i] : top[i]; const unsigned pos = 255u - (k & 255u);
        const unsigned ia = lut[pos >> 4], ib = lut[16 + (pos & 15u)];
        eo[i] = (int)(ia * NKEY + ib); go[i] = (hi ? sc[8 + i] : sc[i]) * rs;
    }
#pragma unroll
    for (int i = 0; i < 8; ++i) { so[i] = SCU[eo[i]]; go[i] *= SCV[eo[i]]; }
    asm volatile("s_waitcnt lgkmcnt(0)" ::: "memory");
    asm volatile("s_waitcnt vmcnt(0)" ::: "memory");
    unsigned short* ep = EIDX + (size_t)tok * 128 + h * 16 + hi * 8; unsigned* gp = GATE + (size_t)tok * 128 + h * 16 + hi * 8;
    *(rt_u32x4*)ep = (rt_u32x4){(unsigned)eo[0] | ((unsigned)eo[1] << 16), (unsigned)eo[2] | ((unsigned)eo[3] << 16), (unsigned)eo[4] | ((unsigned)eo[5] << 16), (unsigned)eo[6] | ((unsigned)eo[7] << 16)};
    *(rt_u32x4*)gp = (rt_u32x4){pk2(go[0], so[0]), pk2(go[1], so[1]), pk2(go[2], so[2]), pk2(go[3], so[3])}; *(rt_u32x4*)(gp + 4) = (rt_u32x4){pk2(go[4], so[4]), pk2(go[5], so[5]), pk2(go[6], so[6]), pk2(go[7], so[7])};
}

constexpr size_t WS_PART = 352 * MiB;
__device__ __forceinline__ float dpp_f(float v, const int ctrl_sel) {
    const int x = __builtin_bit_cast(int, v);
    const int r = ctrl_sel == 0 ? __builtin_amdgcn_update_dpp(x, x, 0xB1, 0xf, 0xf, false) : ctrl_sel == 1 ? __builtin_amdgcn_update_dpp(x, x, 0x4E, 0xf, 0xf, false) : __builtin_amdgcn_update_dpp(x, x, 0x141, 0xf, 0xf, false);
    return __builtin_bit_cast(float, r);
}
#define FP8X16(W_, F_) do { const uint4 q_ = (W_); const rt_f32x2 t0_ = __builtin_amdgcn_cvt_pk_f32_fp8((int)q_.x, false), t1_ = __builtin_amdgcn_cvt_pk_f32_fp8((int)q_.x, true), t2_ = __builtin_amdgcn_cvt_pk_f32_fp8((int)q_.y, false), t3_ = __builtin_amdgcn_cvt_pk_f32_fp8((int)q_.y, true); \
    const rt_f32x2 t4_ = __builtin_amdgcn_cvt_pk_f32_fp8((int)q_.z, false), t5_ = __builtin_amdgcn_cvt_pk_f32_fp8((int)q_.z, true), t6_ = __builtin_amdgcn_cvt_pk_f32_fp8((int)q_.w, false), t7_ = __builtin_amdgcn_cvt_pk_f32_fp8((int)q_.w, true); \
    F_[0] = t0_.x; F_[1] = t0_.y; F_[2] = t1_.x; F_[3] = t1_.y; F_[4] = t2_.x; F_[5] = t2_.y; F_[6] = t3_.x; F_[7] = t3_.y; F_[8] = t4_.x; F_[9] = t4_.y; F_[10] = t5_.x; F_[11] = t5_.y; F_[12] = t6_.x; F_[13] = t6_.y; F_[14] = t7_.x; F_[15] = t7_.y; } while (0)
typedef int rt_i32x4 __attribute__((ext_vector_type(4)));
#define U_DOT(Wq, XW, D_) do { const uint4 q_ = (Wq); float d_ = 0.f; \
    d_ = __builtin_amdgcn_fdot2_f32_bf16(__builtin_amdgcn_cvt_scalef32_pk_bf16_fp8(q_.x, 1.0f, false), __builtin_bit_cast(bf16x2v, XW[0]), d_, false); \
    d_ = __builtin_amdgcn_fdot2_f32_bf16(__builtin_amdgcn_cvt_scalef32_pk_bf16_fp8(q_.x, 1.0f, true),  __builtin_bit_cast(bf16x2v, XW[1]), d_, false); \
    d_ = __builtin_amdgcn_fdot2_f32_bf16(__builtin_amdgcn_cvt_scalef32_pk_bf16_fp8(q_.y, 1.0f, false), __builtin_bit_cast(bf16x2v, XW[2]), d_, false); \
    d_ = __builtin_amdgcn_fdot2_f32_bf16(__builtin_amdgcn_cvt_scalef32_pk_bf16_fp8(q_.y, 1.0f, true),  __builtin_bit_cast(bf16x2v, XW[3]), d_, false); \
    d_ = __builtin_amdgcn_fdot2_f32_bf16(__builtin_amdgcn_cvt_scalef32_pk_bf16_fp8(q_.z, 1.0f, false), __builtin_bit_cast(bf16x2v, XW[4]), d_, false); \
    d_ = __builtin_amdgcn_fdot2_f32_bf16(__builtin_amdgcn_cvt_scalef32_pk_bf16_fp8(q_.z, 1.0f, true),  __builtin_bit_cast(bf16x2v, XW[5]), d_, false); \
    d_ = __builtin_amdgcn_fdot2_f32_bf16(__builtin_amdgcn_cvt_scalef32_pk_bf16_fp8(q_.w, 1.0f, false), __builtin_bit_cast(bf16x2v, XW[6]), d_, false); \
    d_ = __builtin_amdgcn_fdot2_f32_bf16(__builtin_amdgcn_cvt_scalef32_pk_bf16_fp8(q_.w, 1.0f, true),  __builtin_bit_cast(bf16x2v, XW[7]), d_, false); \
    D_ = d_; } while (0)
__device__ __forceinline__ void peer_u_wave(int tok0, int step, int k, int lane, const bf16_t* __restrict__ HN, const unsigned short* __restrict__ EIDX, const unsigned char* __restrict__ UF, unsigned* __restrict__ PARTB) {
    asm volatile("" : "+v"(lane));
    const int g = lane >> 3, c = lane & 7;
    const unsigned uoff = (unsigned)(k * (NEXP * 128) + 16 * c);
    const int last = tok0 + ((NTOK - 1 - tok0) / step) * step;
#define U_IDS(DST, tok_, half_) do { const int tt_ = (tok_) <= last ? (tok_) : last; const rt_u32x4 a_ = *(const rt_u32x4*)(EIDX + (size_t)tt_ * 128 + 16 * g + 8 * (half_)); \
        DST[0] = (int)(a_.x & 0xffffu); DST[1] = (int)(a_.x >> 16); DST[2] = (int)(a_.y & 0xffffu); DST[3] = (int)(a_.y >> 16); DST[4] = (int)(a_.z & 0xffffu); DST[5] = (int)(a_.z >> 16); DST[6] = (int)(a_.w & 0xffffu); DST[7] = (int)(a_.w >> 16); } while (0)
#define U_GATHER(W, IDS) do { _Pragma("unroll") for (int i_ = 0; i_ < 8; ++i_) W[i_] = *(const uint4*)(UF + ((unsigned)IDS[i_] * 128u + uoff)); } while (0)
#define U_X(XW, tok_) do { const int tt_ = (tok_) <= last ? (tok_) : last; const uint4* h_ = (const uint4*)(HN + (size_t)tt_ * D + 128 * k + 16 * c); const uint4 a_ = h_[0], b_ = h_[1]; \
        XW[0] = a_.x; XW[1] = a_.y; XW[2] = a_.z; XW[3] = a_.w; XW[4] = b_.x; XW[5] = b_.y; XW[6] = b_.z; XW[7] = b_.w; } while (0)
#define U_COMPUTE(W, XW, R_) do { float d8_[8]; _Pragma("unroll") for (int i_ = 0; i_ < 8; ++i_) U_DOT(W[i_], XW, d8_[i_]); \
        float d4_[4], d2_[2]; \
        _Pragma("unroll") for (int j_ = 0; j_ < 4; ++j_) { const float keep_ = b2_ ? d8_[j_ + 4] : d8_[j_], send_ = b2_ ? d8_[j_] : d8_[j_ + 4]; d4_[j_] = keep_ + dpp_f(send_, 2); } \
        _Pragma("unroll") for (int j_ = 0; j_ < 2; ++j_) { const float keep_ = b0_ ? d4_[j_ + 2] : d4_[j_], send_ = b0_ ? d4_[j_] : d4_[j_ + 2]; d2_[j_] = keep_ + dpp_f(send_, 0); } \
        const float keep_ = b1_ ? d2_[1] : d2_[0], send_ = b1_ ? d2_[0] : d2_[1]; \
        R_ = keep_ + dpp_f(send_, 1); } while (0)
    const bool b0_ = (lane & 1) != 0, b1_ = (lane & 2) != 0, b2_ = (lane & 4) != 0; const int isel = 4 * (int)b2_ + 2 * (int)b0_ + (int)b1_;
    int idsA[8], idsB[8]; uint4 WA[8], WB[8]; unsigned xc[8], xn[8];
    U_IDS(idsA, tok0, 0); U_IDS(idsB, tok0, 1);
    U_GATHER(WA, idsA); U_X(xc, tok0); U_IDS(idsA, tok0 + step, 0);
#pragma unroll 1
    for (int tok = tok0; tok < NTOK; tok += step) {
        U_GATHER(WB, idsB); U_IDS(idsB, tok + step, 1);
        float r0_, r1_;
        U_COMPUTE(WA, xc, r0_);
        U_GATHER(WA, idsA); U_X(xn, tok + step); U_IDS(idsA, tok + 2 * step, 0);
        U_COMPUTE(WB, xc, r1_);
        PARTB[(size_t)tok * 512 + k * 64 + lane] = pk2(r0_, r1_);
#pragma unroll
        for (int j = 0; j < 8; ++j) xc[j] = xn[j];
    }
#undef U_IDS
#undef U_GATHER
#undef U_X
#undef U_COMPUTE
}
__device__ __forceinline__ void peer_hid_token(int tok, int lane, const float* __restrict__ PART, const float* __restrict__ SUA, const unsigned long long* __restrict__ SS, float* __restrict__ GATE_HID) {
    const float* pp = PART + (size_t)tok * 1024 + lane; float a = 0.f, b = 0.f;
#pragma unroll
    for (int k = 0; k < 8; ++k) { a += pp[128 * k]; b += pp[128 * k + 64]; }
    const float rstd = rsqrtf((float)SS[tok] * (5.9604644775390625e-8f / D) + RMS_EPS);
    a *= SUA[(size_t)tok * 128 + lane] * rstd; b *= SUA[(size_t)tok * 128 + 64 + lane] * rstd;
    float* gp = GATE_HID + (size_t)tok * 128 + lane;
    gp[0] = 0.5f * a * (1.f + erff(a * 0.70710678118654752f)) * gp[0];
    gp[64] = 0.5f * b * (1.f + erff(b * 0.70710678118654752f)) * gp[64];
}
__device__ __forceinline__ void peer_hid_token2(int t0, int t1, int lane, const unsigned* __restrict__ PARTB, const float* __restrict__ SUA, const unsigned long long* __restrict__ SS, float* __restrict__ GATE_HID) {
    const unsigned* p0 = PARTB + (size_t)t0 * 512 + lane; const unsigned* p1 = PARTB + (size_t)t1 * 512 + lane;
    unsigned w0[8], w1[8];
#pragma unroll
    for (int k = 0; k < 8; ++k) { w0[k] = p0[64 * k]; w1[k] = p1[64 * k]; }
    const int s0 = 16 * (lane >> 3) + 4 * ((lane >> 2) & 1) + 2 * (lane & 1) + ((lane >> 1) & 1);
    float* g0 = GATE_HID + (size_t)t0 * 128 + s0; float* g1 = GATE_HID + (size_t)t1 * 128 + s0;
    const float ga0 = g0[0], gb0 = g0[8], ga1 = g1[0], gb1 = g1[8];
    const float sa0 = SUA[(size_t)t0 * 128 + s0], sb0 = SUA[(size_t)t0 * 128 + s0 + 8], sa1 = SUA[(size_t)t1 * 128 + s0], sb1 = SUA[(size_t)t1 * 128 + s0 + 8];
    const float r0 = rsqrtf((float)SS[t0] * (5.9604644775390625e-8f / D) + RMS_EPS), r1 = rsqrtf((float)SS[t1] * (5.9604644775390625e-8f / D) + RMS_EPS);
    float a0 = 0.f, b0 = 0.f, a1 = 0.f, b1 = 0.f;
#pragma unroll
    for (int k = 0; k < 8; ++k) { a0 += bflo(w0[k]); b0 += bfhi(w0[k]); a1 += bflo(w1[k]); b1 += bfhi(w1[k]); }
    a0 *= sa0 * r0; b0 *= sb0 * r0; a1 *= sa1 * r1; b1 *= sb1 * r1;
    const float h00 = 0.5f * a0 * (1.f + erff(a0 * 0.70710678118654752f)) * ga0, h01 = 0.5f * b0 * (1.f + erff(b0 * 0.70710678118654752f)) * gb0;
    const float h10 = 0.5f * a1 * (1.f + erff(a1 * 0.70710678118654752f)) * ga1, h11 = 0.5f * b1 * (1.f + erff(b1 * 0.70710678118654752f)) * gb1;
    g0[0] = h00; g0[8] = h01; g1[0] = h10; g1[8] = h11;
}
struct HidIn { unsigned w0[8], w1[8]; float ga0, gb0, ga1, gb1, sa0, sb0, sa1, sb1; unsigned long long q0, q1; };
__device__ __forceinline__ void peer_hid_load(HidIn& r, int t0, int t1, int lane, const unsigned* __restrict__ PARTB, const float* __restrict__ SUA, const unsigned long long* __restrict__ SS, const unsigned* __restrict__ GS) {
    const unsigned* p0 = PARTB + (size_t)t0 * 512 + lane; const unsigned* p1 = PARTB + (size_t)t1 * 512 + lane;
#pragma unroll
    for (int k = 0; k < 8; ++k) { r.w0[k] = p0[64 * k]; r.w1[k] = p1[64 * k]; }
    const int s0 = 16 * (lane >> 3) + 4 * ((lane >> 2) & 1) + 2 * (lane & 1) + ((lane >> 1) & 1);
    const unsigned* g0 = GS + (size_t)t0 * 128 + s0; const unsigned* g1 = GS + (size_t)t1 * 128 + s0;
    const unsigned wa0 = g0[0], wb0 = g0[8], wa1 = g1[0], wb1 = g1[8];
    r.ga0 = bflo(wa0); r.gb0 = bflo(wb0); r.ga1 = bflo(wa1); r.gb1 = bflo(wb1);
    r.sa0 = bfhi(wa0); r.sb0 = bfhi(wb0); r.sa1 = bfhi(wa1); r.sb1 = bfhi(wb1);
    r.q0 = SS[t0]; r.q1 = SS[t1];
}
__device__ __forceinline__ void peer_hid_finish(const HidIn& r, int t0, int t1, int lane, unsigned short* __restrict__ HIDB) {
    const int s0 = 16 * (lane >> 3) + 4 * ((lane >> 2) & 1) + 2 * (lane & 1) + ((lane >> 1) & 1);
    unsigned short* g0 = HIDB + (size_t)t0 * 128 + s0; unsigned short* g1 = HIDB + (size_t)t1 * 128 + s0;
    const float r0 = rsqrtf((float)r.q0 * (5.9604644775390625e-8f / D) + RMS_EPS), r1 = rsqrtf((float)r.q1 * (5.9604644775390625e-8f / D) + RMS_EPS);
    float a0 = 0.f, b0 = 0.f, a1 = 0.f, b1 = 0.f;
#pragma unroll
    for (int k = 0; k < 8; ++k) { a0 += bflo(r.w0[k]); b0 += bfhi(r.w0[k]); a1 += bflo(r.w1[k]); b1 += bfhi(r.w1[k]); }
    a0 *= r.sa0 * r0; b0 *= r.sb0 * r0; a1 *= r.sa1 * r1; b1 *= r.sb1 * r1;
    const float h00 = 0.5f * a0 * (1.f + erff(a0 * 0.70710678118654752f)) * r.ga0, h01 = 0.5f * b0 * (1.f + erff(b0 * 0.70710678118654752f)) * r.gb0;
    const float h10 = 0.5f * a1 * (1.f + erff(a1 * 0.70710678118654752f)) * r.ga1, h11 = 0.5f * b1 * (1.f + erff(b1 * 0.70710678118654752f)) * r.gb1;
    const unsigned p0_ = pk2(h00, h01), p1_ = pk2(h10, h11);
    g0[0] = (unsigned short)(p0_ & 0xffffu); g0[8] = (unsigned short)(p0_ >> 16); if (t1 != t0) { g1[0] = (unsigned short)(p1_ & 0xffffu); g1[8] = (unsigned short)(p1_ >> 16); }
}
__device__ __forceinline__ void peer_v_wave(int tok0, int step, int k, int lane, const unsigned short* __restrict__ EIDX, const unsigned short* __restrict__ HID, const unsigned char* __restrict__ VF, bf16_t* __restrict__ PO) {
    asm volatile("" : "+v"(lane));
    const int g = lane >> 3, c = lane & 7;
    const unsigned voff = (unsigned)(k * (NEXP * 128) + 16 * c);
    const int dim = 128 * k + 16 * c + ((lane >> 5) & 1) * 8 + ((lane >> 4) & 1) * 4 + ((lane >> 3) & 1) * 2;
    const int last = tok0 + ((NTOK - 1 - tok0) / step) * step;
#define V_IDS(DST, tok_, half_) do { const int tt_ = (tok_) <= last ? (tok_) : last; const rt_u32x4 a_ = *(const rt_u32x4*)(EIDX + (size_t)tt_ * 128 + 16 * g + 8 * (half_)); \
        DST[0] = (int)(a_.x & 0xffffu); DST[1] = (int)(a_.x >> 16); DST[2] = (int)(a_.y & 0xffffu); DST[3] = (int)(a_.y >> 16); DST[4] = (int)(a_.z & 0xffffu); DST[5] = (int)(a_.z >> 16); DST[6] = (int)(a_.w & 0xffffu); DST[7] = (int)(a_.w >> 16); } while (0)
#define V_HID(DST, tok_, half_) do { const int tt_ = (tok_) <= last ? (tok_) : last; const rt_u32x4 a_ = *(const rt_u32x4*)(HID + (size_t)tt_ * 128 + 16 * g + 8 * (half_)); \
        DST[0] = bflo(a_.x); DST[1] = bfhi(a_.x); DST[2] = bflo(a_.y); DST[3] = bfhi(a_.y); DST[4] = bflo(a_.z); DST[5] = bfhi(a_.z); DST[6] = bflo(a_.w); DST[7] = bfhi(a_.w); } while (0)
#define V_GATHER(W, IDS) do { _Pragma("unroll") for (int i_ = 0; i_ < 8; ++i_) W[i_] = *(const uint4*)(VF + ((unsigned)IDS[i_] * 128u + voff)); } while (0)
#define V_FMA2(j_, word_, hi_) acc2[j_] = __builtin_amdgcn_cvt_pk_f32_fp8((int)(word_), hi_) * hh_ + acc2[j_]
#define V_COMPUTE(W, HL) do { _Pragma("unroll") for (int i_ = 0; i_ < 8; ++i_) { const uint4 q_ = W[i_]; const rt_f32x2 hh_ = {HL[i_], HL[i_]}; \
        V_FMA2(0, q_.x, false); V_FMA2(1, q_.x, true); V_FMA2(2, q_.y, false); V_FMA2(3, q_.y, true); V_FMA2(4, q_.z, false); V_FMA2(5, q_.z, true); V_FMA2(6, q_.w, false); V_FMA2(7, q_.w, true); \
        asm volatile("" : "+v"(acc2[0]), "+v"(acc2[1]), "+v"(acc2[2]), "+v"(acc2[3]), "+v"(acc2[4]), "+v"(acc2[5]), "+v"(acc2[6]), "+v"(acc2[7]));   \
        __builtin_amdgcn_sched_barrier(0); } } while (0)
    int ids0[8], ids1[8], ids2[8]; uint4 W0[8], W1[8], W2[8]; float h0[8], h1[8], h2[8];
    rt_f32x2 acc2[8];
#define V_TOK(j_) (tb + ((j_) >> 1) * step)
#define V_STEP(j_, Wc, hc, Wn, hn, idn) do { \
        V_GATHER(Wn, idn); V_HID(hn, V_TOK((j_) + 2), ((j_) + 2) & 1); V_IDS(idn, V_TOK((j_) + 5), ((j_) + 5) & 1); \
        if (((j_) & 1) == 0) { _Pragma("unroll") for (int z_ = 0; z_ < 8; ++z_) acc2[z_] = (rt_f32x2){0.f, 0.f}; } \
        V_COMPUTE(Wc, hc); \
        if ((j_) & 1) { \
            float acc[16]; \
            _Pragma("unroll") for (int z_ = 0; z_ < 8; ++z_) { acc[2 * z_] = acc2[z_].x; acc[2 * z_ + 1] = acc2[z_].y; } \
              \
            float a8[8], a4[4], a2[2]; \
            _Pragma("unroll") for (int z_ = 0; z_ < 8; ++z_) { auto rr = __builtin_amdgcn_permlane32_swap(__float_as_uint(acc[z_]), __float_as_uint(acc[z_ + 8]), false, false); a8[z_] = __uint_as_float(rr[0]) + __uint_as_float(rr[1]); } \
            _Pragma("unroll") for (int z_ = 0; z_ < 4; ++z_) { auto rr = __builtin_amdgcn_permlane16_swap(__float_as_uint(a8[z_]), __float_as_uint(a8[z_ + 4]), false, false); a4[z_] = __uint_as_float(rr[0]) + __uint_as_float(rr[1]); } \
            _Pragma("unroll") for (int z_ = 0; z_ < 2; ++z_) { const bool up = (lane & 8) != 0; const float keep = up ? a4[z_ + 2] : a4[z_], send = up ? a4[z_] : a4[z_ + 2]; \
                a2[z_] = keep + __builtin_bit_cast(float, __builtin_amdgcn_update_dpp(0, __builtin_bit_cast(int, send), 0x128, 0xf, 0xf, false)); } \
            const int ts_ = V_TOK(j_) <= last ? V_TOK(j_) : last; \
            *(unsigned*)(PO + (size_t)ts_ * D + dim) = pk2(a2[0], a2[1]); } } while (0)
    { const int tb = tok0;
      V_IDS(ids0, V_TOK(0), 0); V_IDS(ids1, V_TOK(1), 1); V_IDS(ids2, V_TOK(2), 0);
      V_GATHER(W0, ids0); V_HID(h0, V_TOK(0), 0); V_IDS(ids0, V_TOK(3), 1);
      V_GATHER(W1, ids1); V_HID(h1, V_TOK(1), 1); V_IDS(ids1, V_TOK(4), 0); }
#pragma unroll 1
    for (int tb = tok0; tb < NTOK; tb += 3 * step) {
        V_STEP(0, W0, h0, W2, h2, ids2);
        V_STEP(1, W1, h1, W0, h0, ids0);
        V_STEP(2, W2, h2, W1, h1, ids1);
        V_STEP(3, W0, h0, W2, h2, ids2);
        V_STEP(4, W1, h1, W0, h0, ids0);
        V_STEP(5, W2, h2, W1, h1, ids1);
    }
#undef V_TOK
#undef V_STEP
#undef V_IDS
#undef V_HID
#undef V_GATHER
#undef V_COMPUTE
#undef V_FMA2
}
__device__ __forceinline__ void final_norm_row(int row, int lane, const bf16_t* __restrict__ HB, const bf16_t* __restrict__ PO, const float* __restrict__ fg, float* __restrict__ out) {
    const uint2* hr = (const uint2*)(HB + (size_t)row * D) + lane; const uint2* pr = (const uint2*)(PO + (size_t)row * D) + lane;
    f32x4v* orow = (f32x4v*)(out + (size_t)row * D) + lane; f32x4v v[4]; float ss = 0.f;
#pragma unroll
    for (int j = 0; j < 4; ++j) { const uint2 y = hr[64 * j], p = pr[64 * j];
        v[j].x = bflo(y.x) + bflo(p.x); v[j].y = bfhi(y.x) + bfhi(p.x); v[j].z = bflo(y.y) + bflo(p.y); v[j].w = bfhi(y.y) + bfhi(p.y);
        ss += (v[j].x * v[j].x + v[j].y * v[j].y) + (v[j].z * v[j].z + v[j].w * v[j].w); }
    ss = wave_sum(ss);
    const float rstd = rsqrtf(ss * (1.f / D) + RMS_EPS);
#pragma unroll
    for (int j = 0; j < 4; ++j) orow[64 * j] = v[j] * rstd * ((const f32x4v*)fg)[lane + 64 * j];
}

struct FinIn { uint2 y[4], p[4]; };
__device__ __forceinline__ void final_norm_load(FinIn& r, int row, int lane, const bf16_t* __restrict__ HB, const bf16_t* __restrict__ PO) {
    const uint2* hr = (const uint2*)(HB + (size_t)row * D) + lane; const uint2* pr = (const uint2*)(PO + (size_t)row * D) + lane;
#pragma unroll
    for (int j = 0; j < 4; ++j) { r.y[j] = hr[64 * j]; r.p[j] = pr[64 * j]; }
}
__device__ __forceinline__ void final_norm_finish(const FinIn& r, int row, int lane, const float* __restrict__ fg, float* __restrict__ out) {
    f32x4v* orow = (f32x4v*)(out + (size_t)row * D) + lane; f32x4v v[4]; float ss = 0.f;
#pragma unroll
    for (int j = 0; j < 4; ++j) { const uint2 y = r.y[j], p = r.p[j];
        v[j].x = bflo(y.x) + bflo(p.x); v[j].y = bfhi(y.x) + bfhi(p.x); v[j].z = bflo(y.y) + bflo(p.y); v[j].w = bfhi(y.y) + bfhi(p.y);
        ss += (v[j].x * v[j].x + v[j].y * v[j].y) + (v[j].z * v[j].z + v[j].w * v[j].w); }
    ss = wave_sum(ss);
    const float rstd = rsqrtf(ss * (1.f / D) + RMS_EPS);
#pragma unroll
    for (int j = 0; j < 4; ++j) orow[64 * j] = v[j] * rstd * ((const f32x4v*)fg)[lane + 64 * j];
}
struct Args { const float* in[16]; float* out; unsigned char* ws; };
#define XB_TMO      128
#define XB_XCNT(j)  (256  + 64 * (j))
#define XB_XSUB(j)  (1280 + 64 * (j))
#define XB_XGEN(j)  (2304 + 64 * (j))
#define XB_TOP      3328
#define XB_TOPGEN   3392
#define XCD_BAR_WORDS 3456
#define XB_SPIN_CAP (1u << 18)

__device__ __forceinline__ unsigned xb_ld(unsigned* p)              { return __hip_atomic_load(p, __ATOMIC_RELAXED, __HIP_MEMORY_SCOPE_AGENT); }
__device__ __forceinline__ unsigned xb_add(unsigned* p, unsigned v) { return __hip_atomic_fetch_add(p, v, __ATOMIC_RELAXED, __HIP_MEMORY_SCOPE_AGENT); }
__device__ __forceinline__ unsigned xb_xcc_id() { return (unsigned)__builtin_amdgcn_s_getreg((3 << 11) | 20) & 0xFu; }
#define XB_SPIN(cond, bar) do { unsigned _sp = 0; while (cond) { __builtin_amdgcn_s_sleep(1); \
    if ((++_sp & 255u) == 0u) { if (xb_ld(&(bar)[XB_TMO])) break; if (_sp > XB_SPIN_CAP) { atomicAdd(&(bar)[XB_TMO], 1u); break; } } } } while (0)

struct XcdBarrier {
    unsigned* bar; unsigned x;
    volatile LAS unsigned* st;
};

__device__ __forceinline__ XcdBarrier xcd_barrier_post(unsigned* bar, volatile LAS unsigned* st) {
    XcdBarrier b; b.bar = bar; b.x = xb_xcc_id(); b.st = st;
    if (threadIdx.x == 0) (void)xb_add(&bar[XB_XCNT(b.x)], 1u);
    return b;
}
__device__ __forceinline__ void xcd_barrier_complete(unsigned* bar, unsigned x, unsigned& nloc, unsigned& nx) {
    const unsigned G = gridDim.x * gridDim.y * gridDim.z;
    unsigned sum, cnt, mine, sp = 0u;
    for (;;) {
        sum = 0u; cnt = 0u; mine = 0u;
#pragma unroll
        for (unsigned j = 0; j < 16; ++j) { const unsigned c = xb_ld(&bar[XB_XCNT(j)]); sum += c; cnt += (c > 0u) ? 1u : 0u; mine = (j == x) ? c : mine; }
        if (sum == G) break;
        __builtin_amdgcn_s_sleep(1);
        if ((++sp & 255u) == 0u) { if (xb_ld(&bar[XB_TMO])) break; if (sp > XB_SPIN_CAP) { atomicAdd(&bar[XB_TMO], 1u); break; } }
    }
    nloc = mine > 0u ? mine : 1u; nx = cnt > 0u ? cnt : 1u;
}

__device__ __forceinline__ void xcd_barrier(const XcdBarrier& b) {
    asm volatile("s_waitcnt vmcnt(0)" ::: "memory");
    __syncthreads();
    if (threadIdx.x == 0) {
        unsigned* bar = b.bar;
        __builtin_amdgcn_s_waitcnt(0);
        unsigned nloc = b.st[0], nx = b.st[1];
        if (nloc == 0u) { xcd_barrier_complete(bar, b.x, nloc, nx); b.st[0] = nloc; b.st[1] = nx; }
        const unsigned old = xb_add(&bar[XB_XSUB(b.x)], 1u);
        const unsigned gen = old / nloc;
        if (old + 1u == (gen + 1u) * nloc) {
            __builtin_amdgcn_fence(__ATOMIC_RELEASE, "agent");
            asm volatile("s_waitcnt vmcnt(0)" ::: "memory");
            const unsigned og = xb_add(&bar[XB_TOP], 1u);
            const unsigned tg = og / nx;
            if (og + 1u == (tg + 1u) * nx) xb_add(&bar[XB_TOPGEN], 1u);
            else XB_SPIN(xb_ld(&bar[XB_TOPGEN]) == tg, bar);
            __builtin_amdgcn_fence(__ATOMIC_ACQUIRE, "agent");
            xb_add(&bar[XB_XGEN(b.x)], 1u);
            asm volatile("s_waitcnt vmcnt(0)" ::: "memory");
        } else {
            XB_SPIN(xb_ld(&bar[XB_XGEN(b.x)]) == gen, bar);
            __builtin_amdgcn_fence(__ATOMIC_ACQUIRE, "agent");
            asm volatile("s_waitcnt vmcnt(0)" ::: "memory");
        }
    }
    __syncthreads();
}

constexpr int CW_QUEUE = 1024, LDS_QW = 131072 + 128;
constexpr int CW_BAR = 4096;
constexpr int LDS_BARST = 131072 + 64;
#define CAS __attribute__((address_space(4)))
#define PHASE_PROLOGUE() \
    const CAS Args* ap = (const CAS Args*)__builtin_amdgcn_kernarg_segment_ptr(); asm volatile("" : "+s"(ap)); \
    Ctx c; { int t_ = threadIdx.x; asm volatile("" : "+v"(t_)); c.tid = t_; } c.lane = c.tid & 63; c.wave = __builtin_amdgcn_readfirstlane(c.tid >> 6); c.G = gridDim.x; \
    { const int bx = blockIdx.x; c.vcu = (c.G % 8 == 0) ? (bx % 8) * (c.G / 8) + bx / 8 : bx; } \
    c.gw = c.vcu * NWAVES + c.wave; c.NGW = c.G * NWAVES; c.lds = (LAS unsigned char*)lds_raw; c.lds_gen = lds_raw; \
    unsigned char* ws = ap->ws; (void)ws
#define IN(k) (ap->in[k])
#define GRID_BAR() do { XcdBarrier b_; b_.bar = (unsigned*)(((const CAS Args*)__builtin_amdgcn_kernarg_segment_ptr())->ws + WS_CTL) + CW_BAR; b_.x = xb_xcc_id(); b_.st = (volatile LAS unsigned*)((LAS unsigned char*)lds_raw + LDS_BARST); xcd_barrier(b_); } while (0)
#ifndef PROBE_PHASE
#define PROBE_PHASE -1
#endif
#define STAMP(k) do { if (PROBE_PHASE >= 0 && blockIdx.x == 0 && threadIdx.x == 0) ((unsigned long long*)(((const CAS Args*)__builtin_amdgcn_kernarg_segment_ptr())->ws + WS_CTL))[k] = __builtin_amdgcn_s_memrealtime(); } while (0)
__global__ void __launch_bounds__(NTHR, 2) fwd_megakernel(Args a_unused) {
    extern __shared__ __attribute__((aligned(16))) unsigned char lds_raw[];
    { volatile LAS unsigned* st_ = (volatile LAS unsigned*)((LAS unsigned char*)lds_raw + LDS_BARST); if (threadIdx.x == 0) { st_[0] = 0u; st_[1] = 0u; } }
    STAMP(0);
    if (blockIdx.x == 0) { unsigned* ctl_ = (unsigned*)(((const CAS Args*)__builtin_amdgcn_kernarg_segment_ptr())->ws + WS_CTL);
        for (int i = 64 + (int)threadIdx.x; i < 16384; i += NTHR) ctl_[i] = 0u; }
    { PHASE_PROLOGUE();
      p0_weights(c, IN(2), IN(9), IN(11), IN(10), IN(1), (bf16_t*)(ws + WS_WIN), (bf16_t*)(ws + WS_WOUT), (bf16_t*)(ws + WS_WQ));
      p0_subkey_image(c, IN(12), ws + WS_SKIMG);
      rms1_gates_wave(c.gw, c.NGW, c.lane, IN(0), IN(1), IN(2), IN(3), (bf16_t*)(ws + WS_XN), (float*)(ws + WS_LOGF), (float*)(ws + WS_RSTD)); }
    { PHASE_PROLOGUE();
      for (int i = c.vcu * NTHR + c.tid; i < NRM_WORDS; i += c.G * NTHR) ((float*)(ws + WS_NRM))[i] = 0.f;
      for (int i = c.vcu * NTHR + c.tid; i < NTOK; i += c.G * NTHR) ((unsigned long long*)(ws + WS_SS))[i] = 0ull; }
    cg::this_grid().sync();
    (void)xcd_barrier_post((unsigned*)(((const CAS Args*)__builtin_amdgcn_kernarg_segment_ptr())->ws + WS_CTL) + CW_BAR, (volatile LAS unsigned*)((LAS unsigned char*)lds_raw + LDS_BARST));
    STAMP(1);
    { PHASE_PROLOGUE();
      if (c.gw < BATCH * FH) cumsum_seq(c.gw, c.lane, (const float*)(ws + WS_LOGF), (float*)(ws + WS_CUM));
      __syncthreads(); }
    { PHASE_PROLOGUE();
      pg8::Gemm g{(const bf16_t*)(ws + WS_XN), (const bf16_t*)(ws + WS_WIN), NTOK, NPROJ, D}; pg8::StaticOrder S; S.init(NTOK, NPROJ, c.G, (int)blockIdx.x);
      pg8::EpiBf16Norm E{(bf16_t*)(ws + WS_PROJ), NPROJ, (unsigned*)(ws + WS_NRM), (const float*)(ws + WS_RSTD)};
      pg8::gemm_phase<pg8::EpiBf16Norm, pg8::StaticOrder, true, true>(c.lds, g, S, E); }
    GRID_BAR(); STAMP(2);
    STAMP(3);
    { PHASE_PROLOGUE();
      const float lam = expf(wave_sum(IN(4)[c.lane] * IN(5)[c.lane])) - expf(wave_sum(IN(6)[c.lane] * IN(7)[c.lane])) + LAMBDA_INIT;
      if (c.tid == 0) ((LAS float*)(c.lds + LDS_LAM))[0] = lam;
      __syncthreads(); }
    { PHASE_PROLOGUE();
      const int xg = (int)blockIdx.x & 7;
      unsigned* qctr = (unsigned*)(ws + WS_CTL) + CW_QUEUE + 64 * xg;
      __syncthreads();
      if (c.tid == 0) ((LAS unsigned*)(c.lds + LDS_QW))[0] = atomicAdd(qctr, 1u);
      for (;;) {
          __syncthreads();
          const int u = __builtin_amdgcn_readfirstlane((int)((LAS unsigned*)(c.lds + LDS_QW))[0]);
          if (u >= 2 * 16 * (DH + FH)) break;
          unsigned nxt = 0;
          if (u < 2 * 16 * DH) { const int bl = u >> 4; diff_unit(c, xg + 8 * (bl >> 2), bl & 3, 15 - (u & 15), (const bf16_t*)(ws + WS_PROJ), (const float*)(ws + WS_NRM), IN(8), (bf16_t*)(ws + WS_MIXED), ws, qctr, nxt); }
          else { const int v = u - 2 * 16 * DH, bl = v >> 4; fox_unit(c, xg + 8 * (bl >> 3), bl & 7, 15 - (v & 15), (const bf16_t*)(ws + WS_PROJ), (const float*)(ws + WS_CUM), (const float*)(ws + WS_NRM), (bf16_t*)(ws + WS_MIXED), qctr, nxt); }
          if (threadIdx.x == 0) ((LAS unsigned*)(c.lds + LDS_QW))[0] = nxt;
      } }
    { PHASE_PROLOGUE();
      unsigned* tctr = (unsigned*)(ws + WS_CTL) + CW_QUEUE + 64 * 8;
      for (;;) {
          __syncthreads();
          if (c.tid == 0) ((LAS unsigned*)(c.lds + LDS_QW))[0] = atomicAdd(tctr, 1u);
          __syncthreads();
          const int u = __builtin_amdgcn_readfirstlane((int)((LAS unsigned*)(c.lds + LDS_QW))[0]);
          if (u >= 2 * NEXP / 64) break;
#pragma unroll 1
          for (int i = 0; i < 8; i += 4) { const int r = u * 64 + c.wave * 8 + i;
              if (r < NEXP) p0_table_rows4(c.lane, IN(13) + (size_t)r * D, IN(10), ws + WS_UF8, r, (float*)(ws + WS_SCU) + r);
              else p0_table_rows4(c.lane, IN(14) + (size_t)(r - NEXP) * D, nullptr, ws + WS_VF8, r - NEXP, (float*)(ws + WS_SCV) + (r - NEXP)); }
      } }
    GRID_BAR(); STAMP(4);
    { PHASE_PROLOGUE();
      pg8::Gemm g{(const bf16_t*)(ws + WS_MIXED), (const bf16_t*)(ws + WS_WOUT), NTOK, D, D}; pg8::StaticOrder S; S.init(NTOK, D, c.G, (int)blockIdx.x);
      pg8::EpiResidual E{(const bf16_t*)(ws + WS_XN), (bf16_t*)(ws + WS_XN), (unsigned long long*)(ws + WS_SS), D};
      pg8::gemm_phase<pg8::EpiResidual, pg8::StaticOrder, true, true>(c.lds, g, S, E); }
    GRID_BAR(); STAMP(5); STAMP(6);
    { PHASE_PROLOGUE();
      pg8::Gemm g{(const bf16_t*)(ws + WS_XN), (const bf16_t*)(ws + WS_WQ), NTOK, PQ, D}; pg8::StaticOrder S; S.init(NTOK, PQ, c.G, (int)blockIdx.x);
      pg8::EpiBf16RowScale E{(bf16_t*)(ws + WS_QP), PQ, (const unsigned long long*)(ws + WS_SS), 1.f / D, RMS_EPS};
      pg8::gemm_phase<pg8::EpiBf16RowScale, pg8::StaticOrder, true, true>(c.lds, g, S, E); }
    { PHASE_PROLOGUE(); route_dma_subkeys(c, ws + WS_SKIMG); }
    GRID_BAR(); STAMP(7);
    { PHASE_PROLOGUE();
      for (int blk = c.vcu; blk < NTOK / 256; blk += c.G) {
          if (blk != c.vcu) { __syncthreads(); route_dma_subkeys(c, ws + WS_SKIMG); }
          asm volatile("s_waitcnt vmcnt(0)" ::: "memory");
          for (int h = 0; h < PH; ++h) {
              __syncthreads();
              route_tile(c, blk * 8 + c.wave, h, (const bf16_t*)(ws + WS_QP), (const float*)(ws + WS_SCU), (const float*)(ws + WS_SCV), (unsigned short*)(ws + WS_EIDX), (unsigned*)(ws + WS_GATE), (float*)(ws + WS_SUA),
                         h + 1 < PH ? ws + WS_SKIMG + (size_t)(h + 1) * 65536 : nullptr);
          }
      } }
    GRID_BAR(); STAMP(8);
    asm volatile(".rept 7\n s_nop 0\n .endr" ::: "memory");
    { PHASE_PROLOGUE();
      const int k = (int)blockIdx.x & 7, nw = (c.G >> 3) * NWAVES, wx = ((int)blockIdx.x >> 3) * NWAVES + c.wave;
      peer_u_wave(wx, nw, k, c.lane, (const bf16_t*)(ws + WS_XN), (const unsigned short*)(ws + WS_EIDX), ws + WS_UF8, (unsigned*)(ws + WS_PART)); }
    GRID_BAR(); STAMP(9);
    { PHASE_PROLOGUE();
      const unsigned* PB_ = (const unsigned*)(ws + WS_PART); const float* SU_ = (const float*)(ws + WS_SUA); const unsigned long long* SS_ = (const unsigned long long*)(ws + WS_SS); const unsigned* GH_ = (const unsigned*)(ws + WS_GATE);
      const int st = c.NGW;
#define HID_T1(t_) (((t_) + st < NTOK) ? (t_) + st : (t_))
      HidIn A, B;
      if (c.gw < NTOK) peer_hid_load(A, c.gw, HID_T1(c.gw), c.lane, PB_, SU_, SS_, GH_);
#pragma unroll 1
      for (int tok = c.gw; tok < NTOK; tok += 4 * st) {
          const int tb = tok + 2 * st, tn = tok + 4 * st;
          if (tb < NTOK) peer_hid_load(B, tb, HID_T1(tb), c.lane, PB_, SU_, SS_, GH_);
          peer_hid_finish(A, tok, HID_T1(tok), c.lane, (unsigned short*)(ws + WS_HIDB));
          if (tn < NTOK) peer_hid_load(A, tn, HID_T1(tn), c.lane, PB_, SU_, SS_, GH_);
          if (tb < NTOK) peer_hid_finish(B, tb, HID_T1(tb), c.lane, (unsigned short*)(ws + WS_HIDB));
      }
#undef HID_T1
    }
    GRID_BAR(); STAMP(10);
    asm volatile(".rept 3\n s_nop 0\n .endr" ::: "memory");
    { PHASE_PROLOGUE();
      const int k = (int)blockIdx.x & 7, nw = (c.G >> 3) * NWAVES, wx = ((int)blockIdx.x >> 3) * NWAVES + c.wave;
      peer_v_wave(wx, nw, k, c.lane, (const unsigned short*)(ws + WS_EIDX), (const unsigned short*)(ws + WS_HIDB), ws + WS_VF8, (bf16_t*)(ws + WS_PO)); }
    GRID_BAR(); STAMP(11);
    { PHASE_PROLOGUE();
      { const bf16_t* HB_ = (const bf16_t*)(ws + WS_XN); const bf16_t* PO_ = (const bf16_t*)(ws + WS_PO); const int st = c.NGW;
        FinIn A, B;
        if (c.gw < NTOK) final_norm_load(A, c.gw, c.lane, HB_, PO_);
#pragma unroll 1
        for (int row = c.gw; row < NTOK; row += 2 * st) {
            const int rb = row + st, rn = row + 2 * st;
            if (rb < NTOK) final_norm_load(B, rb, c.lane, HB_, PO_);
            final_norm_finish(A, row, c.lane, IN(15), ap->out);
            if (rn < NTOK) final_norm_load(A, rn, c.lane, HB_, PO_);
            if (rb < NTOK) final_norm_finish(B, rb, c.lane, IN(15), ap->out);
        } }
      STAMP(12);
      if (PROBE_PHASE >= 0 && blockIdx.x == 0 && threadIdx.x == 0) { asm volatile("s_waitcnt vmcnt(0)" ::: "memory"); const unsigned long long* ts = (const unsigned long long*)(ws + WS_CTL);
          ap->out[0] += (float)(PROBE_PHASE == 100 ? ts[12] - ts[0] : ts[PROBE_PHASE + 1] - ts[PROBE_PHASE]) * 1e-4f; } }
}

extern "C" void kernel_launch(void* const* d_in, const int* in_sizes, int n_in, void* d_out, int out_size, void* d_ws, size_t ws_size, hipStream_t stream) {
    static int grid = 0;
    if (grid == 0) {
        if (n_in != 16 || in_sizes[0] != NTOK * D || out_size != NTOK * D || ws_size < WS_END2) { fprintf(stderr, "kernel_launch: unexpected shapes (n_in %d in0 %d out %d ws %zu)\n", n_in, in_sizes[0], out_size, ws_size); grid = -1; return; }
        int dev = 0, cus = 0, per_cu = 0;
        if (hipGetDevice(&dev) != hipSuccess || hipDeviceGetAttribute(&cus, hipDeviceAttributeMultiprocessorCount, dev) != hipSuccess) { grid = -1; return; }
        if (hipFuncSetAttribute((const void*)fwd_megakernel, hipFuncAttributeMaxDynamicSharedMemorySize, LDS_BYTES) != hipSuccess) { fprintf(stderr, "hipFuncSetAttribute failed\n"); grid = -1; return; }
        if (hipOccupancyMaxActiveBlocksPerMultiprocessor(&per_cu, (const void*)fwd_megakernel, NTHR, LDS_BYTES) != hipSuccess || per_cu < 1) { fprintf(stderr, "occupancy query failed (%d)\n", per_cu); grid = -1; return; }
        grid = cus;
    }
    if (grid < 0) return;
    Args a{};
    for (int i = 0; i < 16; ++i) a.in[i] = (const float*)d_in[i];
    a.out = (float*)d_out; a.ws = (unsigned char*)d_ws;
    void* args[] = {&a};
    hipError_t e = hipLaunchCooperativeKernel((const void*)fwd_megakernel, dim3(grid), dim3(NTHR), args, LDS_BYTES, stream);
    if (e != hipSuccess) fprintf(stderr, "cooperative launch failed: %s (grid %d)\n", hipGetErrorString(e), grid);
}
```
